# Optimizing an MI355X kernel written in HIP

```python
import math
import jax
import jax.numpy as jnp
from jax import lax
import numpy as np

D_MODEL = 2048
BATCH = 1
SEQ = 16384
DEPTH = 4

MEM_LEN = 256
EPS = 1e-6
DN_HEADS = 8
DN_DK = 128
DN_DV = 128
DN_CONV = 4
DN_CHUNK = 64
SWA_HEADS = 8
SWA_KV_HEADS = 2
SWA_DH = 64
WINDOW = 128
SB_HEADS = 4
SB_DH = 128
SB_BLOCK = 128
X_HEADS = 4
X_DH = 128
D_FF = 4096
FFN_CONV = 3
N_BRANCH = 3

DN_QK_WIDTH = DN_HEADS * DN_DK
DN_WIDTH = DN_HEADS * DN_DV
SWA_WIDTH = SWA_HEADS * SWA_DH
SWA_KV_WIDTH = SWA_KV_HEADS * SWA_DH
SB_WIDTH = SB_HEADS * SB_DH
X_WIDTH = X_HEADS * X_DH
IN_SIZES = (2 * DN_QK_WIDTH + DN_WIDTH, DN_WIDTH, DN_HEADS, DN_HEADS, SWA_WIDTH, 2 * SWA_KV_WIDTH, 3 * SB_WIDTH, N_BRANCH * D_MODEL)
IN_COLS = sum(IN_SIZES)

kernel_name = 'hybrid_gdn_swa_stickbreak_decoder'


def rmsnorm(x, g):
    xf = x.astype(jnp.float32)
    y = xf * lax.rsqrt(jnp.mean(xf * xf, axis=-1, keepdims=True) + EPS)
    return (y * g.astype(jnp.float32)).astype(x.dtype)


def l2norm(x):
    xf = x.astype(jnp.float32)
    return xf * lax.rsqrt(jnp.sum(xf * xf, axis=-1, keepdims=True) + EPS)


def causal_dwconv(x, w):
    width = w.shape[0]
    seq = x.shape[1]
    xp = jnp.pad(x, ((0, 0), (width - 1, 0), (0, 0)))
    out = xp[:, 0:seq] * w[0]
    for i in range(1, width):
        out = out + xp[:, i:i + seq] * w[i]
    return out


def split_cols(t, sizes):
    offsets = [int(o) for o in np.cumsum(sizes)[:-1]]
    return jnp.split(t, offsets, axis=-1)


def alibi_slopes(n):
    return jnp.exp2(-8.0 * (jnp.arange(n, dtype=jnp.float32) + 1.0) / n)


def gated_delta_rule(q, k, v, g, beta):
    bsz, seq, heads, dk = q.shape
    dv = v.shape[-1]
    c = DN_CHUNK
    n = seq // c
    f32 = jnp.float32

    def chunks(t):
        return t.astype(f32).reshape(bsz, n, c, heads, -1).transpose(0, 1, 3, 2, 4)

    qc = chunks(q) * (dk ** -0.5)
    kc = chunks(k)
    vc = chunks(v)
    gc = jnp.cumsum(g.astype(f32).reshape(bsz, n, c, heads).transpose(0, 1, 3, 2), axis=-1)
    bc = beta.astype(f32).reshape(bsz, n, c, heads).transpose(0, 1, 3, 2)[..., None]
    causal = jnp.tril(jnp.ones((c, c), dtype=bool))
    strict = jnp.tril(jnp.ones((c, c), dtype=bool), -1)
    diff = gc[..., :, None] - gc[..., None, :]
    decay = jnp.where(causal, jnp.exp(jnp.where(causal, diff, 0.0)), 0.0)
    kb = kc * bc
    kk = jnp.einsum('bnhid,bnhjd->bnhij', kb, kc) * decay
    t_mat = jnp.eye(c, dtype=f32) + jnp.where(strict, kk, 0.0)
    u = lax.linalg.triangular_solve(t_mat, vc * bc, left_side=True, lower=True, unit_diagonal=True)
    w = lax.linalg.triangular_solve(t_mat, kb * jnp.exp(gc)[..., None], left_side=True, lower=True, unit_diagonal=True)
    qk = jnp.einsum('bnhid,bnhjd->bnhij', qc, kc) * decay
    q_dec = qc * jnp.exp(gc)[..., None]
    k_dec = kc * jnp.exp(gc[..., -1:] - gc)[..., None]
    g_last = jnp.exp(gc[..., -1])

    def step(state, xs):
        qk_n, qd_n, kd_n, u_n, w_n, gl_n = xs
        v_new = u_n - jnp.einsum('bhcd,bhde->bhce', w_n, state)
        o = jnp.einsum('bhcd,bhde->bhce', qd_n, state) + jnp.einsum('bhij,bhje->bhie', qk_n, v_new)
        state = state * gl_n[..., None, None] + jnp.einsum('bhcd,bhce->bhde', kd_n, v_new)
        return state, o

    xs = tuple(jnp.moveaxis(t, 1, 0) for t in (qk, q_dec, k_dec, u, w, g_last))
    state0 = jnp.zeros((bsz, heads, dk, dv), f32)
    _, o = lax.scan(step, state0, xs)
    return o.transpose(1, 0, 3, 2, 4).reshape(bsz, seq, heads, dv)


def sliding_window_gqa(q, k, v, sinks):
    bsz, seq = q.shape[:2]
    n = seq // WINDOW
    grp = SWA_HEADS // SWA_KV_HEADS
    qb = q.reshape(bsz, n, WINDOW, SWA_KV_HEADS, grp, SWA_DH)

    def band(t):
        tb = t.reshape(bsz, n, WINDOW, SWA_KV_HEADS, SWA_DH)
        prev = jnp.pad(tb, ((0, 0), (1, 0), (0, 0), (0, 0), (0, 0)))[:, :-1]
        return jnp.concatenate([prev, tb], axis=2)

    kb = band(k)
    vb = band(v)
    s = jnp.einsum('bnqhgd,bnkhd->bnhgqk', qb, kb).astype(jnp.float32) * (SWA_DH ** -0.5)
    qi = jnp.arange(WINDOW)[:, None]
    kj = jnp.arange(2 * WINDOW)[None, :]
    dist = qi + WINDOW - kj
    blk = jnp.arange(n)[:, None, None]
    valid = (dist >= 0) & (dist < WINDOW) & (blk * WINDOW + kj - WINDOW >= 0)
    slopes = alibi_slopes(SWA_HEADS).reshape(SWA_KV_HEADS, grp)[:, :, None, None]
    s = s - slopes * dist.astype(jnp.float32)
    s = jnp.where(valid[None, :, None, None], s, -jnp.inf)
    sink = sinks.astype(jnp.float32).reshape(SWA_KV_HEADS, grp)[:, :, None, None]
    m = jnp.maximum(jnp.max(s, axis=-1, keepdims=True), sink)
    p = jnp.exp(s - m)
    p = p / (jnp.sum(p, axis=-1, keepdims=True) + jnp.exp(sink - m))
    o = jnp.einsum('bnhgqk,bnkhd->bnqhgd', p.astype(vb.dtype), vb)
    return o.reshape(bsz, seq, SWA_WIDTH)


def stick_breaking_attention(q, k, v):
    bsz, seq, heads, dh = q.shape
    n = seq // SB_BLOCK
    f32 = jnp.float32
    tri_incl = jnp.tril(jnp.ones((SB_BLOCK, SB_BLOCK), f32))
    tri_blocks = jnp.tril(jnp.ones((n, n), f32), -1)
    scale = dh ** -0.5
    outs = []
    for i in range(n):
        nk = i + 1
        length = nk * SB_BLOCK
        q_blk = q[:, i * SB_BLOCK:(i + 1) * SB_BLOCK]
        k_blk = k[:, :length]
        v_blk = v[:, :length]
        z = jnp.einsum('bqhd,bshd->bhqs', q_blk, k_blk).astype(f32) * scale
        qpos = i * SB_BLOCK + jnp.arange(SB_BLOCK)
        valid = jnp.arange(length)[None, :] < qpos[:, None]
        zm = jnp.where(valid, z, -jnp.inf)
        l = jax.nn.log_sigmoid(-zm).reshape(bsz, heads, SB_BLOCK, nk, SB_BLOCK)
        rev_in = jnp.einsum('bhqnj,js->bhqns', l, tri_incl)
        after = jnp.einsum('bhqm,mn->bhqn', jnp.sum(l, axis=-1), tri_blocks[:nk, :nk])
        rev = (rev_in + after[..., None]).reshape(bsz, heads, SB_BLOCK, length)
        a = jnp.exp(zm + rev)
        outs.append(jnp.einsum('bhqs,bshd->bqhd', a.astype(v.dtype), v_blk))
    o = jnp.concatenate(outs, axis=1)
    return o.reshape(bsz, seq, heads * dh)


def hybrid_mixer(xn, w_in, dn_conv, dn_a_log, dn_dt_bias, dn_norm, swa_sinks, w_br_dn, w_br_swa, w_br_sb, w_o):
    bsz, seq, _ = xn.shape
    proj = xn @ w_in
    dn_qkv, dn_z, dn_a, dn_b, swa_q, swa_kv, sb_qkv, gates = split_cols(proj, IN_SIZES)
    dn_qkv = jax.nn.silu(causal_dwconv(dn_qkv, dn_conv))
    q, k, v = split_cols(dn_qkv, (DN_QK_WIDTH, DN_QK_WIDTH, DN_WIDTH))
    q = l2norm(q.reshape(bsz, seq, DN_HEADS, DN_DK))
    k = l2norm(k.reshape(bsz, seq, DN_HEADS, DN_DK))
    v = v.reshape(bsz, seq, DN_HEADS, DN_DV)
    g = -jnp.exp(dn_a_log.astype(jnp.float32)) * jax.nn.softplus(dn_a.astype(jnp.float32) + dn_dt_bias.astype(jnp.float32))
    beta = jax.nn.sigmoid(dn_b.astype(jnp.float32))
    o_dn = gated_delta_rule(q, k, v, g, beta)
    o_dn = rmsnorm(o_dn, dn_norm) * jax.nn.silu(dn_z.reshape(bsz, seq, DN_HEADS, DN_DV).astype(jnp.float32))
    y_dn = o_dn.reshape(bsz, seq, DN_WIDTH).astype(xn.dtype)
    swa_k, swa_v = split_cols(swa_kv, (SWA_KV_WIDTH, SWA_KV_WIDTH))
    y_swa = sliding_window_gqa(swa_q.reshape(bsz, seq, SWA_HEADS, SWA_DH), swa_k.reshape(bsz, seq, SWA_KV_HEADS, SWA_DH), swa_v.reshape(bsz, seq, SWA_KV_HEADS, SWA_DH), swa_sinks)
    sb_q, sb_k, sb_v = split_cols(sb_qkv, (SB_WIDTH, SB_WIDTH, SB_WIDTH))
    y_sb = stick_breaking_attention(sb_q.reshape(bsz, seq, SB_HEADS, SB_DH), sb_k.reshape(bsz, seq, SB_HEADS, SB_DH), sb_v.reshape(bsz, seq, SB_HEADS, SB_DH))
    gate = jax.nn.sigmoid(gates).reshape(bsz, seq, N_BRANCH, D_MODEL)
    merged = gate[:, :, 0] * (y_dn @ w_br_dn) + gate[:, :, 1] * (y_swa @ w_br_swa) + gate[:, :, 2] * (y_sb @ w_br_sb)
    return merged @ w_o


def memory_cross_attention(hn, mem_n, w_xq, w_xkv, w_xo):
    bsz, seq, _ = hn.shape
    q = (hn @ w_xq).reshape(bsz, seq, X_HEADS, X_DH)
    kv = (mem_n @ w_xkv).reshape(bsz, mem_n.shape[1], 2, X_HEADS, X_DH)
    s = jnp.einsum('bqhd,bmhd->bhqm', q, kv[:, :, 0]).astype(jnp.float32) * (X_DH ** -0.5)
    p = jax.nn.softmax(s, axis=-1)
    o = jnp.einsum('bhqm,bmhd->bqhd', p.astype(kv.dtype), kv[:, :, 1])
    return o.reshape(bsz, seq, X_WIDTH) @ w_xo


def conv_ffn(hn, w_up, ffn_conv, w_down):
    up = causal_dwconv(hn @ w_up, ffn_conv)
    gate, val = jnp.split(up, 2, axis=-1)
    return (jax.nn.silu(gate) * val) @ w_down


def setup_inputs(seed: int = 0) -> dict:
    key = jax.random.key(seed)
    ks = jax.random.split(key, 24)
    f32 = jnp.float32

    def dense(k, shape, fan_in):
        return jax.random.normal(k, shape, f32) * (fan_in ** -0.5)

    def gain(k, shape):
        return 1.0 + 0.02 * jax.random.normal(k, shape, f32)

    dt = jnp.exp(jax.random.uniform(ks[6], (DEPTH, DN_HEADS), f32, minval=math.log(1e-3), maxval=math.log(0.1)))
    return {
        'x': jax.random.normal(ks[0], (BATCH, SEQ, D_MODEL), f32),
        'mem': jax.random.normal(ks[1], (BATCH, MEM_LEN, D_MODEL), f32),
        'norm_mix': gain(ks[2], (DEPTH, D_MODEL)),
        'w_in': dense(ks[3], (DEPTH, D_MODEL, IN_COLS), D_MODEL),
        'dn_conv': dense(ks[4], (DEPTH, DN_CONV, 2 * DN_QK_WIDTH + DN_WIDTH), DN_CONV),
        'dn_a_log': jnp.log(jax.random.uniform(ks[5], (DEPTH, DN_HEADS), f32, minval=1.0, maxval=16.0)),
        'dn_dt_bias': dt + jnp.log(-jnp.expm1(-dt)),
        'dn_norm': gain(ks[7], (DEPTH, DN_DV)),
        'swa_sinks': 0.5 * jax.random.normal(ks[8], (DEPTH, SWA_HEADS), f32),
        'w_br_dn': dense(ks[9], (DEPTH, DN_WIDTH, D_MODEL), DN_WIDTH),
        'w_br_swa': dense(ks[10], (DEPTH, SWA_WIDTH, D_MODEL), SWA_WIDTH),
        'w_br_sb': dense(ks[11], (DEPTH, SB_WIDTH, D_MODEL), SB_WIDTH),
        'w_o': dense(ks[12], (DEPTH, D_MODEL, D_MODEL), D_MODEL),
        'norm_xattn': gain(ks[13], (DEPTH, D_MODEL)),
        'norm_mem': gain(ks[14], (DEPTH, D_MODEL)),
        'w_xq': dense(ks[15], (DEPTH, D_MODEL, X_WIDTH), D_MODEL),
        'w_xkv': dense(ks[16], (DEPTH, D_MODEL, 2 * X_WIDTH), D_MODEL),
        'w_xo': dense(ks[17], (DEPTH, X_WIDTH, D_MODEL), X_WIDTH),
        'norm_ffn': gain(ks[18], (DEPTH, D_MODEL)),
        'w_up': dense(ks[19], (DEPTH, D_MODEL, 2 * D_FF), D_MODEL),
        'ffn_conv': dense(ks[20], (DEPTH, FFN_CONV, 2 * D_FF), FFN_CONV),
        'w_down': dense(ks[21], (DEPTH, D_FF, D_MODEL), D_FF),
        'norm_final': gain(ks[22], (D_MODEL,)),
    }


def reference(x, mem, norm_mix, w_in, dn_conv, dn_a_log, dn_dt_bias, dn_norm, swa_sinks, w_br_dn, w_br_swa, w_br_sb, w_o, norm_xattn, norm_mem, w_xq, w_xkv, w_xo, norm_ffn, w_up, ffn_conv, w_down, norm_final):
    h = x
    for l in range(DEPTH):
        h = h + hybrid_mixer(rmsnorm(h, norm_mix[l]), w_in[l], dn_conv[l], dn_a_log[l], dn_dt_bias[l], dn_norm[l], swa_sinks[l], w_br_dn[l], w_br_swa[l], w_br_sb[l], w_o[l])
        h = h + memory_cross_attention(rmsnorm(h, norm_xattn[l]), rmsnorm(mem, norm_mem[l]), w_xq[l], w_xkv[l], w_xo[l])
        h = h + conv_ffn(rmsnorm(h, norm_ffn[l]), w_up[l], ffn_conv[l], w_down[l])
    return rmsnorm(h, norm_final)
```

```cpp
#include <hip/hip_runtime.h>
#include <cstdio>
#include <cstdint>

#define GAS __attribute__((address_space(1)))
#define LAS __attribute__((address_space(3)))
typedef unsigned short bf16;
typedef unsigned u32x4 __attribute__((ext_vector_type(4)));
typedef unsigned u32x2 __attribute__((ext_vector_type(2)));
typedef float f32x4 __attribute__((ext_vector_type(4)));
typedef float f32x2 __attribute__((ext_vector_type(2)));
typedef short bf16x8 __attribute__((ext_vector_type(8)));

constexpr int S_ = 16384, D_ = 2048, DEPTH_ = 4, MEML = 256, DFF = 4096;
constexpr int NPROJ = 12800;
constexpr int PC_DNQ = 0, PC_DNK = 1024, PC_DNV = 2048, PC_A = 3072, PC_B = 3080, PC_SBK = 3328, PC_GATE = 3840, PC_Z = 9984,
              PC_SWAQ = 11008, PC_SWAK = 11520, PC_SWAV = 11648, PC_SBQ = 11776, PC_SBV = 12288;
constexpr int NPART_A = 4096, NPART_B = NPROJ - NPART_A;
constexpr int IN_COLS_SRC = 12560;
constexpr float EPS_ = 1e-6f;

constexpr size_t MiB = 1u << 20;
constexpr size_t WS_CTL = 0, CTL_ZERO_BYTES = 1 * MiB;
constexpr size_t WS_WIN = 2 * MiB;
constexpr size_t WS_WUP = 202 * MiB;
constexpr size_t WS_WDN = 330 * MiB;
constexpr size_t WS_WO = 394 * MiB;
constexpr size_t WS_WBD = 426 * MiB;
constexpr size_t WS_WBS = 442 * MiB;
constexpr size_t WS_WBB = 450 * MiB;
constexpr size_t WS_WXQ = 458 * MiB;
constexpr size_t WS_WXKV = 466 * MiB;
constexpr size_t WS_WXO = 482 * MiB;
constexpr size_t WS_XN = 490 * MiB;
constexpr size_t WS_PROJ = 554 * MiB;
constexpr size_t WS_UP = 554 * MiB;
constexpr size_t WS_ACT = 810 * MiB;
constexpr size_t WS_DPREP = 954 * MiB;
constexpr size_t WS_ORAW = 1146 * MiB;
constexpr size_t WS_Y = 1210 * MiB;
constexpr size_t WS_MRG = 1274 * MiB;
constexpr size_t WS_MRGB = 1402 * MiB;
constexpr size_t WS_XQ = 1466 * MiB;
constexpr size_t WS_XO = 1482 * MiB;
constexpr size_t WS_KV = 1498 * MiB;
constexpr size_t WS_MEMN = 1500 * MiB;
constexpr size_t WS_GL = 1504 * MiB;
constexpr size_t WS_SSQ = 1506 * MiB, SSQ_BYTES = 2 * MiB;
constexpr size_t WS_OPB = 1508 * MiB;
constexpr size_t WS_END = 1540 * MiB;
constexpr int CW_BAR = 4096;
constexpr int CW_BAR2 = 8192;
constexpr int CW_B1CNT = 12288;
constexpr int CW_PREPCNT = 14336;
constexpr int CW_KMAX = 16384;

constexpr int RING_BYTES = 131072;
constexpr int LDSCTL_OFF = 162816, MISC_OFF = LDSCTL_OFF + 320;
constexpr int LDS_BYTES = 163840;
constexpr int NWAVES = 8;

#define LDS_WAIT() asm volatile("s_waitcnt lgkmcnt(0)" ::: "memory")
#define VM_WAIT() asm volatile("s_waitcnt vmcnt(0)" ::: "memory")
__device__ __forceinline__ unsigned cvt_pk_bf16(float lo, float hi) { unsigned r; asm volatile("v_cvt_pk_bf16_f32 %0, %1, %2" : "=v"(r) : "v"(lo), "v"(hi)); return r; }
__device__ __forceinline__ float bf_lo(unsigned w) { return __uint_as_float(w << 16); }
__device__ __forceinline__ float bf_hi(unsigned w) { return __uint_as_float(w & 0xffff0000u); }
__device__ __forceinline__ float bf2f(bf16 b) { return __uint_as_float(((unsigned)b) << 16); }
__device__ __forceinline__ float wave_sum(float v) {
#pragma unroll
    for (int o = 1; o < 64; o <<= 1) v += __shfl_xor(v, o);
    return v;
}
__device__ __forceinline__ float wave_max(float v) {
#pragma unroll
    for (int o = 1; o < 64; o <<= 1) v = fmaxf(v, __shfl_xor(v, o));
    return v;
}
__device__ __forceinline__ float sigmoidf_(float x) { return 1.0f / (1.0f + __expf(-x)); }
__device__ __forceinline__ float siluf_(float x) { return x / (1.0f + __expf(-x)); }
__device__ __forceinline__ float softplusf_(float x) { return fmaxf(x, 0.f) + log1pf(__expf(-fabsf(x))); }
__device__ __forceinline__ float dot8(u32x4 a, u32x4 b) {
    float s = bf_lo(a.x) * bf_lo(b.x);
    s += bf_hi(a.x) * bf_hi(b.x);
    s += bf_lo(a.y) * bf_lo(b.y); s += bf_hi(a.y) * bf_hi(b.y);
    s += bf_lo(a.z) * bf_lo(b.z); s += bf_hi(a.z) * bf_hi(b.z);
    s += bf_lo(a.w) * bf_lo(b.w); s += bf_hi(a.w) * bf_hi(b.w);
    return s;
}

__device__ __forceinline__ int launder_v(int x) { asm volatile("" : "+v"(x)); return x; }
__device__ __forceinline__ int launder_s(int x) { asm volatile("" : "+s"(x)); return x; }
namespace pg8 {
#define PG8_LAS __attribute__((address_space(3)))
typedef unsigned short bf16_t;
constexpr int BM = 256, BK = 64, HALF = 128, HTB = HALF * BK * 2, STAGE_BYTES = 8 * HTB, NXCD = 8, WGM = 8;
__host__ __device__ __forceinline__ int lds_byte(int r, int c) { const int st = (r >> 4) * 2 + (c >> 5), rr = r & 15, cc = c & 31, ob = rr * 64 + cc * 2; return st * 1024 + (ob ^ (((ob >> 9) & 1) << 5)); }
__host__ __device__ __forceinline__ void stage_rc(int b, int& R, int& C) { const int st = b / 1024, sb = b % 1024, swz = sb ^ (((sb >> 9) & 1) << 5); R = (st >> 1) * 16 + swz / 64; C = (st & 1) * 32 + (swz % 64) / 2; }
__host__ __device__ __forceinline__ int perm32(int rho) { const int n = rho >> 4, i = rho & 15; return 8 * (i >> 2) + 4 * n + (i & 3); }
struct Unit { int pm, pn; };
struct Gemm { const bf16_t* A; const bf16_t* Bt; int M, N, K, lda, ldb; };
struct StaticOrder {
    int nM, nN, nwg, G, c;
    __host__ __device__ void init(int M, int N, int G_, int c_) { nM = M / BM; nN = N / BM; nwg = nM * nN; G = G_; c = c_; }
    __host__ __device__ bool next(int i, Unit& u) const {
        const long L = (long)i * G + c; if (L >= nwg) return false;
        int wgid = (int)L; { const int q = nwg / NXCD, r = nwg % NXCD, xcd = wgid % NXCD, off = wgid / NXCD; wgid = (xcd < r ? xcd * (q + 1) : r * (q + 1) + (xcd - r) * q) + off; }
        const int nig = WGM * nN, gid = wgid / nig, fm = gid * WGM, gsz = (nM - fm) < WGM ? (nM - fm) : WGM;
        u.pm = fm + ((wgid % nig) % gsz); u.pn = (wgid % nig) / gsz; return true;
    }
    __device__ __forceinline__ void a_ready(const Unit&) const {}
    __device__ __forceinline__ void done(const Unit&) const {}
};
struct EpiBf16 {
    static constexpr bool PERM = true, AFTER_DRAIN = false;
    bf16_t* O; int ldc; const unsigned long long* ssq;
    __device__ __forceinline__ void operator()(const f32x4 (&acc)[2][2][4][2], const Unit& u, int wr, int wc, int fr, int fq) const {
        const int row0 = u.pm * BM + wr * 64 + fr, col0 = u.pn * BM + wc * 64 + 8 * fq;
        float rs[2][4];
        if (ssq) { unsigned long long q[2][4];
#pragma unroll
            for (int ai = 0; ai < 2; ++ai)
#pragma unroll
                for (int m = 0; m < 4; ++m) q[ai][m] = ssq[row0 + ai * HALF + m * 16];
#pragma unroll
            for (int ai = 0; ai < 2; ++ai)
#pragma unroll
                for (int m = 0; m < 4; ++m) rs[ai][m] = rsqrtf((float)q[ai][m] * (1.f / (2048.f * 1048576.f)) + 1e-6f);
        } else {
#pragma unroll
            for (int ai = 0; ai < 2; ++ai)
#pragma unroll
                for (int m = 0; m < 4; ++m) rs[ai][m] = 1.f; }
#pragma unroll
        for (int ai = 0; ai < 2; ++ai)
#pragma unroll
            for (int m = 0; m < 4; ++m) { const int row = row0 + ai * HALF + m * 16; bf16_t* rowp = O + (size_t)row * ldc + col0;
#pragma unroll
                for (int bj = 0; bj < 2; ++bj) { const f32x4 v0 = acc[ai][bj][m][0] * rs[ai][m], v1 = acc[ai][bj][m][1] * rs[ai][m];
                    u32x4 w; w.x = cvt_pk_bf16(v0[0], v0[1]); w.y = cvt_pk_bf16(v0[2], v0[3]); w.z = cvt_pk_bf16(v1[0], v1[1]); w.w = cvt_pk_bf16(v1[2], v1[3]);
                    *(u32x4*)(rowp + bj * 32) = w; } }
    }
};
struct EpiProj {
    static constexpr bool PERM = true, AFTER_DRAIN = false;
    bf16_t* O; int ldc; const unsigned long long* ssq; unsigned char* gq; int glo, ghi;
    __device__ __forceinline__ void operator()(const f32x4 (&acc)[2][2][4][2], const Unit& u, int wr, int wc, int fr, int fq) const {
        const int row0 = u.pm * BM + wr * 64 + fr, col0 = u.pn * BM + wc * 64 + 8 * fq;
        float rs[2][4];
        { unsigned long long q[2][4];
#pragma unroll
            for (int ai = 0; ai < 2; ++ai)
#pragma unroll
                for (int m = 0; m < 4; ++m) q[ai][m] = ssq[row0 + ai * HALF + m * 16];
#pragma unroll
            for (int ai = 0; ai < 2; ++ai)
#pragma unroll
                for (int m = 0; m < 4; ++m) rs[ai][m] = rsqrtf((float)q[ai][m] * (1.f / (2048.f * 1048576.f)) + 1e-6f); }
        const bool isg = (u.pn * BM >= glo) && (u.pn * BM < ghi);
        if (!isg) {
#pragma unroll
            for (int ai = 0; ai < 2; ++ai)
#pragma unroll
                for (int m = 0; m < 4; ++m) { const int row = row0 + ai * HALF + m * 16; bf16_t* rowp = O + (size_t)row * ldc + col0;
#pragma unroll
                    for (int bj = 0; bj < 2; ++bj) { const f32x4 v0 = acc[ai][bj][m][0] * rs[ai][m], v1 = acc[ai][bj][m][1] * rs[ai][m];
                        u32x4 w; w.x = cvt_pk_bf16(v0[0], v0[1]); w.y = cvt_pk_bf16(v0[2], v0[3]); w.z = cvt_pk_bf16(v1[0], v1[1]); w.w = cvt_pk_bf16(v1[2], v1[3]);
                        *(u32x4*)(rowp + bj * 32) = w; } }
        } else {
#define SGQ(x) ((unsigned)(__builtin_amdgcn_rcpf(1.f + __expf(-(x))) * 255.f + 0.5f))
#pragma unroll
            for (int ai = 0; ai < 2; ++ai)
#pragma unroll
                for (int m = 0; m < 4; ++m) { const int row = row0 + ai * HALF + m * 16; unsigned char* rowp = gq + (size_t)row * 6144 + (col0 - glo);
#pragma unroll
                    for (int bj = 0; bj < 2; ++bj) { const f32x4 v0 = acc[ai][bj][m][0] * rs[ai][m], v1 = acc[ai][bj][m][1] * rs[ai][m];
                        u32x2 w; w.x = SGQ(v0[0]) | (SGQ(v0[1]) << 8) | (SGQ(v0[2]) << 16) | (SGQ(v0[3]) << 24); w.y = SGQ(v1[0]) | (SGQ(v1[1]) << 8) | (SGQ(v1[2]) << 16) | (SGQ(v1[3]) << 24);
                        *(u32x2*)(rowp + bj * 32) = w; } }
#undef SGQ
        }
    }
};
struct EpiRes {
    static constexpr bool PERM = true, AFTER_DRAIN = false;
    bf16_t* hb; int ldc; unsigned long long* ssq;
    __device__ __forceinline__ void operator()(const f32x4 (&acc)[2][2][4][2], const Unit& u, int wr, int wc, int fr, int fq) const {
        const int row0 = u.pm * BM + wr * 64 + fr, col0 = u.pn * BM + wc * 64 + 8 * fq;
        u32x4 bs[2][4][2];
#pragma unroll
        for (int ai = 0; ai < 2; ++ai)
#pragma unroll
            for (int m = 0; m < 4; ++m)
#pragma unroll
                for (int bj = 0; bj < 2; ++bj) bs[ai][m][bj] = *(const u32x4*)(hb + (size_t)(row0 + ai * HALF + m * 16) * ldc + col0 + bj * 32);
#pragma unroll
        for (int ai = 0; ai < 2; ++ai)
#pragma unroll
            for (int m = 0; m < 4; ++m) { const int row = row0 + ai * HALF + m * 16; const size_t off = (size_t)row * ldc + col0; float ss = 0.f;
#pragma unroll
                for (int bj = 0; bj < 2; ++bj) { const u32x4 b = bs[ai][m][bj]; const f32x4 a0 = acc[ai][bj][m][0], a1 = acc[ai][bj][m][1];
                    const float v0 = bf_lo(b.x) + a0[0], v1 = bf_hi(b.x) + a0[1], v2 = bf_lo(b.y) + a0[2], v3 = bf_hi(b.y) + a0[3];
                    const float v4 = bf_lo(b.z) + a1[0], v5 = bf_hi(b.z) + a1[1], v6 = bf_lo(b.w) + a1[2], v7 = bf_hi(b.w) + a1[3];
                    ss += (v0 * v0 + v1 * v1) + (v2 * v2 + v3 * v3) + (v4 * v4 + v5 * v5) + (v6 * v6 + v7 * v7);
                    u32x4 w; w.x = cvt_pk_bf16(v0, v1); w.y = cvt_pk_bf16(v2, v3); w.z = cvt_pk_bf16(v4, v5); w.w = cvt_pk_bf16(v6, v7);
                    *(u32x4*)(hb + off + bj * 32) = w; }
                ss += __shfl_xor(ss, 16); ss += __shfl_xor(ss, 32);
                if (fq == 0) atomicAdd(ssq + row, (unsigned long long)(ss * 1048576.f)); }
    }
};
template <int MODE> struct EpiGate {
    static constexpr bool PERM = true, AFTER_DRAIN = false;
    const unsigned char* gate; int ldg; bf16_t* mrgb; int ldc;
    __device__ __forceinline__ void operator()(const f32x4 (&acc)[2][2][4][2], const Unit& u, int wr, int wc, int fr, int fq) const {
        const int row0 = u.pm * BM + wr * 64 + fr, col0 = u.pn * BM + wc * 64 + 8 * fq;
#pragma unroll
        for (int ai = 0; ai < 2; ++ai) {
            u32x2 gw[4][2]; u32x4 pv[4][2];
#pragma unroll
            for (int m = 0; m < 4; ++m)
#pragma unroll
                for (int bj = 0; bj < 2; ++bj) { const int row = row0 + ai * HALF + m * 16;
                    gw[m][bj] = *(const u32x2*)(gate + (size_t)row * ldg + col0 + bj * 32);
                    if (MODE != 0) pv[m][bj] = *(const u32x4*)(mrgb + (size_t)row * ldc + col0 + bj * 32); }
#pragma unroll
            for (int m = 0; m < 4; ++m)
#pragma unroll
                for (int bj = 0; bj < 2; ++bj) { const size_t off = (size_t)(row0 + ai * HALF + m * 16) * ldc + col0 + bj * 32;
                    const u32x2 g2 = gw[m][bj]; const f32x4 a0 = acc[ai][bj][m][0], a1 = acc[ai][bj][m][1];
                    const float k255 = 1.f / 255.f;
                    float v[8];
                    v[0] = (float)(g2.x & 255u) * k255 * a0[0]; v[1] = (float)((g2.x >> 8) & 255u) * k255 * a0[1]; v[2] = (float)((g2.x >> 16) & 255u) * k255 * a0[2]; v[3] = (float)(g2.x >> 24) * k255 * a0[3];
                    v[4] = (float)(g2.y & 255u) * k255 * a1[0]; v[5] = (float)((g2.y >> 8) & 255u) * k255 * a1[1]; v[6] = (float)((g2.y >> 16) & 255u) * k255 * a1[2]; v[7] = (float)(g2.y >> 24) * k255 * a1[3];
                    if (MODE != 0) { const u32x4 p = pv[m][bj]; v[0] += bf_lo(p.x); v[1] += bf_hi(p.x); v[2] += bf_lo(p.y); v[3] += bf_hi(p.y); v[4] += bf_lo(p.z); v[5] += bf_hi(p.z); v[6] += bf_lo(p.w); v[7] += bf_hi(p.w); }
                    u32x4 w; w.x = cvt_pk_bf16(v[0], v[1]); w.y = cvt_pk_bf16(v[2], v[3]); w.z = cvt_pk_bf16(v[4], v[5]); w.w = cvt_pk_bf16(v[6], v[7]);
                    *(u32x4*)(mrgb + off) = w; }
        }
    }
};

template <class Epi, class Sched, bool ALIGN_EPI = true>
__device__ __forceinline__ void gemm_phase(PG8_LAS unsigned char* lds, const Gemm g, const Sched& S, const Epi& E) {
    const int tid = launder_v(threadIdx.x), wid = __builtin_amdgcn_readfirstlane(tid >> 6), lane = tid & 63, wr = wid >> 2, wc = wid & 3, fr = lane & 15, fq = lane >> 4;
    const int K = g.K, nt = K / BK;
    unsigned voffA[2], voffB[2];
#pragma unroll
    for (int i = 0; i < 2; ++i) { int R, C; stage_rc(tid * 16 + i * 8192, R, C); const int Rb = 64 * (R >> 5) + perm32(R & 31);
        voffA[i] = (unsigned)(R * g.lda + C) * 2u; voffB[i] = (unsigned)(Rb * g.ldb + C) * 2u; }
    const size_t kstep = (size_t)(BK * 2);
    const size_t hstepA = (size_t)HALF * g.lda * 2, hstepB = (size_t)32 * g.ldb * 2;
    const size_t tstepA = 2 * hstepA, tstepB = (size_t)BM * g.ldb * 2;
    const unsigned ldsw = (unsigned)wid * 1024u;
    const int aoff = lds_byte(wr * 64 + fr, fq * 8), boff = lds_byte(wc * 32 + fr, fq * 8);
#define PG8_SA(b, h) (((b) * 2 + (h)) * HTB)
#define PG8_SB(b, h) ((4 + (b) * 2 + (h)) * HTB)
#define PG8_STAGE(bufoff, gbase, voff) do { _Pragma("unroll") for (int _i = 0; _i < 2; ++_i) \
        __builtin_amdgcn_global_load_lds((const unsigned*)((const char*)(gbase) + (voff)[_i]), (PG8_LAS unsigned*)(lds + (bufoff) + ldsw + _i * 8192), 16, 0, 0); } while (0)
#define PG8_LDA(dst, b, h) do { _Pragma("unroll") for (int m = 0; m < 4; ++m) _Pragma("unroll") for (int k = 0; k < 2; ++k) dst[m][k] = *(const PG8_LAS bf16x8*)(lds + PG8_SA(b, h) + aoff + m * 2048 + k * 1024); } while (0)
#define PG8_LDB(dst, b, h) do { _Pragma("unroll") for (int n = 0; n < 2; ++n) _Pragma("unroll") for (int k = 0; k < 2; ++k) dst[n][k] = *(const PG8_LAS bf16x8*)(lds + PG8_SB(b, h) + boff + n * 2048 + k * 1024); } while (0)
#define PG8_MMA(ai, bj, At, Bt) do { __builtin_amdgcn_s_setprio(1); _Pragma("unroll") for (int m = 0; m < 4; ++m) _Pragma("unroll") for (int n = 0; n < 2; ++n) _Pragma("unroll") for (int k = 0; k < 2; ++k) \
        acc[ai][bj][m][n] = __builtin_amdgcn_mfma_f32_16x16x32_bf16(Bt[n][k], At[m][k], acc[ai][bj][m][n], 0, 0, 0); __builtin_amdgcn_s_setprio(0); } while (0)
#define PG8_WAIT_V(n) asm volatile("s_waitcnt vmcnt(" #n ")" ::: "memory")
#define PG8_WAIT_L(n) asm volatile("s_waitcnt lgkmcnt(" #n ")" ::: "memory")
#define PG8_BAR __builtin_amdgcn_s_barrier()
#define PG8_SCHED __builtin_amdgcn_sched_barrier(0)
    Unit cur, nxt; int ui = 0;
    if (!S.next(0, cur)) return;
    f32x4 acc[2][2][4][2];
#pragma unroll
    for (int a = 0; a < 2; ++a)
#pragma unroll
        for (int b = 0; b < 2; ++b)
#pragma unroll
            for (int m = 0; m < 4; ++m)
#pragma unroll
                for (int n = 0; n < 2; ++n) acc[a][b][m][n] = (f32x4){0.f, 0.f, 0.f, 0.f};
    bf16x8 At[4][2], B0[2][2], B1[2][2];
    const char* cA = (const char*)g.A + (size_t)cur.pm * tstepA; const char* cB = (const char*)g.Bt + (size_t)cur.pn * tstepB;
    S.a_ready(cur);
    PG8_STAGE(PG8_SB(0, 0), cB, voffB); PG8_STAGE(PG8_SB(0, 1), cB + hstepB, voffB); PG8_STAGE(PG8_SA(0, 0), cA, voffA); PG8_STAGE(PG8_SA(0, 1), cA + hstepA, voffA);
    if (wr == 1) PG8_BAR;
    PG8_WAIT_V(2); PG8_BAR;
    PG8_STAGE(PG8_SB(1, 0), cB + kstep, voffB); PG8_STAGE(PG8_SA(1, 0), cA + kstep, voffA); PG8_STAGE(PG8_SB(1, 1), cB + hstepB + kstep, voffB);
    PG8_WAIT_V(6); PG8_BAR;
    for (;;) {
        const bool has_next = S.next(ui + 1, nxt);
        const char* nA = has_next ? (const char*)g.A + (size_t)nxt.pm * tstepA : cA; const char* nB = has_next ? (const char*)g.Bt + (size_t)nxt.pn * tstepB : cB;
        for (int t = 0; t < nt; t += 2) {
            const bool last = (t == nt - 2);
            const char* a1 = cA + (size_t)(t + 1) * kstep;
            const char* a2 = last ? nA : cA + (size_t)(t + 2) * kstep; const char* b2 = last ? nB : cB + (size_t)(t + 2) * kstep;
            const char* a3 = a2 + kstep; const char* b3 = b2 + kstep;
            if (last && has_next) S.a_ready(nxt);
            PG8_LDB(B0, 0, 0); PG8_LDB(B1, 0, 1); PG8_SCHED; PG8_LDA(At, 0, 0); PG8_STAGE(PG8_SA(1, 1), a1 + hstepA, voffA);
            PG8_WAIT_V(8); PG8_WAIT_L(0); PG8_BAR; PG8_MMA(0, 0, At, B0); PG8_MMA(0, 1, At, B1); PG8_BAR; PG8_SCHED;
            PG8_LDA(At, 0, 1); PG8_STAGE(PG8_SB(0, 0), b2, voffB); PG8_STAGE(PG8_SB(0, 1), b2 + hstepB, voffB); PG8_STAGE(PG8_SA(0, 0), a2, voffA);
            PG8_WAIT_V(8); PG8_WAIT_L(0); PG8_BAR; PG8_MMA(1, 0, At, B0); PG8_MMA(1, 1, At, B1); PG8_BAR; PG8_SCHED;
            PG8_LDB(B0, 1, 0); PG8_LDB(B1, 1, 1); PG8_SCHED; PG8_LDA(At, 1, 0); PG8_STAGE(PG8_SA(0, 1), a2 + hstepA, voffA);
            PG8_WAIT_V(8); PG8_WAIT_L(0); PG8_BAR; PG8_MMA(0, 0, At, B0); PG8_MMA(0, 1, At, B1); PG8_BAR; PG8_SCHED;
            PG8_LDA(At, 1, 1); PG8_STAGE(PG8_SB(1, 0), b3, voffB); PG8_STAGE(PG8_SB(1, 1), b3 + hstepB, voffB); PG8_STAGE(PG8_SA(1, 0), a3, voffA);
            PG8_WAIT_V(8); PG8_WAIT_L(0); PG8_BAR; PG8_MMA(1, 0, At, B0); PG8_MMA(1, 1, At, B1); PG8_BAR; PG8_SCHED;
        }
        if constexpr (ALIGN_EPI) { if (wr == 0) PG8_BAR; }
        E(acc, cur, wr, wc, fr, fq);
        if (!has_next) break;
#pragma unroll
        for (int a = 0; a < 2; ++a)
#pragma unroll
            for (int b = 0; b < 2; ++b)
#pragma unroll
                for (int m = 0; m < 4; ++m)
#pragma unroll
                    for (int n = 0; n < 2; ++n) acc[a][b][m][n] = (f32x4){0.f, 0.f, 0.f, 0.f};
        cur = nxt; cA = nA; cB = nB; ++ui;
        if constexpr (ALIGN_EPI) { if (wr == 1) PG8_BAR; }
    }
    PG8_WAIT_V(0);
    if constexpr (!ALIGN_EPI) { if (wr == 0) PG8_BAR; }
    PG8_BAR;
#undef PG8_SA
#undef PG8_SB
#undef PG8_STAGE
#undef PG8_LDA
#undef PG8_LDB
#undef PG8_MMA
#undef PG8_WAIT_V
#undef PG8_WAIT_L
#undef PG8_BAR
#undef PG8_SCHED
}
}

#define XB_TMO      128
#define XB_XCNT(j)  (256  + 64 * (j))
#define XB_XSUB(j)  (1280 + 64 * (j))
#define XB_XGEN(j)  (2304 + 64 * (j))
#define XB_TOP      3328
#define XB_TOPGEN   3392
#define XCD_BAR_WORDS 3456
#define XB_SPIN_CAP (1u << 22)
__device__ __forceinline__ unsigned xb_ld(unsigned* p)              { return __hip_atomic_load(p, __ATOMIC_RELAXED, __HIP_MEMORY_SCOPE_AGENT); }
__device__ __forceinline__ unsigned xb_add(unsigned* p, unsigned v) { return __hip_atomic_fetch_add(p, v, __ATOMIC_RELAXED, __HIP_MEMORY_SCOPE_AGENT); }
__device__ __forceinline__ unsigned xb_xcc_id() { return (unsigned)__builtin_amdgcn_s_getreg((3 << 11) | 20) & 0xFu; }
#define XB_SPIN(cond, bar) do { unsigned _sp = 0; while (cond) { __builtin_amdgcn_s_sleep(8); \
    if ((++_sp & 255u) == 0u) { if (xb_ld(&(bar)[XB_TMO])) break; if (_sp > XB_SPIN_CAP) { atomicAdd(&(bar)[XB_TMO], 1u); break; } } } } while (0)
struct XcdBarrier { unsigned* bar; unsigned x; volatile LAS unsigned* st; unsigned G; };
__device__ __forceinline__ XcdBarrier xcd_barrier_post(unsigned* bar, volatile LAS unsigned* st) {
    XcdBarrier b; b.bar = bar; b.x = xb_xcc_id(); b.st = st; b.G = 0;
    if (threadIdx.x == 0) (void)xb_add(&bar[XB_XCNT(b.x)], 1u);
    return b;
}
__device__ __forceinline__ void xcd_barrier_complete(unsigned* bar, unsigned x, unsigned G, unsigned& nloc, unsigned& nx) {
    unsigned sum, cnt, mine, sp = 0u;
    for (;;) {
        sum = 0u; cnt = 0u; mine = 0u;
#pragma unroll
        for (unsigned j = 0; j < 16; ++j) { const unsigned c = xb_ld(&bar[XB_XCNT(j)]); sum += c; cnt += (c > 0u) ? 1u : 0u; mine = (j == x) ? c : mine; }
        if (sum == G) break;
        __builtin_amdgcn_s_sleep(1);
        if ((++sp & 255u) == 0u) { if (xb_ld(&bar[XB_TMO])) break; if (sp > XB_SPIN_CAP) { atomicAdd(&bar[XB_TMO], 1u); break; } }
    }
    nloc = mine > 0u ? mine : 1u; nx = cnt > 0u ? cnt : 1u;
}
__device__ __forceinline__ void xcd_barrier(const XcdBarrier& b) {
    asm volatile("s_waitcnt vmcnt(0)" ::: "memory");
    __syncthreads();
    if (threadIdx.x == 0) {
        unsigned* bar = b.bar;
        __builtin_amdgcn_s_waitcnt(0);
        unsigned nloc = b.st[0], nx = b.st[1];
        if (nloc == 0u) { xcd_barrier_complete(bar, b.x, b.G, nloc, nx); b.st[0] = nloc; b.st[1] = nx; }
        const unsigned old = xb_add(&bar[XB_XSUB(b.x)], 1u);
        const unsigned gen = old / nloc;
        if (old + 1u == (gen + 1u) * nloc) {
            __builtin_amdgcn_fence(__ATOMIC_RELEASE, "agent");
            asm volatile("s_waitcnt vmcnt(0)" ::: "memory");
            const unsigned og = xb_add(&bar[XB_TOP], 1u);
            const unsigned tg = og / nx;
            if (og + 1u == (tg + 1u) * nx) xb_add(&bar[XB_TOPGEN], 1u);
            else XB_SPIN(xb_ld(&bar[XB_TOPGEN]) == tg, bar);
            __builtin_amdgcn_fence(__ATOMIC_ACQUIRE, "agent");
            xb_add(&bar[XB_XGEN(b.x)], 1u);
            asm volatile("s_waitcnt vmcnt(0)" ::: "memory");
        } else {
            XB_SPIN(xb_ld(&bar[XB_XGEN(b.x)]) == gen, bar);
            __builtin_amdgcn_fence(__ATOMIC_ACQUIRE, "agent");
            asm volatile("s_waitcnt vmcnt(0)" ::: "memory");
        }
    }
    __syncthreads();
}

template <int MODE>
__device__ __forceinline__ void transpose_item(const float* __restrict__ W, int K, int Nsrc, bf16* __restrict__ WT, LAS float* scr, int kb, int nb, int lane, const float* __restrict__ gk) {
    const int k0 = 64 * kb, n0 = 32 * nb;
    const int dstc = n0 + (lane & 31);
    int srcc = dstc;
    if (MODE == 1) srcc = dstc < 3072 ? dstc : (dstc < 3088 ? dstc - 3072 + 4096 : (dstc < 3328 ? -1 : (dstc < 3840 ? dstc - 3328 + 5392 : (dstc < 9984 ? dstc - 3840 + 6416 : (dstc < 11008 ? dstc - 9984 + 3072 :
                          (dstc < 11520 ? dstc - 11008 + 4112 : (dstc < 11776 ? dstc - 11520 + 4624 : (dstc < 12288 ? dstc - 11776 + 4880 : dstc - 12288 + 5904))))))));
    const bool ok = srcc >= 0; const int sc = ok ? srcc : 0;
    const float* wp = W + (size_t)(k0 + (lane >> 5)) * Nsrc + sc;
    float v[32];
#pragma unroll
    for (int i = 0; i < 32; ++i) v[i] = wp[(size_t)(2 * i) * Nsrc];
    if (gk) { float gv[32];
#pragma unroll
        for (int i = 0; i < 32; ++i) gv[i] = gk[k0 + 2 * i + (lane >> 5)];
#pragma unroll
        for (int i = 0; i < 32; ++i) v[i] *= gv[i]; }
#pragma unroll
    for (int i = 0; i < 32; ++i) scr[(2 * i + (lane >> 5)) * 33 + (lane & 31)] = ok ? v[i] : 0.f;
    LDS_WAIT(); asm volatile("" ::: "memory");
    const int c = lane & 7;
#pragma unroll
    for (int j = 0; j < 4; ++j) { const int n = (lane >> 3) + 8 * j; const LAS float* s = scr + (8 * c) * 33 + n;
        u32x4 o; o.x = cvt_pk_bf16(s[0 * 33], s[1 * 33]); o.y = cvt_pk_bf16(s[2 * 33], s[3 * 33]); o.z = cvt_pk_bf16(s[4 * 33], s[5 * 33]); o.w = cvt_pk_bf16(s[6 * 33], s[7 * 33]);
        *(u32x4*)(WT + (size_t)(n0 + n) * K + k0 + 8 * c) = o; }
    LDS_WAIT(); asm volatile("" ::: "memory");
}
__device__ __forceinline__ void rms_row_bf16(const float* xrow, const float* g, bf16* orow, int lane) {
    const f32x4* xr = (const f32x4*)xrow + lane; f32x4 v[8]; float s = 0.f;
#pragma unroll
    for (int j = 0; j < 8; ++j) { v[j] = xr[64 * j]; s += (v[j].x * v[j].x + v[j].y * v[j].y) + (v[j].z * v[j].z + v[j].w * v[j].w); }
    const float rstd = rsqrtf(wave_sum(s) * (1.f / D_) + EPS_);
    const f32x4* gr = (const f32x4*)g + lane;
    u32x2* o8 = (u32x2*)orow + lane;
    f32x4 gq[8];
#pragma unroll
    for (int j = 0; j < 8; ++j) gq[j] = gr[64 * j];
#pragma unroll
    for (int j = 0; j < 8; ++j) { const f32x4 gv = gq[j]; u32x2 w; w.x = cvt_pk_bf16(v[j].x * rstd * gv.x, v[j].y * rstd * gv.y); w.y = cvt_pk_bf16(v[j].z * rstd * gv.z, v[j].w * rstd * gv.w); o8[64 * j] = w; }
}
__device__ __forceinline__ void rms_row_f32_inplace(float* xrow, const float* g, int lane) {
    f32x4* xr = (f32x4*)xrow + lane; f32x4 v[8]; float s = 0.f;
#pragma unroll
    for (int j = 0; j < 8; ++j) { v[j] = xr[64 * j]; s += (v[j].x * v[j].x + v[j].y * v[j].y) + (v[j].z * v[j].z + v[j].w * v[j].w); }
    const float rstd = rsqrtf(wave_sum(s) * (1.f / D_) + EPS_);
    const f32x4* gr = (const f32x4*)g + lane;
#pragma unroll
    for (int j = 0; j < 8; ++j) { const f32x4 gv = gr[64 * j]; xr[64 * j] = v[j] * rstd * gv; }
}
__device__ __forceinline__ float red16(float v) { v += __shfl_xor(v, 1); v += __shfl_xor(v, 2); v += __shfl_xor(v, 4); v += __shfl_xor(v, 8); return v; }

typedef float f32x16 __attribute__((ext_vector_type(16)));
typedef __bf16 bf2v __attribute__((ext_vector_type(2)));
__device__ __forceinline__ unsigned pk2(float lo, float hi) { const f32x2 v = {lo, hi}; return __builtin_bit_cast(unsigned, __builtin_convertvector(v, bf2v)); }
#define MFMA16(a, b, c) __builtin_amdgcn_mfma_f32_16x16x32_bf16((a), (b), (c), 0, 0, 0)
#define MFMA32(a, b, c) __builtin_amdgcn_mfma_f32_32x32x16_bf16((a), (b), (c), 0, 0, 0)
constexpr int DU_NKW = 0, DU_QP = 32768, DU_BM = 49152, DU_OP = 81920, DU_BYTES = 98304;
constexpr int P_K = 0, P_Q = 17408, P_QD = 34816, P_VBT = 52224, P_KBGT = 70656, P_KDT = 89088, P_TINV = 107520, P_QK = 116736, P_T11T = 125952, P_M1T = 128512, P_SM = 131072, P_CW = 131584, P_PS = 137728;
constexpr int LDK = 136, LDT = 72, LDL = 68, LDS40 = 40;
__device__ __forceinline__ void st_dev8(unsigned char* p, u32x2 v) { __hip_atomic_store((unsigned long long*)p, __builtin_bit_cast(unsigned long long, v), __ATOMIC_RELAXED, __HIP_MEMORY_SCOPE_AGENT); }
__device__ __forceinline__ bf16x8 ldfrag(const LAS bf16* mat, int ld, int row0, int k0, int fr, int fq) { return *(const LAS bf16x8*)(mat + (row0 + fr) * ld + k0 + 8 * fq); }

__device__ __forceinline__ void delta_prep_unit(LAS unsigned char* lds, const bf16* proj, const float* convw  , float a_log, float dt_bias, unsigned char* dst  , float* gl_out, bf16* opb,
                                                int t0, int hd, int tid_in, unsigned* prev_cnt  ) {
    const int tid = launder_v(tid_in);
    const int lane = tid & 63, wave = __builtin_amdgcn_readfirstlane(tid >> 6), fr = lane & 15, fq = lane >> 4;
    LAS bf16* Kk = (LAS bf16*)(lds + P_K); LAS bf16* Qq = (LAS bf16*)(lds + P_Q); LAS bf16* QD = (LAS bf16*)(lds + P_QD);
    LAS bf16* VBT = (LAS bf16*)(lds + P_VBT); LAS bf16* KBGT = (LAS bf16*)(lds + P_KBGT); LAS bf16* KDT = (LAS bf16*)(lds + P_KDT);
    LAS bf16* TINV = (LAS bf16*)(lds + P_TINV); LAS bf16* QK = (LAS bf16*)(lds + P_QK); LAS bf16* T11T = (LAS bf16*)(lds + P_T11T); LAS bf16* M1T = (LAS bf16*)(lds + P_M1T);
    LAS float* Lf = (LAS float*)(lds + P_Q); LAS float* gcs = (LAS float*)(lds + P_SM); LAS float* bts = gcs + 64;
    const float scale = 0.08838834764831845f;
    __syncthreads();
    if (wave == 0) {
        const float a = bf2f(proj[(size_t)(t0 + lane) * NPROJ + PC_A + hd]), b = bf2f(proj[(size_t)(t0 + lane) * NPROJ + PC_B + hd]);
        float g = -__expf(a_log) * softplusf_(a + dt_bias);
#pragma unroll
        for (int off = 1; off < 64; off <<= 1) { const float nb = __shfl_up(g, off); if (lane >= off) g += nb; }
        gcs[lane] = g; bts[lane] = sigmoidf_(b);
        if (lane == 63) __hip_atomic_store(gl_out, __expf(g), __ATOMIC_RELAXED, __HIP_MEMORY_SCOPE_AGENT);
    }
    LAS bf16* RAW = (LAS bf16*)lds;
    const LAS float* CW = (const LAS float*)(lds + P_CW);
    {
        u32x4 rv[7];
#pragma unroll
        for (int q7 = 0; q7 < 7; ++q7) { const int ci = tid + 512 * q7, r = ci / 48, cc = ci % 48, sec = cc >> 4, c8 = cc & 15; const int tt = t0 - 3 + r;
            rv[q7] = (u32x4){0u, 0u, 0u, 0u};
            if (ci < 67 * 48 && tt >= 0) rv[q7] = *(const u32x4*)(proj + (size_t)tt * NPROJ + sec * 1024 + hd * 128 + 8 * c8); }
#pragma unroll
        for (int q7 = 0; q7 < 7; ++q7) { const int ci = tid + 512 * q7, r = ci / 48, cc = ci % 48; if (ci < 67 * 48) *(LAS u32x4*)(RAW + r * 392 + 8 * cc) = rv[q7]; }
    }
    asm volatile("s_waitcnt vmcnt(0)" ::: "memory");
    __syncthreads();
    if (prev_cnt && tid == 0) { __builtin_amdgcn_fence(__ATOMIC_RELEASE, "workgroup"); (void)xb_add(prev_cnt, 1u); }
    const int tok = lane, js = wave;
    LAS float* PS = (LAS float*)(lds + P_PS);
    float qv[16], kv[16], vv[16];
#pragma unroll
    for (int sec = 0; sec < 3; ++sec) {
        float acc[16];
#pragma unroll
        for (int i = 0; i < 16; ++i) acc[i] = 0.f;
#pragma unroll
        for (int tap = 0; tap < 4; ++tap) {
            const LAS bf16* rp = RAW + (tok + tap) * 392 + sec * 128 + 16 * js;
            const u32x4 r0 = *(const LAS u32x4*)rp, r1 = *(const LAS u32x4*)(rp + 8);
            const LAS float* wp = CW + tap * 384 + sec * 128 + 16 * js;
            const f32x4 w0 = *(const LAS f32x4*)(wp), w1 = *(const LAS f32x4*)(wp + 4), w2 = *(const LAS f32x4*)(wp + 8), w3 = *(const LAS f32x4*)(wp + 12);
            acc[0] += w0.x * bf_lo(r0.x); acc[1] += w0.y * bf_hi(r0.x); acc[2] += w0.z * bf_lo(r0.y); acc[3] += w0.w * bf_hi(r0.y);
            acc[4] += w1.x * bf_lo(r0.z); acc[5] += w1.y * bf_hi(r0.z); acc[6] += w1.z * bf_lo(r0.w); acc[7] += w1.w * bf_hi(r0.w);
            acc[8] += w2.x * bf_lo(r1.x); acc[9] += w2.y * bf_hi(r1.x); acc[10] += w2.z * bf_lo(r1.y); acc[11] += w2.w * bf_hi(r1.y);
            acc[12] += w3.x * bf_lo(r1.z); acc[13] += w3.y * bf_hi(r1.z); acc[14] += w3.z * bf_lo(r1.w); acc[15] += w3.w * bf_hi(r1.w);
        }
        float ss = 0.f;
#pragma unroll
        for (int i = 0; i < 16; ++i) { acc[i] = siluf_(acc[i]); ss += acc[i] * acc[i]; }
        if (sec < 2) PS[(sec * 8 + js) * 64 + tok] = ss;
#pragma unroll
        for (int i = 0; i < 16; ++i) { if (sec == 0) qv[i] = acc[i]; else if (sec == 1) kv[i] = acc[i]; else vv[i] = acc[i]; }
    }
    __syncthreads();
    {
        const float gc = gcs[tok], bt = bts[tok], gclast = gcs[63];
        const float eg = __expf(gc), sq = scale * eg, ekd = __expf(gclast - gc), bkg = bt * eg;
        { float sq2 = 0.f, sk2 = 0.f;
#pragma unroll
          for (int w8 = 0; w8 < 8; ++w8) { sq2 += PS[w8 * 64 + tok]; sk2 += PS[(8 + w8) * 64 + tok]; }
          const float rq = rsqrtf(sq2 + EPS_), rk = rsqrtf(sk2 + EPS_);
#pragma unroll
          for (int i = 0; i < 16; ++i) { qv[i] *= rq; kv[i] *= rk; } }
        u32x4 w;
        LAS bf16* kr = Kk + tok * LDK + 16 * js; LAS bf16* qr = Qq + tok * LDK + 16 * js; LAS bf16* qdr = QD + tok * LDK + 16 * js;
        w.x = pk2(kv[0], kv[1]); w.y = pk2(kv[2], kv[3]); w.z = pk2(kv[4], kv[5]); w.w = pk2(kv[6], kv[7]); *(LAS u32x4*)kr = w;
        w.x = pk2(kv[8], kv[9]); w.y = pk2(kv[10], kv[11]); w.z = pk2(kv[12], kv[13]); w.w = pk2(kv[14], kv[15]); *(LAS u32x4*)(kr + 8) = w;
        w.x = pk2(qv[0], qv[1]); w.y = pk2(qv[2], qv[3]); w.z = pk2(qv[4], qv[5]); w.w = pk2(qv[6], qv[7]); *(LAS u32x4*)qr = w;
        w.x = pk2(qv[8], qv[9]); w.y = pk2(qv[10], qv[11]); w.z = pk2(qv[12], qv[13]); w.w = pk2(qv[14], qv[15]); *(LAS u32x4*)(qr + 8) = w;
        w.x = pk2(sq * qv[0], sq * qv[1]); w.y = pk2(sq * qv[2], sq * qv[3]); w.z = pk2(sq * qv[4], sq * qv[5]); w.w = pk2(sq * qv[6], sq * qv[7]); *(LAS u32x4*)qdr = w;
        w.x = pk2(sq * qv[8], sq * qv[9]); w.y = pk2(sq * qv[10], sq * qv[11]); w.z = pk2(sq * qv[12], sq * qv[13]); w.w = pk2(sq * qv[14], sq * qv[15]); *(LAS u32x4*)(qdr + 8) = w;
#pragma unroll
        for (int i = 0; i < 16; ++i) {
            const int c = 16 * js + i;
            VBT[c * LDT + tok] = (bf16)(pk2(bt * vv[i], 0.f) & 0xffffu);
            KBGT[c * LDT + tok] = (bf16)(pk2(bkg * kv[i], 0.f) & 0xffffu);
            KDT[c * LDT + tok] = (bf16)(pk2(ekd * kv[i], 0.f) & 0xffffu);
        }
    }
    __syncthreads();
    const f32x4 z4 = {0.f, 0.f, 0.f, 0.f};
#pragma unroll
    for (int rep = 0; rep < 2; ++rep) {
        const int id = wave + 8 * rep, it = id >> 2, jt = id & 3;
        const int i = 16 * it + fr, j0 = 16 * jt + 4 * fq;
        u32x2 o = {0u, 0u};
        if (it >= jt) {
            f32x4 acc = z4;
#pragma unroll
            for (int ks = 0; ks < 4; ++ks) acc = MFMA16(ldfrag(Kk, LDK, 16 * jt, 32 * ks, fr, fq), ldfrag(Qq, LDK, 16 * it, 32 * ks, fr, fq), acc);
            const float gi = gcs[i]; float v[4];
#pragma unroll
            for (int r = 0; r < 4; ++r) v[r] = (i >= j0 + r) ? scale * acc[r] * __expf(gi - gcs[j0 + r]) : 0.f;
            o.x = pk2(v[0], v[1]); o.y = pk2(v[2], v[3]);
        }
        *(LAS u32x2*)(QK + i * LDT + j0) = o;
    }
    __syncthreads();
#pragma unroll
    for (int rep = 0; rep < 2; ++rep) {
        const int id = wave + 8 * rep, it = id >> 2, jt = id & 3;
        const int i = 16 * it + fr, j0 = 16 * jt + 4 * fq;
        f32x4 v = z4;
        if (it >= jt) {
            f32x4 acc = z4;
#pragma unroll
            for (int ks = 0; ks < 4; ++ks) acc = MFMA16(ldfrag(Kk, LDK, 16 * jt, 32 * ks, fr, fq), ldfrag(Kk, LDK, 16 * it, 32 * ks, fr, fq), acc);
            const float gi = gcs[i], bi = bts[i];
#pragma unroll
            for (int r = 0; r < 4; ++r) v[r] = (i > j0 + r) ? bi * acc[r] * __expf(gi - gcs[j0 + r]) : 0.f;
        }
        *(LAS f32x4*)(Lf + i * LDL + j0) = v;
        if ((it >= 2) != (jt >= 2)) { u32x2 o; o.x = pk2(v[0], v[1]); o.y = pk2(v[2], v[3]); *(LAS u32x2*)(TINV + i * LDT + j0) = o; }
    }
    __syncthreads();
    if (wave < 2) {
        const int off = 32 * wave, c = lane & 31;
        float A[32];
#pragma unroll
        for (int i = 0; i < 32; ++i) {
            const float lrow = Lf[(off + i) * LDL + off + c];
            float a0 = -lrow, a1 = 0.f;
#pragma unroll
            for (int j = 0; j < i; ++j) { const float s = __uint_as_float(__builtin_amdgcn_readlane(__float_as_uint(lrow), j)); if (j & 1) a1 -= s * A[j]; else a0 -= s * A[j]; }
            A[i] = a0 + a1;
        }
        if (lane < 32) {
#pragma unroll
            for (int j = 0; j < 32; ++j) TINV[(off + j) * LDT + off + c] = (bf16)(pk2(A[j] + (j == c ? 1.f : 0.f), 0.f) & 0xffffu);
            if (wave == 0) {
#pragma unroll
                for (int j = 0; j < 32; j += 2) *(LAS unsigned*)(T11T + c * LDS40 + j) = pk2(A[j] + (j == c ? 1.f : 0.f), A[j + 1] + (j + 1 == c ? 1.f : 0.f));
            }
        }
    }
    __syncthreads();
    if (wave < 4) {
        const int mt = wave >> 1, nt = wave & 1;
        const f32x4 acc = MFMA16(ldfrag(TINV, LDT, 32 + 16 * mt, 0, fr, fq), ldfrag(T11T, LDS40, 16 * nt, 0, fr, fq), z4);
        u32x2 o; o.x = pk2(acc[0], acc[1]); o.y = pk2(acc[2], acc[3]);
        *(LAS u32x2*)(M1T + (16 * nt + fr) * LDS40 + 16 * mt + 4 * fq) = o;
    }
    __syncthreads();
    if (wave < 4) {
        const int itl = wave >> 1, ct = wave & 1;
        const f32x4 acc = MFMA16(ldfrag(M1T, LDS40, 16 * ct, 0, fr, fq), ldfrag(TINV + 32, LDT, 32 + 16 * itl, 0, fr, fq), z4);
        u32x2 o; o.x = pk2(-acc[0], -acc[1]); o.y = pk2(-acc[2], -acc[3]);
        *(LAS u32x2*)(TINV + (32 + 16 * itl + fr) * LDT + 16 * ct + 4 * fq) = o;
    }
    __syncthreads();
    {
        bf16x8 at[4][2];
#pragma unroll
        for (int mt = 0; mt < 4; ++mt)
#pragma unroll
            for (int ks = 0; ks < 2; ++ks) at[mt][ks] = ldfrag(TINV, LDT, 16 * mt, 32 * ks, fr, fq);
        bf16x8 bv[2], bk[2];
#pragma unroll
        for (int ks = 0; ks < 2; ++ks) { bv[ks] = ldfrag(VBT, LDT, 16 * wave, 32 * ks, fr, fq); bk[ks] = ldfrag(KBGT, LDT, 16 * wave, 32 * ks, fr, fq); }
        f32x4 au[4], aw[4];
#pragma unroll
        for (int mt = 0; mt < 4; ++mt) { au[mt] = z4; aw[mt] = z4;
#pragma unroll
            for (int ks = 0; ks < 2; ++ks) { au[mt] = MFMA16(at[mt][ks], bv[ks], au[mt]); aw[mt] = MFMA16(at[mt][ks], bk[ks], aw[mt]); } }
#pragma unroll
        for (int mt = 0; mt < 4; ++mt) {
            u32x2 o; o.x = pk2(au[mt][0], au[mt][1]); o.y = pk2(au[mt][2], au[mt][3]); *(LAS u32x2*)(VBT + (16 * wave + fr) * LDT + 16 * mt + 4 * fq) = o;
            o.x = pk2(aw[mt][0], aw[mt][1]); o.y = pk2(aw[mt][2], aw[mt][3]); *(LAS u32x2*)(KBGT + (16 * wave + fr) * LDT + 16 * mt + 4 * fq) = o;
        }
    }
    __syncthreads();
    LAS bf16* UT = VBT; LAS bf16* WT = KBGT;
    {
        bf16x8 kd[2];
#pragma unroll
        for (int ks = 0; ks < 2; ++ks) kd[ks] = ldfrag(KDT, LDT, 16 * wave, 32 * ks, fr, fq);
#pragma unroll 2
        for (int nt = 0; nt < 8; ++nt) {
            f32x4 an = z4, ab = z4;
#pragma unroll
            for (int ks = 0; ks < 2; ++ks) { an = MFMA16(ldfrag(WT, LDT, 16 * nt, 32 * ks, fr, fq), kd[ks], an); ab = MFMA16(kd[ks], ldfrag(UT, LDT, 16 * nt, 32 * ks, fr, fq), ab); }
            { const int m = 16 * wave + fr; u32x2 o; o.x = pk2(-an[0], -an[1]); o.y = pk2(-an[2], -an[3]);
              st_dev8(dst + DU_NKW + ((((m >> 5) * 8 + nt) * 64 + (m & 31) + 32 * (fq & 1)) * 16) + 8 * (fq >> 1), o); }
            { const int dv = 16 * nt + fr, d = 16 * wave + 4 * fq, rr = d & 31; u32x2 o; o.x = pk2(ab[0], ab[1]); o.y = pk2(ab[2], ab[3]);
              st_dev8(dst + DU_BM + (((((dv >> 5) * 4 + (d >> 5)) * 64 + (dv & 31) + 32 * ((rr >> 2) & 1)) * 16 + 4 * (rr >> 3)) * 2), o); }
        }
    }
    {
        bf16x8 wt[2], ut[2];
#pragma unroll
        for (int ks = 0; ks < 2; ++ks) { wt[ks] = ldfrag(WT, LDT, 16 * wave, 32 * ks, fr, fq); ut[ks] = ldfrag(UT, LDT, 16 * wave, 32 * ks, fr, fq); }
#pragma unroll 2
        for (int it = 0; it < 4; ++it) {
            f32x4 aq = z4, ao = z4;
#pragma unroll
            for (int ks = 0; ks < 2; ++ks) { const bf16x8 qf = ldfrag(QK, LDT, 16 * it, 32 * ks, fr, fq); aq = MFMA16(wt[ks], qf, aq); ao = MFMA16(ut[ks], qf, ao); }
            { const int i = 16 * it + fr; const u32x2 qd = *(const LAS u32x2*)(QD + i * LDK + 16 * wave + 4 * fq);
              u32x2 o; o.x = pk2(bf_lo(qd.x) - aq[0], bf_hi(qd.x) - aq[1]); o.y = pk2(bf_lo(qd.y) - aq[2], bf_hi(qd.y) - aq[3]);
              st_dev8(dst + DU_QP + ((((i >> 5) * 8 + wave) * 64 + (i & 31) + 32 * (fq & 1)) * 16) + 8 * (fq >> 1), o); }
            { u32x2 o; o.x = pk2(ao[0], ao[1]); o.y = pk2(ao[2], ao[3]); *(u32x2*)(opb + (size_t)(t0 + 16 * it + fr) * 1024 + hd * 128 + 16 * wave + 4 * fq) = o; }
        }
    }
}

__device__ __forceinline__ void delta_scan_head(LAS unsigned char* lds, const unsigned char* dprep  , const float* gl, bf16* oraw, int hd, int tid, unsigned* blk_cnt  , unsigned* tmo) {
    const int lane = tid & 63, wave = __builtin_amdgcn_readfirstlane(tid >> 6);
    constexpr int NCH = S_ / 64, SLOT = 49152, OBUF = 3 * SLOT;
    const unsigned char* ub = dprep + (size_t)hd * (S_ / 64) * DU_BYTES;
    constexpr size_t CSTEP = (size_t)DU_BYTES;
    volatile LAS unsigned* MISCW = (volatile LAS unsigned*)(lds + MISC_OFF);
    __syncthreads();
    const unsigned sv0 = MISCW[8], sv1 = MISCW[9], sv2 = MISCW[10], sv3 = MISCW[11];
#define SCAN_BLOCK_READY(b_) do { XB_SPIN(xb_ld(blk_cnt + (b_)) < 32u, tmo); __builtin_amdgcn_fence(__ATOMIC_ACQUIRE, "agent"); asm volatile("s_waitcnt vmcnt(0)" ::: "memory"); } while (0)
    if (tid == 0) SCAN_BLOCK_READY(0);
    __syncthreads();
#define SCAN_STAGE(n_, slot_) do { const unsigned char* src_ = ub + (size_t)(n_) * CSTEP + lane * 16; \
        _Pragma("unroll") for (int q_ = 0; q_ < 24; ++q_) { const int idx_ = (wave - 4) + 2 * q_; \
            __builtin_amdgcn_global_load_lds((const unsigned*)(src_ + idx_ * 1024), (LAS unsigned*)(lds + (slot_) * SLOT + idx_ * 1024), 16, 0, 0); } } while (0)
#define SCAN_FLUSH(n_) do { const int v_ = wave - 6; u32x4 t_[8]; \
        _Pragma("unroll") for (int i_ = 0; i_ < 8; ++i_) { const int tok_ = 32 * v_ + 4 * i_ + (lane >> 4), ck_ = (lane & 15) ^ (tok_ & 15); t_[i_] = *(const LAS u32x4*)(lds + OBUF + tok_ * 256 + ck_ * 16); } \
        _Pragma("unroll") for (int i_ = 0; i_ < 8; ++i_) { const int tok_ = 32 * v_ + 4 * i_ + (lane >> 4); *(u32x4*)(oraw + (size_t)(64 * (n_) + tok_) * 1024 + hd * 128 + 8 * (lane & 15)) = t_[i_]; } } while (0)
    if (wave >= 6) {
        __builtin_amdgcn_s_barrier(); asm volatile("" ::: "memory");
#pragma unroll 1
        for (int n = 0; n < NCH; ++n) {
            if (n > 0) SCAN_FLUSH(n - 1);
            asm volatile("s_waitcnt lgkmcnt(0)" ::: "memory");
            __builtin_amdgcn_s_barrier(); asm volatile("" ::: "memory");
            __builtin_amdgcn_s_barrier(); asm volatile("" ::: "memory");
        }
        SCAN_FLUSH(NCH - 1);
    } else if (wave >= 4) {
        SCAN_STAGE(0, 0); SCAN_STAGE(1, 1);
        asm volatile("s_waitcnt vmcnt(24)" ::: "memory");
        __builtin_amdgcn_s_barrier(); asm volatile("" ::: "memory");
#pragma unroll 1
        for (int n = 0; n < NCH; ++n) {
            if (((n + 3) & 31) == 0 && n + 3 < NCH) SCAN_BLOCK_READY((n + 3) >> 5);
            if (n + 2 < NCH) { SCAN_STAGE(n + 2, (n + 2) % 3); asm volatile("s_waitcnt vmcnt(24)" ::: "memory"); }
            else asm volatile("s_waitcnt vmcnt(0)" ::: "memory");
            __builtin_amdgcn_s_barrier(); asm volatile("" ::: "memory");
            __builtin_amdgcn_s_barrier(); asm volatile("" ::: "memory");
        }
    } else {
        f32x16 Sacc[4];
#pragma unroll
        for (int mt = 0; mt < 4; ++mt)
#pragma unroll
            for (int r = 0; r < 16; ++r) Sacc[mt][r] = 0.f;
        u32x4 bc[16];
        float gq2[2];
#pragma unroll
        for (int par = 0; par < 2; ++par) {
            const u32x4* bp = (const u32x4*)(ub + (size_t)par * CSTEP + DU_BM + (size_t)(wave * 4 * 64 + lane) * 32);
#pragma unroll
            for (int mt = 0; mt < 4; ++mt) { bc[8 * par + 2 * mt] = bp[mt * 128]; bc[8 * par + 2 * mt + 1] = bp[mt * 128 + 1]; }
            gq2[par] = gl[par * 8 + hd];
        }
        asm volatile("" ::: "memory");
        __builtin_amdgcn_s_barrier(); asm volatile("" ::: "memory");
#pragma unroll 1
        for (int n2 = 0; n2 < NCH; n2 += 2) {
#pragma unroll
          for (int par = 0; par < 2; ++par) {
            const int n = n2 + par;
            const int slot = n % 3;
            const float g = gq2[par];
            bf16x8 Sb[8];
#define SCAN_PACK(k_) do { constexpr int mt_ = (k_) >> 1, s_ = (k_) & 1; u32x4 p_; p_.x = pk2(Sacc[mt_][8 * s_], Sacc[mt_][8 * s_ + 1]); p_.y = pk2(Sacc[mt_][8 * s_ + 2], Sacc[mt_][8 * s_ + 3]); \
                p_.z = pk2(Sacc[mt_][8 * s_ + 4], Sacc[mt_][8 * s_ + 5]); p_.w = pk2(Sacc[mt_][8 * s_ + 6], Sacc[mt_][8 * s_ + 7]); Sb[k_] = __builtin_bit_cast(bf16x8, p_); } while (0)
#define SCAN_CINIT(h_) do { const int p_ = (h_) >> 1, mt_ = p_ >> 1, h2_ = p_ & 1, hf_ = (h_) & 1, e_ = 8 * h2_ + 4 * hf_; const u32x4 b_ = bc[8 * par + 2 * mt_ + h2_]; const unsigned w0_ = hf_ ? b_.z : b_.x, w1_ = hf_ ? b_.w : b_.y; \
                Sacc[mt_][e_ + 0] = g * Sacc[mt_][e_ + 0] + bf_lo(w0_); Sacc[mt_][e_ + 1] = g * Sacc[mt_][e_ + 1] + bf_hi(w0_); \
                Sacc[mt_][e_ + 2] = g * Sacc[mt_][e_ + 2] + bf_lo(w1_); Sacc[mt_][e_ + 3] = g * Sacc[mt_][e_ + 3] + bf_hi(w1_); } while (0)
            SCAN_PACK(0); SCAN_PACK(1); SCAN_PACK(2); SCAN_PACK(3);
            const LAS bf16x8* fr0 = (const LAS bf16x8*)(lds + slot * SLOT + lane * 16);
            constexpr int PD = 4;
            bf16x8 fa[PD];
#define SCAN_FIDX(f_) (((f_) < 16) ? 32 + (f_) : (f_) - 16)
#pragma unroll
            for (int i = 0; i < PD; ++i) fa[i] = fr0[SCAN_FIDX(i) * 64];
            const int nn = (n + 2 < NCH) ? n + 2 : n;
            const u32x4* bpn = (const u32x4*)(ub + (size_t)nn * CSTEP + DU_BM + (size_t)(wave * 4 * 64 + lane) * 32);
            gq2[par] = gl[nn * 8 + hd];
            f32x16 oacc[2];
            __builtin_amdgcn_sched_barrier(0);
#pragma unroll
            for (int f = 0; f < 16; ++f) {
                const bf16x8 a = fa[f % PD];
                fa[f % PD] = fr0[SCAN_FIDX(f + PD) * 64];
                if ((f & 7) == 0) { f32x16 z16;
#pragma unroll
                    for (int r = 0; r < 16; ++r) z16[r] = 0.f;
                    oacc[f >> 3] = MFMA32(Sb[f & 7], a, z16); }
                else oacc[f >> 3] = MFMA32(Sb[f & 7], a, oacc[f >> 3]);
                if (f == 0) SCAN_PACK(4); if (f == 2) SCAN_PACK(5); if (f == 4) SCAN_PACK(6); if (f == 6) SCAN_PACK(7);
                SCAN_CINIT(f);
                if ((f & 3) == 3) { bc[8 * par + 2 * (f >> 2)] = bpn[(f >> 2) * 128]; bc[8 * par + 2 * (f >> 2) + 1] = bpn[(f >> 2) * 128 + 1]; }
                __builtin_amdgcn_sched_barrier(0);
            }
#pragma unroll
            for (int f = 16; f < 48; ++f) {
                const bf16x8 a = fa[f % PD];
                if (f + PD < 48) fa[f % PD] = fr0[SCAN_FIDX(f + PD) * 64];
                Sacc[(f - 16) >> 3] = MFMA32(a, Sb[f & 7], Sacc[(f - 16) >> 3]);
            }
#undef SCAN_FIDX
#undef SCAN_PACK
#undef SCAN_CINIT
#pragma unroll
            for (int f = 16; f < 48 - PD; ++f) { __builtin_amdgcn_sched_group_barrier(0x008, 1, 0); __builtin_amdgcn_sched_group_barrier(0x100, 1, 0); }
            __builtin_amdgcn_sched_group_barrier(0x008, PD, 0);
            asm volatile("s_waitcnt lgkmcnt(0)" ::: "memory");
            __builtin_amdgcn_s_barrier(); asm volatile("" ::: "memory");
#pragma unroll
            for (int mt = 0; mt < 2; ++mt) { const int tok = 32 * mt + (lane & 31);
#pragma unroll
                for (int gq = 0; gq < 4; ++gq) { u32x2 w; w.x = pk2(oacc[mt][4 * gq], oacc[mt][4 * gq + 1]); w.y = pk2(oacc[mt][4 * gq + 2], oacc[mt][4 * gq + 3]);
                    *(LAS u32x2*)(lds + OBUF + tok * 256 + (((4 * wave + gq) ^ (tok & 15)) * 16) + 8 * (lane >> 5)) = w; } }
            asm volatile("s_waitcnt lgkmcnt(0)" ::: "memory");
            __builtin_amdgcn_s_barrier(); asm volatile("" ::: "memory");
          }
        }
    }
    __syncthreads();
    if (tid == 0) { MISCW[8] = sv0; MISCW[9] = sv1; MISCW[10] = sv2; MISCW[11] = sv3; }
    __syncthreads();
#undef SCAN_STAGE
#undef SCAN_FLUSH
#undef SCAN_BLOCK_READY
}

__device__ __forceinline__ int vt_pos(int key) { const int kk = key & 15; return (key & ~15) + 8 * ((kk >> 2) & 1) + 4 * (kk >> 3) + (kk & 3); }
template <int DH, int NKEYS>
__device__ __forceinline__ void stage_k(LAS bf16* Kl, const bf16* __restrict__ src, int gld, int kbase, int tid, bool zero) {
    constexpr int CPR = DH / 8, NIT = NKEYS * CPR / 512;
    u32x4 v[NIT];
#pragma unroll
    for (int it = 0; it < NIT; ++it) { const int ci = tid + 512 * it, r = ci / CPR, c = ci % CPR; const unsigned z0 = (unsigned)launder_v(0); v[it] = (u32x4){z0, z0, z0, z0}; if (!zero) v[it] = *(const u32x4*)(src + (size_t)r * gld + 8 * c); }
#pragma unroll
    for (int it = 0; it < NIT; ++it) { const int ci = tid + 512 * it, r = ci / CPR, c = ci % CPR; *(LAS u32x4*)(Kl + (kbase + r) * (DH + 8) + 8 * c) = v[it]; }
}
template <int DH, int NKEYS>
__device__ __forceinline__ void stage_vt(LAS bf16* Vt, int ldv, const bf16* __restrict__ src, int gld, int kbase, int tid, bool zero) {
    constexpr int CPR = DH / 8, NIT = NKEYS * CPR / 512;
    u32x4 v[NIT];
#pragma unroll
    for (int it = 0; it < NIT; ++it) { const int ci = tid + 512 * it, r = ci % NKEYS, c = ci / NKEYS; const unsigned z0 = (unsigned)launder_v(0); v[it] = (u32x4){z0, z0, z0, z0}; if (!zero) v[it] = *(const u32x4*)(src + (size_t)r * gld + 8 * c); }
#pragma unroll
    for (int it = 0; it < NIT; ++it) { const int ci = tid + 512 * it, r = ci % NKEYS, c = ci / NKEYS;
        LAS bf16* d = Vt + (8 * c) * ldv + vt_pos(kbase + r); const u32x4 w = v[it];
        d[0] = (bf16)(w.x & 0xffffu); d[ldv] = (bf16)(w.x >> 16); d[2 * ldv] = (bf16)(w.y & 0xffffu); d[3 * ldv] = (bf16)(w.y >> 16);
        d[4 * ldv] = (bf16)(w.z & 0xffffu); d[5 * ldv] = (bf16)(w.z >> 16); d[6 * ldv] = (bf16)(w.w & 0xffffu); d[7 * ldv] = (bf16)(w.w >> 16); }
}
template <int DH>
__device__ __forceinline__ void stage_k_loop(LAS bf16* Kl, const bf16* src, int gld, int nkeys, int kbase, int tid) {
    constexpr int CPR = DH / 8;
    for (int ci = tid; ci < nkeys * CPR; ci += 512) { const int r = ci / CPR, c = ci % CPR;
        const u32x4 v = *(const u32x4*)(src + (size_t)r * gld + 8 * c);
        *(LAS u32x4*)(Kl + (kbase + r) * (DH + 8) + 8 * c) = v; }
}
template <int DH>
__device__ __forceinline__ void stage_vt_loop(LAS bf16* Vt, int ldv, const bf16* src, int gld, int nkeys, int kbase, int tid) {
    constexpr int CPR = DH / 8;
    for (int ci = tid; ci < nkeys * CPR; ci += 512) { const int r = ci % nkeys, c = ci / nkeys;
        const u32x4 v = *(const u32x4*)(src + (size_t)r * gld + 8 * c);
        LAS bf16* d = Vt + (8 * c) * ldv + vt_pos(kbase + r);
        d[0] = (bf16)(v.x & 0xffffu); d[ldv] = (bf16)(v.x >> 16); d[2 * ldv] = (bf16)(v.y & 0xffffu); d[3 * ldv] = (bf16)(v.y >> 16);
        d[4 * ldv] = (bf16)(v.z & 0xffffu); d[5 * ldv] = (bf16)(v.z >> 16); d[6 * ldv] = (bf16)(v.w & 0xffffu); d[7 * ldv] = (bf16)(v.w >> 16); }
}
__device__ __forceinline__ bf16x8 pack8(const f32x16& x, int s) {
    u32x4 p; p.x = pk2(x[8 * s], x[8 * s + 1]); p.y = pk2(x[8 * s + 2], x[8 * s + 3]); p.z = pk2(x[8 * s + 4], x[8 * s + 5]); p.w = pk2(x[8 * s + 6], x[8 * s + 7]);
    return __builtin_bit_cast(bf16x8, p);
}
__device__ __forceinline__ int crow16(int reg, int h) { return (reg & 3) + 8 * (reg >> 2) + 4 * h; }
__device__ __forceinline__ void store_ot(bf16* orow  , const f32x16& o, float inv, int h) {
#pragma unroll
    for (int g = 0; g < 4; ++g) { u32x2 w; w.x = pk2(o[4 * g] * inv, o[4 * g + 1] * inv); w.y = pk2(o[4 * g + 2] * inv, o[4 * g + 3] * inv); *(u32x2*)(orow + 8 * g + 4 * h) = w; }
}

__device__ __forceinline__ void swa_unit(LAS unsigned char* lds, const bf16* proj, const float* sinks, bf16* y, int kvh, int b, int tid) {
    const int lane = tid & 63, wave = __builtin_amdgcn_readfirstlane(tid >> 6), c = lane & 31, h = lane >> 5;
    LAS bf16* Kl = (LAS bf16*)lds;
    LAS bf16* Vt = (LAS bf16*)(lds + 36864);
    constexpr int LDV = 264;
    __syncthreads();
    const bf16* kg = proj + PC_SWAK + kvh * 64; const bf16* vg = proj + PC_SWAV + kvh * 64;
    if (b > 0) { stage_k<64, 256>(Kl, kg + (size_t)(128 * (b - 1)) * NPROJ, NPROJ, 0, tid, false); stage_vt<64, 256>(Vt, LDV, vg + (size_t)(128 * (b - 1)) * NPROJ, NPROJ, 0, tid, false); }
    else { stage_k<64, 128>(Kl, kg, NPROJ, 0, tid, true); stage_vt<64, 128>(Vt, LDV, vg, NPROJ, 0, tid, true);
           stage_k<64, 128>(Kl, kg, NPROJ, 128, tid, false); stage_vt<64, 128>(Vt, LDV, vg, NPROJ, 128, tid, false); }
    __syncthreads();
#pragma unroll 1
    for (int rep = 0; rep < 2; ++rep) {
        const int id = wave + 8 * rep, qh = id >> 2, qo = 32 * (id & 3), hg = 4 * kvh + qh;
        const int cL = launder_v(c), hL = launder_v(h);
        const int t = 128 * b + qo + c;
        const float slope = exp2f(-(float)(hg + 1)), sink = sinks[hg];
        bf16x8 qf[4];
#pragma unroll
        for (int ks = 0; ks < 4; ++ks) qf[ks] = *(const bf16x8*)(proj + (size_t)t * NPROJ + PC_SWAQ + hg * 64 + 16 * ks + 8 * h);
        f32x16 sc[5];
        const int kt0 = qo >> 5;
        float mx = -INFINITY;
#pragma unroll
        for (int j5 = 0; j5 < 5; ++j5) {
            const int kt = kt0 + j5;
            f32x16 acc;
#pragma unroll
            for (int r = 0; r < 16; ++r) acc[r] = 0.f;
#pragma unroll
            for (int ks = 0; ks < 4; ++ks) acc = MFMA32(*(const LAS bf16x8*)(Kl + (32 * kt + c) * 72 + 16 * ks + 8 * h), qf[ks], acc);
            const int dbase = launder_v(cL + 128 - 32 * j5 - 4 * hL);
#pragma unroll
            for (int r = 0; r < 16; ++r) { const int dist = dbase - ((r & 3) + 8 * (r >> 2)); const int kl = qo + cL + 128 - dist;
                const bool valid = (dist >= 0) && (dist < 128) && (b > 0 || kl >= 128);
                const float s = valid ? acc[r] * 0.125f - slope * (float)dist : -INFINITY; acc[r] = s; mx = fmaxf(mx, s); }
            sc[j5] = acc;
        }
        mx = fmaxf(mx, __shfl_xor(mx, 32)); mx = fmaxf(mx, sink);
        float sum = 0.f;
#pragma unroll
        for (int j5 = 0; j5 < 5; ++j5)
#pragma unroll
            for (int r = 0; r < 16; ++r) { const float p = __expf(sc[j5][r] - mx); sc[j5][r] = p; sum += p; }
        sum += __shfl_xor(sum, 32); sum += __expf(sink - mx);
        f32x16 o[2];
#pragma unroll
        for (int mt = 0; mt < 2; ++mt)
#pragma unroll
            for (int r = 0; r < 16; ++r) o[mt][r] = 0.f;
#pragma unroll
        for (int j5 = 0; j5 < 5; ++j5)
#pragma unroll
            for (int s = 0; s < 2; ++s) { const bf16x8 pf = pack8(sc[j5], s); const int kstep = 2 * (kt0 + j5) + s;
#pragma unroll
                for (int mt = 0; mt < 2; ++mt) o[mt] = MFMA32(*(const LAS bf16x8*)(Vt + (32 * mt + c) * LDV + 16 * kstep + 8 * h), pf, o[mt]); }
        const float inv = 1.f / sum;
#pragma unroll
        for (int mt = 0; mt < 2; ++mt) store_ot(y + (size_t)t * 2048 + 1024 + hg * 64 + 32 * mt, o[mt], inv, h);
    }
}

__device__ __forceinline__ void xattn_unit(LAS unsigned char* lds, const bf16* xq, const bf16* kv  , bf16* xo, int hd, int qb, int tid) {
    const int lane = tid & 63, wave = __builtin_amdgcn_readfirstlane(tid >> 6), c = lane & 31, h = lane >> 5;
    LAS bf16* Kl = (LAS bf16*)lds;
    LAS bf16* Vt = (LAS bf16*)(lds + 69632);
    constexpr int LDV = 264;
    const float scale = 0.08838834764831845f;
    __syncthreads();
    stage_k<128, 128>(Kl, kv + hd * 128, 1024, 0, tid, false); stage_vt<128, 128>(Vt, LDV, kv + 512 + hd * 128, 1024, 0, tid, false);
    stage_k<128, 128>(Kl, kv + (size_t)128 * 1024 + hd * 128, 1024, 128, tid, false); stage_vt<128, 128>(Vt, LDV, kv + (size_t)128 * 1024 + 512 + hd * 128, 1024, 128, tid, false);
    __syncthreads();
    const int t = 256 * qb + 32 * wave + c;
    bf16x8 qf[8];
#pragma unroll
    for (int ks = 0; ks < 8; ++ks) qf[ks] = *(const bf16x8*)(xq + (size_t)t * 512 + hd * 128 + 16 * ks + 8 * h);
    f32x16 o[4];
#pragma unroll
    for (int mt = 0; mt < 4; ++mt)
#pragma unroll
        for (int r = 0; r < 16; ++r) o[mt][r] = 0.f;
    float mrun = -INFINITY, sum = 0.f;
#pragma unroll 1
    for (int half = 0; half < 2; ++half) {
        f32x16 sc[4]; float mx = -INFINITY;
#pragma unroll
        for (int j4 = 0; j4 < 4; ++j4) { const int kt = 4 * half + j4; f32x16 acc;
#pragma unroll
            for (int r = 0; r < 16; ++r) acc[r] = 0.f;
#pragma unroll
            for (int ks = 0; ks < 8; ++ks) acc = MFMA32(*(const LAS bf16x8*)(Kl + (32 * kt + c) * 136 + 16 * ks + 8 * h), qf[ks], acc);
#pragma unroll
            for (int r = 0; r < 16; ++r) { acc[r] *= scale; mx = fmaxf(mx, acc[r]); }
            sc[j4] = acc; }
        mx = fmaxf(mx, __shfl_xor(mx, 32));
        const float mnew = fmaxf(mrun, mx), resc = __expf(mrun - mnew);
        float ps = 0.f;
#pragma unroll
        for (int j4 = 0; j4 < 4; ++j4)
#pragma unroll
            for (int r = 0; r < 16; ++r) { const float p = __expf(sc[j4][r] - mnew); sc[j4][r] = p; ps += p; }
        ps += __shfl_xor(ps, 32);
        sum = sum * resc + ps; mrun = mnew;
#pragma unroll
        for (int mt = 0; mt < 4; ++mt)
#pragma unroll
            for (int r = 0; r < 16; ++r) o[mt][r] *= resc;
#pragma unroll
        for (int j4 = 0; j4 < 4; ++j4)
#pragma unroll
            for (int s = 0; s < 2; ++s) { const bf16x8 pf = pack8(sc[j4], s); const int kstep = 2 * (4 * half + j4) + s;
#pragma unroll
                for (int mt = 0; mt < 4; ++mt) o[mt] = MFMA32(*(const LAS bf16x8*)(Vt + (32 * mt + c) * LDV + 16 * kstep + 8 * h), pf, o[mt]); }
    }
    const float inv = 1.f / sum;
#pragma unroll
    for (int mt = 0; mt < 4; ++mt) store_ot(xo + (size_t)t * 512 + hd * 128 + 32 * mt, o[mt], inv, h);
}

__device__ __forceinline__ void sb_unit(LAS unsigned char* lds, const bf16* proj, float kmax2, bf16* y, int hd, int qb, int tid) {
    const int lane = tid & 63, wave = __builtin_amdgcn_readfirstlane(tid >> 6), c = lane & 31, h = lane >> 5;
    LAS bf16* Kl = (LAS bf16*)lds;
    LAS bf16* Vt = (LAS bf16*)(lds + 34816);
    LAS unsigned* flags = (LAS unsigned*)(lds + 69632);
    constexpr int LDV = 136;
    const float scale = 0.08838834764831845f;
    const int t = 256 * qb + 32 * wave + c;
    bf16x8 qf[8]; float qq = 0.f;
#pragma unroll
    for (int ks = 0; ks < 8; ++ks) { const u32x4 w = *(const u32x4*)(proj + (size_t)t * NPROJ + PC_SBQ + hd * 128 + 16 * ks + 8 * h); qq += dot8(w, w); qf[ks] = __builtin_bit_cast(bf16x8, w); }
    qq += __shfl_xor(qq, 32);
    const float zb = sqrtf(qq * kmax2) * scale;
    f32x16 o[4];
#pragma unroll
    for (int mt = 0; mt < 4; ++mt)
#pragma unroll
        for (int r = 0; r < 16; ++r) o[mt][r] = 0.f;
    float carry = 0.f; bool wdone = false;
    const int tmax = 256 * qb + 32 * wave + 31;
#pragma unroll 1
    for (int kb = 2 * qb + 1; kb >= 0; --kb) {
        __syncthreads();
        stage_k_loop<128>(Kl, proj + (size_t)(128 * kb) * NPROJ + PC_SBK + hd * 128, NPROJ, 128, 0, tid);
        stage_vt_loop<128>(Vt, LDV, proj + (size_t)(128 * kb) * NPROJ + PC_SBV + hd * 128, NPROJ, 128, 0, tid);
        __syncthreads();
        if (!wdone && 128 * kb < tmax) {
#pragma unroll 1
            for (int kt = 3; kt >= 0; --kt) {
                const int key0 = 128 * kb + 32 * kt;
                if (key0 >= tmax) continue;
                const int trel = launder_v(t - key0 - 4 * h);
                f32x16 acc;
#pragma unroll
                for (int r = 0; r < 16; ++r) acc[r] = 0.f;
#pragma unroll
                for (int ks = 0; ks < 8; ++ks) acc = MFMA32(*(const LAS bf16x8*)(Kl + (32 * kt + c) * 136 + 16 * ks + 8 * h), qf[ks], acc);
                float lg[16], gso[4], gst[4];
#pragma unroll
                for (int g = 0; g < 4; ++g) { float s = 0.f;
#pragma unroll
                    for (int r = 0; r < 4; ++r) { const int reg = 4 * g + r; const bool valid = (r + 8 * g) < trel; const float z = acc[reg] * scale; acc[reg] = z;
                        const float l = valid ? -(fmaxf(z, 0.f) + __logf(1.f + __expf(-fabsf(z)))) : 0.f; lg[reg] = l; s += l; }
                    gso[g] = s; const float oth = __shfl_xor(s, 32); gst[g] = (h == 0) ? oth : 0.f; gso[g] = s + oth; }
                float suf = carry;
#pragma unroll
                for (int g = 3; g >= 0; --g) { float R = suf + gst[g];
#pragma unroll
                    for (int r = 3; r >= 0; --r) { const int reg = 4 * g + r; R += lg[reg]; const bool valid = (r + 8 * g) < trel; acc[reg] = valid ? __expf(acc[reg] + R) : 0.f; }
                    suf += gso[g]; }
                carry = suf;
#pragma unroll
                for (int s = 0; s < 2; ++s) { const bf16x8 pf = pack8(acc, s); const int kstep = 2 * kt + s;
#pragma unroll
                    for (int mt = 0; mt < 4; ++mt) o[mt] = MFMA32(*(const LAS bf16x8*)(Vt + (32 * mt + c) * LDV + 16 * kstep + 8 * h), pf, o[mt]); }
            }
            wdone = __all(carry + zb < -110.f);
        }
        if (lane == 0) flags[wave] = (wdone || kb == 0) ? 0u : 1u;
        LDS_WAIT();
        __syncthreads();
        unsigned any = 0u;
#pragma unroll
        for (int w8 = 0; w8 < 8; ++w8) any |= flags[w8];
        if (any == 0u) break;
    }
#pragma unroll
    for (int mt = 0; mt < 4; ++mt) store_ot(y + (size_t)t * 2048 + 1536 + hd * 128 + 32 * mt, o[mt], 1.f, h);
}

__device__ __forceinline__ void dpost_token(const bf16* __restrict__ oraw, const bf16* __restrict__ opb, const bf16* __restrict__ proj, const float* __restrict__ gain, bf16* __restrict__ y, int t, int lane) {
#pragma unroll
    for (int p = 0; p < 2; ++p) {
        const int c = 512 * p + 8 * lane;
        const u32x4 ov = *(const u32x4*)(oraw + (size_t)t * 1024 + c), pv = *(const u32x4*)(opb + (size_t)t * 1024 + c);
        const f32x4 a = {bf_lo(ov.x) + bf_lo(pv.x), bf_hi(ov.x) + bf_hi(pv.x), bf_lo(ov.y) + bf_lo(pv.y), bf_hi(ov.y) + bf_hi(pv.y)},
                    b = {bf_lo(ov.z) + bf_lo(pv.z), bf_hi(ov.z) + bf_hi(pv.z), bf_lo(ov.w) + bf_lo(pv.w), bf_hi(ov.w) + bf_hi(pv.w)};
        float ss = (a.x * a.x + a.y * a.y) + (a.z * a.z + a.w * a.w) + (b.x * b.x + b.y * b.y) + (b.z * b.z + b.w * b.w);
        ss = red16(ss);
        const float r = rsqrtf(ss * (1.f / 128.f) + EPS_);
        const f32x4 g0 = *(const f32x4*)(gain + (c & 127)), g1 = *(const f32x4*)(gain + (c & 127) + 4);
        const u32x4 zz = *(const u32x4*)(proj + (size_t)t * NPROJ + PC_Z + c);
        u32x4 o;
        o.x = cvt_pk_bf16(a.x * r * g0.x * siluf_(bf_lo(zz.x)), a.y * r * g0.y * siluf_(bf_hi(zz.x)));
        o.y = cvt_pk_bf16(a.z * r * g0.z * siluf_(bf_lo(zz.y)), a.w * r * g0.w * siluf_(bf_hi(zz.y)));
        o.z = cvt_pk_bf16(b.x * r * g1.x * siluf_(bf_lo(zz.z)), b.y * r * g1.y * siluf_(bf_hi(zz.z)));
        o.w = cvt_pk_bf16(b.z * r * g1.z * siluf_(bf_lo(zz.w)), b.w * r * g1.w * siluf_(bf_hi(zz.w)));
        *(u32x4*)(y + (size_t)t * 2048 + c) = o;
    }
}

__device__ __forceinline__ void convact_item(const bf16* __restrict__ up, const float* __restrict__ cw  , bf16* __restrict__ act, int tb, int cb, int lane) {
    const int c = 512 * cb + 8 * lane;
    float wg[3][8], wv[3][8];
#pragma unroll
    for (int i = 0; i < 3; ++i) {
        const f32x4 a = *(const f32x4*)(cw + i * 8192 + c), b = *(const f32x4*)(cw + i * 8192 + c + 4);
        const f32x4 d = *(const f32x4*)(cw + i * 8192 + 4096 + c), e = *(const f32x4*)(cw + i * 8192 + 4096 + c + 4);
        wg[i][0] = a.x; wg[i][1] = a.y; wg[i][2] = a.z; wg[i][3] = a.w; wg[i][4] = b.x; wg[i][5] = b.y; wg[i][6] = b.z; wg[i][7] = b.w;
        wv[i][0] = d.x; wv[i][1] = d.y; wv[i][2] = d.z; wv[i][3] = d.w; wv[i][4] = e.x; wv[i][5] = e.y; wv[i][6] = e.z; wv[i][7] = e.w;
    }
    const int t0 = tb * 32;
    const u32x4 z4 = {0u, 0u, 0u, 0u};
    u32x4 gp0 = z4, vp0 = z4, gp1 = z4, vp1 = z4;
    if (t0 >= 2) { gp0 = *(const u32x4*)(up + (size_t)(t0 - 2) * 8192 + c); vp0 = *(const u32x4*)(up + (size_t)(t0 - 2) * 8192 + 4096 + c);
                   gp1 = *(const u32x4*)(up + (size_t)(t0 - 1) * 8192 + c); vp1 = *(const u32x4*)(up + (size_t)(t0 - 1) * 8192 + 4096 + c); }
#pragma unroll 1
    for (int bt = 0; bt < 4; ++bt) {
        u32x4 gr[10], vr[10];
        gr[0] = gp0; vr[0] = vp0; gr[1] = gp1; vr[1] = vp1;
#pragma unroll
        for (int r = 0; r < 8; ++r) { const int t = t0 + 8 * bt + r; gr[2 + r] = *(const u32x4*)(up + (size_t)t * 8192 + c); vr[2 + r] = *(const u32x4*)(up + (size_t)t * 8192 + 4096 + c); }
        u32x4 ov[8];
#pragma unroll
        for (int r = 0; r < 8; ++r) {
            float ga[8], va[8];
#define CA_TAP(i, G, V, OP) \
            ga[0] OP wg[i][0] * bf_lo(G.x); ga[1] OP wg[i][1] * bf_hi(G.x); ga[2] OP wg[i][2] * bf_lo(G.y); ga[3] OP wg[i][3] * bf_hi(G.y); \
            ga[4] OP wg[i][4] * bf_lo(G.z); ga[5] OP wg[i][5] * bf_hi(G.z); ga[6] OP wg[i][6] * bf_lo(G.w); ga[7] OP wg[i][7] * bf_hi(G.w); \
            va[0] OP wv[i][0] * bf_lo(V.x); va[1] OP wv[i][1] * bf_hi(V.x); va[2] OP wv[i][2] * bf_lo(V.y); va[3] OP wv[i][3] * bf_hi(V.y); \
            va[4] OP wv[i][4] * bf_lo(V.z); va[5] OP wv[i][5] * bf_hi(V.z); va[6] OP wv[i][6] * bf_lo(V.w); va[7] OP wv[i][7] * bf_hi(V.w);
            CA_TAP(0, gr[r], vr[r], =) CA_TAP(1, gr[r + 1], vr[r + 1], +=) CA_TAP(2, gr[r + 2], vr[r + 2], +=)
#undef CA_TAP
            u32x4 o;
            o.x = cvt_pk_bf16(siluf_(ga[0]) * va[0], siluf_(ga[1]) * va[1]); o.y = cvt_pk_bf16(siluf_(ga[2]) * va[2], siluf_(ga[3]) * va[3]);
            o.z = cvt_pk_bf16(siluf_(ga[4]) * va[4], siluf_(ga[5]) * va[5]); o.w = cvt_pk_bf16(siluf_(ga[6]) * va[6], siluf_(ga[7]) * va[7]);
            ov[r] = o;
        }
#pragma unroll
        for (int r = 0; r < 8; ++r) *(u32x4*)(act + (size_t)(t0 + 8 * bt + r) * 4096 + c) = ov[r];
        gp0 = gr[8]; vp0 = vr[8]; gp1 = gr[9]; vp1 = vr[9];
    }
}

__device__ __forceinline__ const void* arg_ptr(int i) {
    const int off = launder_s(i * 8);
    const __attribute__((address_space(4))) char* ka = (const __attribute__((address_space(4))) char*)__builtin_amdgcn_kernarg_segment_ptr();
    return *(const void* const __attribute__((address_space(4)))*)(ka + off);
}
#define AIN(i) ((const float*)arg_ptr(i))
struct Args { const float* in[23]; float* out; unsigned char* ws; };
static_assert(sizeof(Args) == 25 * 8, "Args has no padding");

__global__ void __launch_bounds__(NWAVES * 64, 2) fwd_kernel(Args args) {
    extern __shared__ __attribute__((aligned(16))) unsigned char lds_raw[];
    LAS unsigned char* lds = (LAS unsigned char*)lds_raw;
    const int tid0 = threadIdx.x;
    const int G = gridDim.x, bx = blockIdx.x;
    const int NGW = G * NWAVES;
    unsigned* ctl0 = (unsigned*)((unsigned char*)arg_ptr(24) + WS_CTL);
    for (int u = tid0; u < (LDS_BYTES - LDSCTL_OFF) / 4; u += NWAVES * 64) ((LAS unsigned*)(lds + LDSCTL_OFF))[u] = 0u;
    __syncthreads();
    volatile LAS unsigned* MISC = (volatile LAS unsigned*)(lds + MISC_OFF);
    (void)xcd_barrier_post(ctl0 + CW_BAR, MISC + 8);
    if (bx >= 8) (void)xcd_barrier_post(ctl0 + CW_BAR2, MISC + 10);
#define GRID_BAR() do { XcdBarrier b_; b_.bar = (unsigned*)((unsigned char*)arg_ptr(24) + WS_CTL) + CW_BAR; b_.x = xb_xcc_id(); b_.st = MISC + 8; b_.G = gridDim.x; xcd_barrier(b_); } while (0)
#define SUB_BAR() do { XcdBarrier b_; b_.bar = (unsigned*)((unsigned char*)arg_ptr(24) + WS_CTL) + CW_BAR2; b_.x = xb_xcc_id(); b_.st = MISC + 10; b_.G = gridDim.x - 8; xcd_barrier(b_); } while (0)
#define PHASE_IDS() const int tid = launder_v(threadIdx.x), lane = tid & 63, wave = __builtin_amdgcn_readfirstlane(tid >> 6), gw = bx * NWAVES + wave; (void)lane; (void)gw; (void)tid; WS_PTRS()

#define WS_PTRS() unsigned char* ws = (unsigned char*)arg_ptr(24); float* hbuf = (float*)arg_ptr(23); (void)hbuf; \
    bf16* Win_t = (bf16*)(ws + WS_WIN); bf16* Wup_t = (bf16*)(ws + WS_WUP); bf16* Wdn_t = (bf16*)(ws + WS_WDN); bf16* Wo_t = (bf16*)(ws + WS_WO); \
    bf16* Wbd_t = (bf16*)(ws + WS_WBD); bf16* Wbs_t = (bf16*)(ws + WS_WBS); bf16* Wbb_t = (bf16*)(ws + WS_WBB); \
    bf16* Wxq_t = (bf16*)(ws + WS_WXQ); bf16* Wxkv_t = (bf16*)(ws + WS_WXKV); bf16* Wxo_t = (bf16*)(ws + WS_WXO); \
    bf16* XN = (bf16*)(ws + WS_XN); bf16* PROJ = (bf16*)(ws + WS_PROJ); bf16* UP = (bf16*)(ws + WS_UP); bf16* ACT = (bf16*)(ws + WS_ACT); \
    unsigned char* DPREP = ws + WS_DPREP; bf16* ORAW = (bf16*)(ws + WS_ORAW); bf16* OPB = (bf16*)(ws + WS_OPB); (void)OPB; bf16* Y = (bf16*)(ws + WS_Y); \
    unsigned char* GATES = ws + WS_MRG; (void)GATES; bf16* MRGB = (bf16*)(ws + WS_MRGB); bf16* XQ = (bf16*)(ws + WS_XQ); bf16* XO = (bf16*)(ws + WS_XO); \
    bf16* KV = (bf16*)(ws + WS_KV); bf16* MEMN = (bf16*)(ws + WS_MEMN); float* GL = (float*)(ws + WS_GL); unsigned* ctl = (unsigned*)(ws + WS_CTL); unsigned long long* SSQ = (unsigned long long*)(ws + WS_SSQ); (void)SSQ; \
    (void)Win_t; (void)Wup_t; (void)Wdn_t; (void)Wo_t; (void)Wbd_t; (void)Wbs_t; (void)Wbb_t; (void)Wxq_t; (void)Wxkv_t; (void)Wxo_t; (void)XN; (void)PROJ; (void)UP; (void)ACT; \
    (void)DPREP; (void)ORAW; (void)Y; (void)MRGB; (void)XQ; (void)XO; (void)KV; (void)MEMN; (void)GL; (void)ctl

#define CONVERT_WEIGHTS(LIN, LREST, W0_, NW_) do { \
        LAS float* scr = (LAS float*)(lds + wave * 16384); \
        constexpr int N_IN = 32 * 400, N_UP = 32 * 256, N_DN = 64 * 64, N_O = 32 * 64, N_BD = 16 * 64, N_BS = 8 * 64, N_XQ = 32 * 16, N_XKV = 32 * 32, N_XO = 8 * 64; \
        constexpr int N_REST = N_UP + N_DN + N_O + N_BD + 2 * N_BS + N_XQ + N_XKV + N_XO; \
        const int lin_ = (LIN), lrest_ = (LREST); \
        const int nitems_ = (lin_ >= 0 ? N_IN : 0) + (lrest_ >= 0 ? N_REST : 0); \
        _Pragma("unroll 1") for (int it = (W0_); it < nitems_; it += (NW_)) { \
            int r = it; \
            if (lin_ >= 0) { if (r < N_IN) { const int kb = r / 400, nb = r % 400; \
                transpose_item<1>(AIN(3) + (size_t)lin_ * 2048 * IN_COLS_SRC, 2048, IN_COLS_SRC, Win_t + (size_t)lin_ * NPROJ * 2048, scr, kb, nb, lane, AIN(2) + lin_ * 2048); continue; } r -= N_IN; } \
            TR_CASE(N_UP, 19, 2048, 8192, Wup_t, AIN(18) + lrest_ * 2048) TR_CASE(N_DN, 21, 4096, 2048, Wdn_t, nullptr) TR_CASE(N_O, 12, 2048, 2048, Wo_t, nullptr) TR_CASE(N_BD, 9, 1024, 2048, Wbd_t, nullptr) \
            TR_CASE(N_BS, 10, 512, 2048, Wbs_t, nullptr) TR_CASE(N_BS, 11, 512, 2048, Wbb_t, nullptr) TR_CASE(N_XQ, 15, 2048, 512, Wxq_t, AIN(13) + lrest_ * 2048) TR_CASE(N_XKV, 16, 2048, 1024, Wxkv_t, nullptr) TR_CASE(N_XO, 17, 512, 2048, Wxo_t, nullptr) \
        } } while (0)
#define TR_CASE(NPER, IDX, KK, NN, DSTP, GK) \
            if (r < (NPER)) { const int kb = r / ((NN) / 32), nb = r % ((NN) / 32); \
                transpose_item<0>(AIN(IDX) + (size_t)lrest_ * (KK) * (NN), KK, NN, (DSTP) + (size_t)lrest_ * (NN) * (KK), scr, kb, nb, lane, GK); continue; } r -= (NPER);
    {
        PHASE_IDS();
        CONVERT_WEIGHTS(0, -1, gw, NGW);
#pragma unroll 1
        for (int m = gw; m < S_; m += NGW) {
            const f32x4* xr = (const f32x4*)(AIN(0) + (size_t)m * D_) + lane; u32x2* o8 = (u32x2*)(XN + (size_t)m * D_) + lane; float ss = 0.f;
            f32x4 xv[8];
#pragma unroll
            for (int j = 0; j < 8; ++j) xv[j] = xr[64 * j];
#pragma unroll
            for (int j = 0; j < 8; ++j) { const f32x4 v = xv[j]; ss += (v.x * v.x + v.y * v.y) + (v.z * v.z + v.w * v.w); u32x2 w; w.x = cvt_pk_bf16(v.x, v.y); w.y = cvt_pk_bf16(v.z, v.w); o8[64 * j] = w; }
            ss = wave_sum(ss); if (lane == 0) SSQ[m] = (unsigned long long)(ss * 1048576.f); }
#pragma unroll 1
        for (int it = gw; it < 4 * MEML; it += NGW) { const int l = it / MEML, m = it % MEML;
            rms_row_bf16(AIN(1) + (size_t)m * D_, AIN(14) + l * D_, MEMN + ((size_t)l * MEML + m) * D_, lane); }
    }
    GRID_BAR();

#pragma unroll 1
    for (int l = 0; l < DEPTH_; ++l) {

        { WS_PTRS(); pg8::Gemm g{XN, Win_t + (size_t)l * NPROJ * D_, S_, NPART_A, D_, D_, D_}; pg8::StaticOrder SO; SO.init(S_, NPART_A, G, bx);
          pg8::EpiProj E{PROJ, NPROJ, SSQ + (size_t)(3 * l) * S_, GATES, PC_GATE, NPART_A};
          pg8::gemm_phase<pg8::EpiProj, pg8::StaticOrder, true>(lds, g, SO, E); }
        GRID_BAR();
        { PHASE_IDS();
        if (bx < 8) delta_scan_head(lds, DPREP, GL, ORAW, bx, tid, ctl + CW_PREPCNT + l * 64 + bx * 8, ctl + CW_BAR);
        else {
            { float kmax = 0.f;
#pragma unroll 1
              for (int t = gw - 8 * NWAVES; t < S_; t += NGW - 8 * NWAVES) { const u32x4 r = *(const u32x4*)(PROJ + (size_t)t * NPROJ + PC_SBK + 8 * lane); float ss = dot8(r, r); ss = red16(ss); kmax = fmaxf(kmax, ss); }
              if ((lane & 15) == 0) atomicMax(ctl + CW_KMAX + l * 64 + (lane >> 4), __float_as_uint(kmax));
              const float* convw = AIN(4) + (size_t)l * 4 * 3072; const float* alog = AIN(5) + l * 8; const float* dtb = AIN(6) + l * 8;
              int cur_hd = -1; unsigned* prevc = nullptr;
              const int j = bx - 8, NSH = G - 8, nfull = ((S_ / 64) * 8 / NSH) * NSH, nrem = (S_ / 64) * 8 - nfull, jx = (NSH == 248) ? j - 184 : j;
#pragma unroll 1
              for (int k = 0; k < (S_ / 64) * 8 / NSH + 1; ++k) {
                int u = j + k * NSH;
                if (u >= nfull) { if (jx < 0 || jx >= nrem) break; u = nfull + jx; }
                const int hd = u & 7;
                if (hd != cur_hd) {
                    __syncthreads();
                    for (int i = tid; i < 4 * 384; i += NWAVES * 64) { const int tap = i / 384, c = i % 384; ((LAS float*)(lds + P_CW))[i] = convw[tap * 3072 + (c >> 7) * 1024 + hd * 128 + (c & 127)]; }
                    cur_hd = hd; }
                delta_prep_unit(lds, PROJ, convw, alog[hd], dtb[hd], DPREP + ((size_t)hd * (S_ / 64) + (u >> 3)) * DU_BYTES, GL + u, OPB, (u >> 3) * 64, hd, tid, prevc);
                prevc = ctl + CW_PREPCNT + l * 64 + hd * 8 + (u >> 8); }
              asm volatile("s_waitcnt vmcnt(0)" ::: "memory");
              __syncthreads();
              if (prevc && tid == 0) { __builtin_amdgcn_fence(__ATOMIC_RELEASE, "workgroup"); (void)xb_add(prevc, 1u); }
              __syncthreads(); }
            const int late = (bx >> 3) & 1;
            if (late) { CONVERT_WEIGHTS(-1, l, gw - 8 * NWAVES, NGW - 8 * NWAVES); __syncthreads(); }
            { pg8::Gemm g{XN, Win_t + (size_t)l * NPROJ * D_ + (size_t)PC_SWAQ * D_, S_, NPROJ - PC_SWAQ, D_, D_, D_}; pg8::StaticOrder SO; SO.init(S_, NPROJ - PC_SWAQ, G - 8, bx - 8);
              pg8::EpiBf16 E{PROJ + PC_SWAQ, NPROJ, SSQ + (size_t)(3 * l) * S_};
              pg8::gemm_phase<pg8::EpiBf16, pg8::StaticOrder, true>(lds, g, SO, E); }
            asm volatile("s_waitcnt vmcnt(0)" ::: "memory");
            __syncthreads();
            if (tid == 0) { __builtin_amdgcn_fence(__ATOMIC_RELEASE, "agent"); asm volatile("s_waitcnt vmcnt(0)" ::: "memory"); (void)xb_add(ctl + CW_B1CNT + l * 64, 1u); }
            { const int cB = (bx - 8 + 56) % (G - 8);
              pg8::Gemm g{XN, Win_t + (size_t)l * NPROJ * D_ + (size_t)NPART_A * D_, S_, PC_SWAQ - NPART_A, D_, D_, D_}; pg8::StaticOrder SO; SO.init(S_, PC_SWAQ - NPART_A, G - 8, cB);
              pg8::EpiProj E{PROJ + NPART_A, NPROJ, SSQ + (size_t)(3 * l) * S_, GATES + (NPART_A - PC_GATE), 0, PC_GATE + 6144 - NPART_A};
              pg8::gemm_phase<pg8::EpiProj, pg8::StaticOrder, true>(lds, g, SO, E); }
            if (tid == 0) { unsigned* bar0 = ctl + CW_BAR; XB_SPIN(xb_ld(ctl + CW_B1CNT + l * 64) < (unsigned)(G - 8), bar0); __builtin_amdgcn_fence(__ATOMIC_ACQUIRE, "agent"); asm volatile("s_waitcnt vmcnt(0)" ::: "memory"); }
            __syncthreads();
            {
              const int j = bx - 8, NSH = G - 8;
              const float* sinks = AIN(8) + l * 8;
              int u0, u1, u2;
              if (NSH == 248) {
                  const bool shortg = (j >= 184 && j < 192) || j >= 200;
                  if (shortg) { const int si = j < 192 ? j - 184 : 8 + (j - 200); u0 = 2 * si; u1 = 2 * si + 1; u2 = 256 + si; }
                  else { const int li = j < 184 ? j : j - 8;
                      if (li < 144) { u0 = 112 + li; u1 = 256 + 56 + li; u2 = -1; }
                      else { const int k2 = li - 144; u0 = 256 + 200 + k2; u1 = k2 < 8 ? 256 + 248 + k2 : -1; u2 = -1; } } }
              else { u0 = j; u1 = j + NSH; u2 = j + 2 * NSH; if (u1 >= 512) u1 = -1; if (u2 >= 512) u2 = -1; }
#pragma unroll 1
              for (int k = 0; k < 3; ++k) { const int u = (k == 0) ? u0 : (k == 1 ? u1 : u2);
                  if (u < 0) continue;
                  if (u < 256) sb_unit(lds, PROJ, __uint_as_float(ctl[CW_KMAX + l * 64 + (u & 3)]), Y, u & 3, u >> 2, tid);
                  else swa_unit(lds, PROJ, sinks, Y, (u - 256) & 1, (u - 256) >> 1, tid); }
            }
            __syncthreads();
            if (!late) { CONVERT_WEIGHTS(-1, l, gw - 8 * NWAVES, NGW - 8 * NWAVES); }
        } }
        GRID_BAR();
        { PHASE_IDS();
#pragma unroll 1
          for (int t = gw; t < S_; t += 2 * NGW) { dpost_token(ORAW, OPB, PROJ, AIN(7) + l * 128, Y, t, lane); dpost_token(ORAW, OPB, PROJ, AIN(7) + l * 128, Y, t + NGW, lane); } }
        GRID_BAR();
        { WS_PTRS(); pg8::StaticOrder SO; SO.init(S_, D_, G, bx);
          { pg8::Gemm g{Y, Wbd_t + (size_t)l * 2048 * 1024, S_, D_, 1024, 2048, 1024}; pg8::EpiGate<0> E{GATES, 6144, MRGB, D_};
            pg8::gemm_phase<pg8::EpiGate<0>, pg8::StaticOrder, true>(lds, g, SO, E); }
          { pg8::Gemm g{Y + 1024, Wbs_t + (size_t)l * 2048 * 512, S_, D_, 512, 2048, 512}; pg8::EpiGate<1> E{GATES + 2048, 6144, MRGB, D_};
            pg8::gemm_phase<pg8::EpiGate<1>, pg8::StaticOrder, true>(lds, g, SO, E); }
          { pg8::Gemm g{Y + 1536, Wbb_t + (size_t)l * 2048 * 512, S_, D_, 512, 2048, 512}; pg8::EpiGate<2> E{GATES + 4096, 6144, MRGB, D_};
            pg8::gemm_phase<pg8::EpiGate<2>, pg8::StaticOrder, true>(lds, g, SO, E); } }
        GRID_BAR();
        { WS_PTRS(); pg8::Gemm g{MRGB, Wo_t + (size_t)l * D_ * D_, S_, D_, D_, D_, D_}; pg8::StaticOrder SO; SO.init(S_, D_, G, bx);
          pg8::EpiRes E{XN, D_, SSQ + (size_t)(3 * l + 1) * S_};
          pg8::gemm_phase<pg8::EpiRes, pg8::StaticOrder, true>(lds, g, SO, E); }
        GRID_BAR();
        { WS_PTRS(); pg8::Gemm g{XN, Wxq_t + (size_t)l * 512 * D_, S_, 512, D_, D_, D_}; pg8::StaticOrder SO; SO.init(S_, 512, G, bx);
          pg8::EpiBf16 E{XQ, 512, SSQ + (size_t)(3 * l + 1) * S_};
          pg8::gemm_phase<pg8::EpiBf16, pg8::StaticOrder, true>(lds, g, SO, E); }
        { WS_PTRS(); pg8::Gemm g{MEMN + (size_t)l * MEML * D_, Wxkv_t + (size_t)l * 1024 * D_, MEML, 1024, D_, D_, D_}; pg8::StaticOrder SO; SO.init(MEML, 1024, G, (bx + G - 128) % G);
          pg8::EpiBf16 E{KV + (size_t)l * MEML * 1024, 1024, nullptr};
          pg8::gemm_phase<pg8::EpiBf16, pg8::StaticOrder, true>(lds, g, SO, E); }
        { PHASE_IDS(); if (bx >= 132 && l + 1 < DEPTH_) { CONVERT_WEIGHTS(l + 1, -1, gw - 132 * NWAVES, NGW - 132 * NWAVES); } }
        GRID_BAR();
        { PHASE_IDS();
#pragma unroll 1
          for (int u = bx; u < 256; u += G) xattn_unit(lds, XQ, KV + (size_t)l * MEML * 1024, XO, u & 3, u >> 2, tid);
          __syncthreads(); }
        GRID_BAR();
        { WS_PTRS(); pg8::Gemm g{XO, Wxo_t + (size_t)l * D_ * 512, S_, D_, 512, 512, 512}; pg8::StaticOrder SO; SO.init(S_, D_, G, bx);
          pg8::EpiRes E{XN, D_, SSQ + (size_t)(3 * l + 2) * S_};
          pg8::gemm_phase<pg8::EpiRes, pg8::StaticOrder, true>(lds, g, SO, E); }
        GRID_BAR();
        { WS_PTRS(); pg8::Gemm g{XN, Wup_t + (size_t)l * 8192 * D_, S_, 8192, D_, D_, D_}; pg8::StaticOrder SO; SO.init(S_, 8192, G, bx);
          pg8::EpiBf16 E{UP, 8192, SSQ + (size_t)(3 * l + 2) * S_};
          pg8::gemm_phase<pg8::EpiBf16, pg8::StaticOrder, true>(lds, g, SO, E); }
        GRID_BAR();
        { PHASE_IDS();
#pragma unroll 1
          for (int it = gw; it < (S_ / 32) * 8; it += NGW) convact_item(UP, AIN(20) + (size_t)l * 3 * 8192, ACT, it >> 3, it & 7, lane); }
        GRID_BAR();
        { WS_PTRS(); pg8::Gemm g{ACT, Wdn_t + (size_t)l * D_ * DFF, S_, D_, DFF, DFF, DFF}; pg8::StaticOrder SO; SO.init(S_, D_, G, bx);
          pg8::EpiRes E{XN, D_, SSQ + (size_t)(3 * l + 3) * S_};
          pg8::gemm_phase<pg8::EpiRes, pg8::StaticOrder, true>(lds, g, SO, E); }
        GRID_BAR();
    }
    { PHASE_IDS();
#pragma unroll 1
      for (int m = gw; m < S_; m += NGW) { const u32x2* hr = (const u32x2*)(XN + (size_t)m * D_) + lane; f32x4* orow = (f32x4*)(hbuf + (size_t)m * D_) + lane; const f32x4* gr = (const f32x4*)AIN(22) + lane;
          const float rstd = rsqrtf((float)SSQ[(size_t)(3 * DEPTH_) * S_ + m] * (1.f / (2048.f * 1048576.f)) + EPS_);
          u32x2 hv[8]; f32x4 gq[8];
#pragma unroll
          for (int j = 0; j < 8; ++j) { hv[j] = hr[64 * j]; gq[j] = gr[64 * j]; }
#pragma unroll
          for (int j = 0; j < 8; ++j) { const f32x4 v = {bf_lo(hv[j].x), bf_hi(hv[j].x), bf_lo(hv[j].y), bf_hi(hv[j].y)}; orow[64 * j] = v * rstd * gq[j]; } } }
}

extern "C" void kernel_launch(void* const* d_in, const int* in_sizes, int n_in, void* d_out, int out_size, void* d_ws, size_t ws_size, hipStream_t stream) {
    static int grid = 0;
    if (grid == 0) {
        if (n_in != 23 || out_size != S_ * D_ || ws_size < WS_END) { fprintf(stderr, "kernel_launch: unexpected shapes (n_in %d, out %d, ws %zu, need %zu)\n", n_in, out_size, ws_size, (size_t)WS_END); grid = -1; return; }
        int dev = 0, cus = 0, per_cu = 0;
        if (hipGetDevice(&dev) != hipSuccess || hipDeviceGetAttribute(&cus, hipDeviceAttributeMultiprocessorCount, dev) != hipSuccess) { grid = -1; return; }
        if (hipFuncSetAttribute((const void*)fwd_kernel, hipFuncAttributeMaxDynamicSharedMemorySize, LDS_BYTES) != hipSuccess) { fprintf(stderr, "kernel_launch: hipFuncSetAttribute failed\n"); grid = -1; return; }
        if (hipOccupancyMaxActiveBlocksPerMultiprocessor(&per_cu, (const void*)fwd_kernel, NWAVES * 64, LDS_BYTES) != hipSuccess || per_cu < 1)
            fprintf(stderr, "kernel_launch: occupancy query reports %d workgroups per CU\n", per_cu);
        (void)hipGetLastError();
        grid = cus;
    }
    if (grid < 0) return;
    if (hipMemsetAsync((char*)d_ws + WS_CTL, 0, CTL_ZERO_BYTES, stream) != hipSuccess || hipMemsetAsync((char*)d_ws + WS_SSQ, 0, SSQ_BYTES, stream) != hipSuccess) { fprintf(stderr, "kernel_launch: memset failed\n"); return; }
    Args a{};
    for (int i = 0; i < 23; ++i) a.in[i] = (const float*)d_in[i];
    a.out = (float*)d_out; a.ws = (unsigned char*)d_ws;
    hipLaunchKernelGGL(fwd_kernel, dim3(grid), dim3(NWAVES * 64), LDS_BYTES, stream, a);
    const hipError_t le = hipPeekAtLastError();
    if (le != hipSuccess) fprintf(stderr, "kernel_launch: launch failed: %s\n", hipGetErrorName(le));
}
```

```cpp
#include <hip/hip_runtime.h>
#include <cstdio>
#include <cstdint>

#define GAS __attribute__((address_space(1)))
#define LAS __attribute__((address_space(3)))
typedef unsigned short bf16;
typedef unsigned u32x4 __attribute__((ext_vector_type(4)));
typedef unsigned u32x2 __attribute__((ext_vector_type(2)));
typedef float f32x4 __attribute__((ext_vector_type(4)));
typedef float f32x2 __attribute__((ext_vector_type(2)));
typedef short bf16x8 __attribute__((ext_vector_type(8)));

constexpr int S_ = 16384, D_ = 2048, DEPTH_ = 4, MEML = 256, DFF = 4096;
constexpr int NPROJ = 12800;
constexpr int PC_DNQ = 0, PC_DNK = 1024, PC_DNV = 2048, PC_A = 3072, PC_B = 3080, PC_SBK = 3328, PC_GATE = 3840, PC_Z = 9984,
              PC_SWAQ = 11008, PC_SWAK = 11520, PC_SWAV = 11648, PC_SBQ = 11776, PC_SBV = 12288;
constexpr int NPART_A = 4096, NPART_B = NPROJ - NPART_A;
constexpr int IN_COLS_SRC = 12560;
constexpr float EPS_ = 1e-6f;

constexpr size_t MiB = 1u << 20;
constexpr size_t WS_CTL = 0, CTL_ZERO_BYTES = 1 * MiB;
constexpr size_t WS_WIN = 2 * MiB;
constexpr size_t WS_WUP = 202 * MiB;
constexpr size_t WS_WDN = 330 * MiB;
constexpr size_t WS_WO = 394 * MiB;
constexpr size_t WS_WBD = 426 * MiB;
constexpr size_t WS_WBS = 442 * MiB;
constexpr size_t WS_WBB = 450 * MiB;
constexpr size_t WS_WXQ = 458 * MiB;
constexpr size_t WS_WXKV = 466 * MiB;
constexpr size_t WS_WXO = 482 * MiB;
constexpr size_t WS_XN = 490 * MiB;
constexpr size_t WS_PROJ = 554 * MiB;
constexpr size_t WS_UP = 554 * MiB;
constexpr size_t WS_ACT = 810 * MiB;
constexpr size_t WS_DPREP = 954 * MiB;
constexpr size_t WS_ORAW = 1146 * MiB;
constexpr size_t WS_Y = 1210 * MiB;
constexpr size_t WS_MRG = 1274 * MiB;
constexpr size_t WS_MRGB = 1402 * MiB;
constexpr size_t WS_XQ = 1466 * MiB;
constexpr size_t WS_XO = 1482 * MiB;
constexpr size_t WS_KV = 1498 * MiB;
constexpr size_t WS_MEMN = 1500 * MiB;
constexpr size_t WS_GL = 1504 * MiB;
constexpr size_t WS_SSQ = 1506 * MiB, SSQ_BYTES = 2 * MiB;
constexpr size_t WS_OPB = 1508 * MiB;
constexpr size_t WS_END = 1540 * MiB;
constexpr int CW_BAR = 4096;
constexpr int CW_BAR2 = 8192;
constexpr int CW_B1CNT = 12288;
constexpr int CW_ZERO16 = 200000;
constexpr int CW_KMAX = 16384;

constexpr int RING_BYTES = 131072;
constexpr int LDSCTL_OFF = 162816, MISC_OFF = LDSCTL_OFF + 320;
constexpr int LDS_BYTES = 163840;
constexpr int NWAVES = 8;

#define LDS_WAIT() asm volatile("s_waitcnt lgkmcnt(0)" ::: "memory")
#define VM_WAIT() asm volatile("s_waitcnt vmcnt(0)" ::: "memory")
__device__ __forceinline__ unsigned cvt_pk_bf16(float lo, float hi) { unsigned r; asm volatile("v_cvt_pk_bf16_f32 %0, %1, %2" : "=v"(r) : "v"(lo), "v"(hi)); return r; }
__device__ __forceinline__ float bf_lo(unsigned w) { return __uint_as_float(w << 16); }
__device__ __forceinline__ float bf_hi(unsigned w) { return __uint_as_float(w & 0xffff0000u); }
__device__ __forceinline__ float bf2f(bf16 b) { return __uint_as_float(((unsigned)b) << 16); }
__device__ __forceinline__ float wave_sum(float v) {
#pragma unroll
    for (int o = 1; o < 64; o <<= 1) v += __shfl_xor(v, o);
    return v;
}
__device__ __forceinline__ float wave_max(float v) {
#pragma unroll
    for (int o = 1; o < 64; o <<= 1) v = fmaxf(v, __shfl_xor(v, o));
    return v;
}
__device__ __forceinline__ float sigmoidf_(float x) { return 1.0f / (1.0f + __expf(-x)); }
__device__ __forceinline__ float siluf_(float x) { return x / (1.0f + __expf(-x)); }
__device__ __forceinline__ float softplusf_(float x) { return fmaxf(x, 0.f) + log1pf(__expf(-fabsf(x))); }
__device__ __forceinline__ float dot8(u32x4 a, u32x4 b) {
    float s = bf_lo(a.x) * bf_lo(b.x);
    s += bf_hi(a.x) * bf_hi(b.x);
    s += bf_lo(a.y) * bf_lo(b.y); s += bf_hi(a.y) * bf_hi(b.y);
    s += bf_lo(a.z) * bf_lo(b.z); s += bf_hi(a.z) * bf_hi(b.z);
    s += bf_lo(a.w) * bf_lo(b.w); s += bf_hi(a.w) * bf_hi(b.w);
    return s;
}

__device__ __forceinline__ int launder_v(int x) { asm volatile("" : "+v"(x)); return x; }
__device__ __forceinline__ int launder_s(int x) { asm volatile("" : "+s"(x)); return x; }
namespace pg8 {
#define PG8_LAS __attribute__((address_space(3)))
typedef unsigned short bf16_t;
constexpr int BM = 256, BK = 64, HALF = 128, HTB = HALF * BK * 2, STAGE_BYTES = 8 * HTB, NXCD = 8, WGM = 8;
__host__ __device__ __forceinline__ int lds_byte(int r, int c) { const int st = (r >> 4) * 2 + (c >> 5), rr = r & 15, cc = c & 31, ob = rr * 64 + cc * 2; return st * 1024 + (ob ^ (((ob >> 9) & 1) << 5)); }
__host__ __device__ __forceinline__ void stage_rc(int b, int& R, int& C) { const int st = b / 1024, sb = b % 1024, swz = sb ^ (((sb >> 9) & 1) << 5); R = (st >> 1) * 16 + swz / 64; C = (st & 1) * 32 + (swz % 64) / 2; }
__host__ __device__ __forceinline__ int perm32(int rho) { const int n = rho >> 4, i = rho & 15; return 8 * (i >> 2) + 4 * n + (i & 3); }
struct Unit { int pm, pn; };
struct Gemm { const bf16_t* A; const bf16_t* Bt; int M, N, K, lda, ldb; };
struct StaticOrder {
    int nM, nN, nwg, G, c;
    __host__ __device__ void init(int M, int N, int G_, int c_) { nM = M / BM; nN = N / BM; nwg = nM * nN; G = G_; c = c_; }
    __host__ __device__ bool next(int i, Unit& u) const {
        const long L = (long)i * G + c; if (L >= nwg) return false;
        int wgid = (int)L; { const int q = nwg / NXCD, r = nwg % NXCD, xcd = wgid % NXCD, off = wgid / NXCD; wgid = (xcd < r ? xcd * (q + 1) : r * (q + 1) + (xcd - r) * q) + off; }
        const int nig = WGM * nN, gid = wgid / nig, fm = gid * WGM, gsz = (nM - fm) < WGM ? (nM - fm) : WGM;
        u.pm = fm + ((wgid % nig) % gsz); u.pn = (wgid % nig) / gsz; return true;
    }
    __device__ __forceinline__ void a_ready(const Unit&) const {}
    __device__ __forceinline__ void done(const Unit&) const {}
};
struct EpiBf16 {
    static constexpr bool PERM = true, AFTER_DRAIN = false;
    bf16_t* O; int ldc; const unsigned long long* ssq;
    __device__ __forceinline__ void operator()(const f32x4 (&acc)[2][2][4][2], const Unit& u, int wr, int wc, int fr, int fq) const {
        const int row0 = u.pm * BM + wr * 64 + fr, col0 = u.pn * BM + wc * 64 + 8 * fq;
        float rs[2][4];
        if (ssq) { unsigned long long q[2][4];
#pragma unroll
            for (int ai = 0; ai < 2; ++ai)
#pragma unroll
                for (int m = 0; m < 4; ++m) q[ai][m] = ssq[row0 + ai * HALF + m * 16];
#pragma unroll
            for (int ai = 0; ai < 2; ++ai)
#pragma unroll
                for (int m = 0; m < 4; ++m) rs[ai][m] = rsqrtf((float)q[ai][m] * (1.f / (2048.f * 1048576.f)) + 1e-6f);
        } else {
#pragma unroll
            for (int ai = 0; ai < 2; ++ai)
#pragma unroll
                for (int m = 0; m < 4; ++m) rs[ai][m] = 1.f; }
#pragma unroll
        for (int ai = 0; ai < 2; ++ai)
#pragma unroll
            for (int m = 0; m < 4; ++m) { const int row = row0 + ai * HALF + m * 16; bf16_t* rowp = O + (size_t)row * ldc + col0;
#pragma unroll
                for (int bj = 0; bj < 2; ++bj) { const f32x4 v0 = acc[ai][bj][m][0] * rs[ai][m], v1 = acc[ai][bj][m][1] * rs[ai][m];
                    u32x4 w; w.x = cvt_pk_bf16(v0[0], v0[1]); w.y = cvt_pk_bf16(v0[2], v0[3]); w.z = cvt_pk_bf16(v1[0], v1[1]); w.w = cvt_pk_bf16(v1[2], v1[3]);
                    *(u32x4*)(rowp + bj * 32) = w; } }
    }
};
struct EpiProj {
    static constexpr bool PERM = true, AFTER_DRAIN = false;
    bf16_t* O; int ldc; const unsigned long long* ssq; unsigned char* gq; int glo, ghi;
    __device__ __forceinline__ void operator()(const f32x4 (&acc)[2][2][4][2], const Unit& u, int wr, int wc, int fr, int fq) const {
        const int row0 = u.pm * BM + wr * 64 + fr, col0 = u.pn * BM + wc * 64 + 8 * fq;
        float rs[2][4];
        { unsigned long long q[2][4];
#pragma unroll
            for (int ai = 0; ai < 2; ++ai)
#pragma unroll
                for (int m = 0; m < 4; ++m) q[ai][m] = ssq[row0 + ai * HALF + m * 16];
#pragma unroll
            for (int ai = 0; ai < 2; ++ai)
#pragma unroll
                for (int m = 0; m < 4; ++m) rs[ai][m] = rsqrtf((float)q[ai][m] * (1.f / (2048.f * 1048576.f)) + 1e-6f); }
        const bool isg = (u.pn * BM >= glo) && (u.pn * BM < ghi);
        if (!isg) {
#pragma unroll
            for (int ai = 0; ai < 2; ++ai)
#pragma unroll
                for (int m = 0; m < 4; ++m) { const int row = row0 + ai * HALF + m * 16; bf16_t* rowp = O + (size_t)row * ldc + col0;
#pragma unroll
                    for (int bj = 0; bj < 2; ++bj) { const f32x4 v0 = acc[ai][bj][m][0] * rs[ai][m], v1 = acc[ai][bj][m][1] * rs[ai][m];
                        u32x4 w; w.x = cvt_pk_bf16(v0[0], v0[1]); w.y = cvt_pk_bf16(v0[2], v0[3]); w.z = cvt_pk_bf16(v1[0], v1[1]); w.w = cvt_pk_bf16(v1[2], v1[3]);
                        *(u32x4*)(rowp + bj * 32) = w; } }
        } else {
#define SGQ(x) ((unsigned)(__builtin_amdgcn_rcpf(1.f + __expf(-(x))) * 255.f + 0.5f))
#pragma unroll
            for (int ai = 0; ai < 2; ++ai)
#pragma unroll
                for (int m = 0; m < 4; ++m) { const int row = row0 + ai * HALF + m * 16; unsigned char* rowp = gq + (size_t)row * 6144 + (col0 - glo);
#pragma unroll
                    for (int bj = 0; bj < 2; ++bj) { const f32x4 v0 = acc[ai][bj][m][0] * rs[ai][m], v1 = acc[ai][bj][m][1] * rs[ai][m];
                        u32x2 w; w.x = SGQ(v0[0]) | (SGQ(v0[1]) << 8) | (SGQ(v0[2]) << 16) | (SGQ(v0[3]) << 24); w.y = SGQ(v1[0]) | (SGQ(v1[1]) << 8) | (SGQ(v1[2]) << 16) | (SGQ(v1[3]) << 24);
                        *(u32x2*)(rowp + bj * 32) = w; } }
#undef SGQ
        }
    }
};
struct EpiRes {
    static constexpr bool PERM = true, AFTER_DRAIN = false;
    bf16_t* hb; int ldc; unsigned long long* ssq;
    __device__ __forceinline__ void operator()(const f32x4 (&acc)[2][2][4][2], const Unit& u, int wr, int wc, int fr, int fq) const {
        const int row0 = u.pm * BM + wr * 64 + fr, col0 = u.pn * BM + wc * 64 + 8 * fq;
        u32x4 bs[2][4][2];
#pragma unroll
        for (int ai = 0; ai < 2; ++ai)
#pragma unroll
            for (int m = 0; m < 4; ++m)
#pragma unroll
                for (int bj = 0; bj < 2; ++bj) bs[ai][m][bj] = *(const u32x4*)(hb + (size_t)(row0 + ai * HALF + m * 16) * ldc + col0 + bj * 32);
#pragma unroll
        for (int ai = 0; ai < 2; ++ai)
#pragma unroll
            for (int m = 0; m < 4; ++m) { const int row = row0 + ai * HALF + m * 16; const size_t off = (size_t)row * ldc + col0; float ss = 0.f;
#pragma unroll
                for (int bj = 0; bj < 2; ++bj) { const u32x4 b = bs[ai][m][bj]; const f32x4 a0 = acc[ai][bj][m][0], a1 = acc[ai][bj][m][1];
                    const float v0 = bf_lo(b.x) + a0[0], v1 = bf_hi(b.x) + a0[1], v2 = bf_lo(b.y) + a0[2], v3 = bf_hi(b.y) + a0[3];
                    const float v4 = bf_lo(b.z) + a1[0], v5 = bf_hi(b.z) + a1[1], v6 = bf_lo(b.w) + a1[2], v7 = bf_hi(b.w) + a1[3];
                    ss += (v0 * v0 + v1 * v1) + (v2 * v2 + v3 * v3) + (v4 * v4 + v5 * v5) + (v6 * v6 + v7 * v7);
                    u32x4 w; w.x = cvt_pk_bf16(v0, v1); w.y = cvt_pk_bf16(v2, v3); w.z = cvt_pk_bf16(v4, v5); w.w = cvt_pk_bf16(v6, v7);
                    *(u32x4*)(hb + off + bj * 32) = w; }
                ss += __shfl_xor(ss, 16); ss += __shfl_xor(ss, 32);
                if (fq == 0) atomicAdd(ssq + row, (unsigned long long)(ss * 1048576.f)); }
    }
};
template <int MODE> struct EpiGate {
    static constexpr bool PERM = true, AFTER_DRAIN = false;
    const unsigned char* gate; int ldg; bf16_t* mrgb; int ldc;
    __device__ __forceinline__ void operator()(const f32x4 (&acc)[2][2][4][2], const Unit& u, int wr, int wc, int fr, int fq) const {
        const int row0 = u.pm * BM + wr * 64 + fr, col0 = u.pn * BM + wc * 64 + 8 * fq;
#pragma unroll
        for (int ai = 0; ai < 2; ++ai) {
            u32x2 gw[4][2]; u32x4 pv[4][2];
#pragma unroll
            for (int m = 0; m < 4; ++m)
#pragma unroll
                for (int bj = 0; bj < 2; ++bj) { const int row = row0 + ai * HALF + m * 16;
                    gw[m][bj] = *(const u32x2*)(gate + (size_t)row * ldg + col0 + bj * 32);
                    if (MODE != 0) pv[m][bj] = *(const u32x4*)(mrgb + (size_t)row * ldc + col0 + bj * 32); }
#pragma unroll
            for (int m = 0; m < 4; ++m)
#pragma unroll
                for (int bj = 0; bj < 2; ++bj) { const size_t off = (size_t)(row0 + ai * HALF + m * 16) * ldc + col0 + bj * 32;
                    const u32x2 g2 = gw[m][bj]; const f32x4 a0 = acc[ai][bj][m][0], a1 = acc[ai][bj][m][1];
                    const float k255 = 1.f / 255.f;
                    float v[8];
                    v[0] = (float)(g2.x & 255u) * k255 * a0[0]; v[1] = (float)((g2.x >> 8) & 255u) * k255 * a0[1]; v[2] = (float)((g2.x >> 16) & 255u) * k255 * a0[2]; v[3] = (float)(g2.x >> 24) * k255 * a0[3];
                    v[4] = (float)(g2.y & 255u) * k255 * a1[0]; v[5] = (float)((g2.y >> 8) & 255u) * k255 * a1[1]; v[6] = (float)((g2.y >> 16) & 255u) * k255 * a1[2]; v[7] = (float)(g2.y >> 24) * k255 * a1[3];
                    if (MODE != 0) { const u32x4 p = pv[m][bj]; v[0] += bf_lo(p.x); v[1] += bf_hi(p.x); v[2] += bf_lo(p.y); v[3] += bf_hi(p.y); v[4] += bf_lo(p.z); v[5] += bf_hi(p.z); v[6] += bf_lo(p.w); v[7] += bf_hi(p.w); }
                    u32x4 w; w.x = cvt_pk_bf16(v[0], v[1]); w.y = cvt_pk_bf16(v[2], v[3]); w.z = cvt_pk_bf16(v[4], v[5]); w.w = cvt_pk_bf16(v[6], v[7]);
                    *(u32x4*)(mrgb + off) = w; }
        }
    }
};

template <class Epi, class Sched, bool ALIGN_EPI = true>
__device__ __forceinline__ void gemm_phase(PG8_LAS unsigned char* lds, const Gemm g, const Sched& S, const Epi& E) {
    const int tid = launder_v(threadIdx.x), wid = __builtin_amdgcn_readfirstlane(tid >> 6), lane = tid & 63, wr = wid >> 2, wc = wid & 3, fr = lane & 15, fq = lane >> 4;
    const int K = g.K, nt = K / BK;
    unsigned voffA[2], voffB[2];
#pragma unroll
    for (int i = 0; i < 2; ++i) { int R, C; stage_rc(tid * 16 + i * 8192, R, C); const int Rb = 64 * (R >> 5) + perm32(R & 31);
        voffA[i] = (unsigned)(R * g.lda + C) * 2u; voffB[i] = (unsigned)(Rb * g.ldb + C) * 2u; }
    const size_t kstep = (size_t)(BK * 2);
    const size_t hstepA = (size_t)HALF * g.lda * 2, hstepB = (size_t)32 * g.ldb * 2;
    const size_t tstepA = 2 * hstepA, tstepB = (size_t)BM * g.ldb * 2;
    const unsigned ldsw = (unsigned)wid * 1024u;
    const int aoff = lds_byte(wr * 64 + fr, fq * 8), boff = lds_byte(wc * 32 + fr, fq * 8);
#define PG8_SA(b, h) (((b) * 2 + (h)) * HTB)
#define PG8_SB(b, h) ((4 + (b) * 2 + (h)) * HTB)
#define PG8_STAGE(bufoff, gbase, voff) do { _Pragma("unroll") for (int _i = 0; _i < 2; ++_i) \
        __builtin_amdgcn_global_load_lds((const unsigned*)((const char*)(gbase) + (voff)[_i]), (PG8_LAS unsigned*)(lds + (bufoff) + ldsw + _i * 8192), 16, 0, 0); } while (0)
#define PG8_LDA(dst, b, h) do { _Pragma("unroll") for (int m = 0; m < 4; ++m) _Pragma("unroll") for (int k = 0; k < 2; ++k) dst[m][k] = *(const PG8_LAS bf16x8*)(lds + PG8_SA(b, h) + aoff + m * 2048 + k * 1024); } while (0)
#define PG8_LDB(dst, b, h) do { _Pragma("unroll") for (int n = 0; n < 2; ++n) _Pragma("unroll") for (int k = 0; k < 2; ++k) dst[n][k] = *(const PG8_LAS bf16x8*)(lds + PG8_SB(b, h) + boff + n * 2048 + k * 1024); } while (0)
#define PG8_MMA(ai, bj, At, Bt) do { __builtin_amdgcn_s_setprio(1); _Pragma("unroll") for (int m = 0; m < 4; ++m) _Pragma("unroll") for (int n = 0; n < 2; ++n) _Pragma("unroll") for (int k = 0; k < 2; ++k) \
        acc[ai][bj][m][n] = __builtin_amdgcn_mfma_f32_16x16x32_bf16(Bt[n][k], At[m][k], acc[ai][bj][m][n], 0, 0, 0); __builtin_amdgcn_s_setprio(0); } while (0)
#define PG8_WAIT_V(n) asm volatile("s_waitcnt vmcnt(" #n ")" ::: "memory")
#define PG8_WAIT_L(n) asm volatile("s_waitcnt lgkmcnt(" #n ")" ::: "memory")
#define PG8_BAR __builtin_amdgcn_s_barrier()
#define PG8_SCHED __builtin_amdgcn_sched_barrier(0)
    Unit cur, nxt; int ui = 0;
    if (!S.next(0, cur)) return;
    f32x4 acc[2][2][4][2];
#pragma unroll
    for (int a = 0; a < 2; ++a)
#pragma unroll
        for (int b = 0; b < 2; ++b)
#pragma unroll
            for (int m = 0; m < 4; ++m)
#pragma unroll
                for (int n = 0; n < 2; ++n) acc[a][b][m][n] = (f32x4){0.f, 0.f, 0.f, 0.f};
    bf16x8 At[4][2], B0[2][2], B1[2][2];
    const char* cA = (const char*)g.A + (size_t)cur.pm * tstepA; const char* cB = (const char*)g.Bt + (size_t)cur.pn * tstepB;
    S.a_ready(cur);
    PG8_STAGE(PG8_SB(0, 0), cB, voffB); PG8_STAGE(PG8_SB(0, 1), cB + hstepB, voffB); PG8_STAGE(PG8_SA(0, 0), cA, voffA); PG8_STAGE(PG8_SA(0, 1), cA + hstepA, voffA);
    if (wr == 1) PG8_BAR;
    PG8_WAIT_V(2); PG8_BAR;
    PG8_STAGE(PG8_SB(1, 0), cB + kstep, voffB); PG8_STAGE(PG8_SA(1, 0), cA + kstep, voffA); PG8_STAGE(PG8_SB(1, 1), cB + hstepB + kstep, voffB);
    PG8_WAIT_V(6); PG8_BAR;
    for (;;) {
        const bool has_next = S.next(ui + 1, nxt);
        const char* nA = has_next ? (const char*)g.A + (size_t)nxt.pm * tstepA : cA; const char* nB = has_next ? (const char*)g.Bt + (size_t)nxt.pn * tstepB : cB;
        for (int t = 0; t < nt; t += 2) {
            const bool last = (t == nt - 2);
            const char* a1 = cA + (size_t)(t + 1) * kstep;
            const char* a2 = last ? nA : cA + (size_t)(t + 2) * kstep; const char* b2 = last ? nB : cB + (size_t)(t + 2) * kstep;
            const char* a3 = a2 + kstep; const char* b3 = b2 + kstep;
            if (last && has_next) S.a_ready(nxt);
            PG8_LDB(B0, 0, 0); PG8_LDB(B1, 0, 1); PG8_SCHED; PG8_LDA(At, 0, 0); PG8_STAGE(PG8_SA(1, 1), a1 + hstepA, voffA);
            PG8_WAIT_V(8); PG8_WAIT_L(0); PG8_BAR; PG8_MMA(0, 0, At, B0); PG8_MMA(0, 1, At, B1); PG8_BAR; PG8_SCHED;
            PG8_LDA(At, 0, 1); PG8_STAGE(PG8_SB(0, 0), b2, voffB); PG8_STAGE(PG8_SB(0, 1), b2 + hstepB, voffB); PG8_STAGE(PG8_SA(0, 0), a2, voffA);
            PG8_WAIT_V(8); PG8_WAIT_L(0); PG8_BAR; PG8_MMA(1, 0, At, B0); PG8_MMA(1, 1, At, B1); PG8_BAR; PG8_SCHED;
            PG8_LDB(B0, 1, 0); PG8_LDB(B1, 1, 1); PG8_SCHED; PG8_LDA(At, 1, 0); PG8_STAGE(PG8_SA(0, 1), a2 + hstepA, voffA);
            PG8_WAIT_V(8); PG8_WAIT_L(0); PG8_BAR; PG8_MMA(0, 0, At, B0); PG8_MMA(0, 1, At, B1); PG8_BAR; PG8_SCHED;
            PG8_LDA(At, 1, 1); PG8_STAGE(PG8_SB(1, 0), b3, voffB); PG8_STAGE(PG8_SB(1, 1), b3 + hstepB, voffB); PG8_STAGE(PG8_SA(1, 0), a3, voffA);
            PG8_WAIT_V(8); PG8_WAIT_L(0); PG8_BAR; PG8_MMA(1, 0, At, B0); PG8_MMA(1, 1, At, B1); PG8_BAR; PG8_SCHED;
        }
        if constexpr (ALIGN_EPI) { if (wr == 0) PG8_BAR; }
        E(acc, cur, wr, wc, fr, fq);
        if (!has_next) break;
#pragma unroll
        for (int a = 0; a < 2; ++a)
#pragma unroll
            for (int b = 0; b < 2; ++b)
#pragma unroll
                for (int m = 0; m < 4; ++m)
#pragma unroll
                    for (int n = 0; n < 2; ++n) acc[a][b][m][n] = (f32x4){0.f, 0.f, 0.f, 0.f};
        cur = nxt; cA = nA; cB = nB; ++ui;
        if constexpr (ALIGN_EPI) { if (wr == 1) PG8_BAR; }
    }
    PG8_WAIT_V(0);
    if constexpr (!ALIGN_EPI) { if (wr == 0) PG8_BAR; }
    PG8_BAR;
#undef PG8_SA
#undef PG8_SB
#undef PG8_STAGE
#undef PG8_LDA
#undef PG8_LDB
#undef PG8_MMA
#undef PG8_WAIT_V
#undef PG8_WAIT_L
#undef PG8_BAR
#undef PG8_SCHED
}
}

#define XB_TMO      128
#define XB_XCNT(j)  (256  + 64 * (j))
#define XB_XSUB(j)  (1280 + 64 * (j))
#define XB_XGEN(j)  (2304 + 64 * (j))
#define XB_TOP      3328
#define XB_TOPGEN   3392
#define XCD_BAR_WORDS 3456
#define XB_SPIN_CAP (1u << 22)
__device__ __forceinline__ unsigned xb_ld(unsigned* p)              { return __hip_atomic_load(p, __ATOMIC_RELAXED, __HIP_MEMORY_SCOPE_AGENT); }
__device__ __forceinline__ unsigned xb_add(unsigned* p, unsigned v) { return __hip_atomic_fetch_add(p, v, __ATOMIC_RELAXED, __HIP_MEMORY_SCOPE_AGENT); }
__device__ __forceinline__ unsigned xb_xcc_id() { return (unsigned)__builtin_amdgcn_s_getreg((3 << 11) | 20) & 0xFu; }
#define XB_SPIN(cond, bar) do { unsigned _sp = 0; while (cond) { __builtin_amdgcn_s_sleep(8); \
    if ((++_sp & 255u) == 0u) { if (xb_ld(&(bar)[XB_TMO])) break; if (_sp > XB_SPIN_CAP) { atomicAdd(&(bar)[XB_TMO], 1u); break; } } } } while (0)
struct XcdBarrier { unsigned* bar; unsigned x; volatile LAS unsigned* st; unsigned G; };
__device__ __forceinline__ XcdBarrier xcd_barrier_post(unsigned* bar, volatile LAS unsigned* st) {
    XcdBarrier b; b.bar = bar; b.x = xb_xcc_id(); b.st = st; b.G = 0;
    if (threadIdx.x == 0) (void)xb_add(&bar[XB_XCNT(b.x)], 1u);
    return b;
}
__device__ __forceinline__ void xcd_barrier_complete(unsigned* bar, unsigned x, unsigned G, unsigned& nloc, unsigned& nx) {
    unsigned sum, cnt, mine, sp = 0u;
    for (;;) {
        sum = 0u; cnt = 0u; mine = 0u;
#pragma unroll
        for (unsigned j = 0; j < 16; ++j) { const unsigned c = xb_ld(&bar[XB_XCNT(j)]); sum += c; cnt += (c > 0u) ? 1u : 0u; mine = (j == x) ? c : mine; }
        if (sum == G) break;
        __builtin_amdgcn_s_sleep(1);
        if ((++sp & 255u) == 0u) { if (xb_ld(&bar[XB_TMO])) break; if (sp > XB_SPIN_CAP) { atomicAdd(&bar[XB_TMO], 1u); break; } }
    }
    nloc = mine > 0u ? mine : 1u; nx = cnt > 0u ? cnt : 1u;
}
__device__ __forceinline__ void xcd_barrier(const XcdBarrier& b) {
    asm volatile("s_waitcnt vmcnt(0)" ::: "memory");
    __syncthreads();
    if (threadIdx.x == 0) {
        unsigned* bar = b.bar;
        __builtin_amdgcn_s_waitcnt(0);
        unsigned nloc = b.st[0], nx = b.st[1];
        if (nloc == 0u) { xcd_barrier_complete(bar, b.x, b.G, nloc, nx); b.st[0] = nloc; b.st[1] = nx; }
        const unsigned old = xb_add(&bar[XB_XSUB(b.x)], 1u);
        const unsigned gen = old / nloc;
        if (old + 1u == (gen + 1u) * nloc) {
            __builtin_amdgcn_fence(__ATOMIC_RELEASE, "agent");
            asm volatile("s_waitcnt vmcnt(0)" ::: "memory");
            const unsigned og = xb_add(&bar[XB_TOP], 1u);
            const unsigned tg = og / nx;
            if (og + 1u == (tg + 1u) * nx) xb_add(&bar[XB_TOPGEN], 1u);
            else XB_SPIN(xb_ld(&bar[XB_TOPGEN]) == tg, bar);
            __builtin_amdgcn_fence(__ATOMIC_ACQUIRE, "agent");
            xb_add(&bar[XB_XGEN(b.x)], 1u);
            asm volatile("s_waitcnt vmcnt(0)" ::: "memory");
        } else {
            XB_SPIN(xb_ld(&bar[XB_XGEN(b.x)]) == gen, bar);
            __builtin_amdgcn_fence(__ATOMIC_ACQUIRE, "agent");
            asm volatile("s_waitcnt vmcnt(0)" ::: "memory");
        }
    }
    __syncthreads();
}

template <int MODE>
__device__ __forceinline__ void transpose_item(const float* __restrict__ W, int K, int Nsrc, bf16* __restrict__ WT, LAS float* scr, int kb, int nb, int lane, const float* __restrict__ gk) {
    const int k0 = 64 * kb, n0 = 32 * nb;
    const int dstc = n0 + (lane & 31);
    int srcc = dstc;
    if (MODE == 1) srcc = dstc < 3072 ? dstc : (dstc < 3088 ? dstc - 3072 + 4096 : (dstc < 3328 ? -1 : (dstc < 3840 ? dstc - 3328 + 5392 : (dstc < 9984 ? dstc - 3840 + 6416 : (dstc < 11008 ? dstc - 9984 + 3072 :
                          (dstc < 11520 ? dstc - 11008 + 4112 : (dstc < 11776 ? dstc - 11520 + 4624 : (dstc < 12288 ? dstc - 11776 + 4880 : dstc - 12288 + 5904))))))));
    const bool ok = srcc >= 0; const int sc = ok ? srcc : 0;
    const float* wp = W + (size_t)(k0 + (lane >> 5)) * Nsrc + sc;
    float v[32];
#pragma unroll
    for (int i = 0; i < 32; ++i) v[i] = wp[(size_t)(2 * i) * Nsrc];
    if (gk) { float gv[32];
#pragma unroll
        for (int i = 0; i < 32; ++i) gv[i] = gk[k0 + 2 * i + (lane >> 5)];
#pragma unroll
        for (int i = 0; i < 32; ++i) v[i] *= gv[i]; }
#pragma unroll
    for (int i = 0; i < 32; ++i) scr[(2 * i + (lane >> 5)) * 33 + (lane & 31)] = ok ? v[i] : 0.f;
    LDS_WAIT(); asm volatile("" ::: "memory");
    const int c = lane & 7;
#pragma unroll
    for (int j = 0; j < 4; ++j) { const int n = (lane >> 3) + 8 * j; const LAS float* s = scr + (8 * c) * 33 + n;
        u32x4 o; o.x = cvt_pk_bf16(s[0 * 33], s[1 * 33]); o.y = cvt_pk_bf16(s[2 * 33], s[3 * 33]); o.z = cvt_pk_bf16(s[4 * 33], s[5 * 33]); o.w = cvt_pk_bf16(s[6 * 33], s[7 * 33]);
        *(u32x4*)(WT + (size_t)(n0 + n) * K + k0 + 8 * c) = o; }
    LDS_WAIT(); asm volatile("" ::: "memory");
}
__device__ __forceinline__ void rms_row_bf16(const float* xrow, const float* g, bf16* orow, int lane) {
    const f32x4* xr = (const f32x4*)xrow + lane; f32x4 v[8]; float s = 0.f;
#pragma unroll
    for (int j = 0; j < 8; ++j) { v[j] = xr[64 * j]; s += (v[j].x * v[j].x + v[j].y * v[j].y) + (v[j].z * v[j].z + v[j].w * v[j].w); }
    const float rstd = rsqrtf(wave_sum(s) * (1.f / D_) + EPS_);
    const f32x4* gr = (const f32x4*)g + lane;
    u32x2* o8 = (u32x2*)orow + lane;
    f32x4 gq[8];
#pragma unroll
    for (int j = 0; j < 8; ++j) gq[j] = gr[64 * j];
#pragma unroll
    for (int j = 0; j < 8; ++j) { const f32x4 gv = gq[j]; u32x2 w; w.x = cvt_pk_bf16(v[j].x * rstd * gv.x, v[j].y * rstd * gv.y); w.y = cvt_pk_bf16(v[j].z * rstd * gv.z, v[j].w * rstd * gv.w); o8[64 * j] = w; }
}
__device__ __forceinline__ void rms_row_f32_inplace(float* xrow, const float* g, int lane) {
    f32x4* xr = (f32x4*)xrow + lane; f32x4 v[8]; float s = 0.f;
#pragma unroll
    for (int j = 0; j < 8; ++j) { v[j] = xr[64 * j]; s += (v[j].x * v[j].x + v[j].y * v[j].y) + (v[j].z * v[j].z + v[j].w * v[j].w); }
    const float rstd = rsqrtf(wave_sum(s) * (1.f / D_) + EPS_);
    const f32x4* gr = (const f32x4*)g + lane;
#pragma unroll
    for (int j = 0; j < 8; ++j) { const f32x4 gv = gr[64 * j]; xr[64 * j] = v[j] * rstd * gv; }
}
__device__ __forceinline__ float red16(float v) { v += __shfl_xor(v, 1); v += __shfl_xor(v, 2); v += __shfl_xor(v, 4); v += __shfl_xor(v, 8); return v; }

typedef float f32x16 __attribute__((ext_vector_type(16)));
typedef __bf16 bf2v __attribute__((ext_vector_type(2)));
__device__ __forceinline__ unsigned pk2(float lo, float hi) { const f32x2 v = {lo, hi}; return __builtin_bit_cast(unsigned, __builtin_convertvector(v, bf2v)); }
#define MFMA16(a, b, c) __builtin_amdgcn_mfma_f32_16x16x32_bf16((a), (b), (c), 0, 0, 0)
#define MFMA32(a, b, c) __builtin_amdgcn_mfma_f32_32x32x16_bf16((a), (b), (c), 0, 0, 0)
constexpr int DU_NKW = 0, DU_QP = 32768, DU_BM = 49152, DU_OP = 81920, DU_BYTES = 98304;
constexpr int P_K = 0, P_Q = 17408, P_VBT = 52736, P_KBGT = 71168, P_KDT = 89600, P_TINV = 108032, P_QK = 117248, P_T11T = 126464, P_M1T = 129024, P_SM = 131584, P_CW = 132096, P_PS = 138240, P_QD = 142336, P_AB = 159744;
constexpr int LDK = 136, LDT = 72, LDL = 68, LDS40 = 40;
__device__ __forceinline__ bf16x8 ldfrag(const LAS bf16* mat, int ld, int row0, int k0, int fr, int fq) { return *(const LAS bf16x8*)(mat + (row0 + fr) * ld + k0 + 8 * fq); }

__device__ __forceinline__ void prep_stage_raw(LAS unsigned char* lds, const bf16* proj, const unsigned char* zero16, int t0, int hd, int tid) {
    const int lane = tid & 63, wave = __builtin_amdgcn_readfirstlane(tid >> 6);
#pragma unroll
    for (int q = 0; q < 7; ++q) {
        const int grp = wave + 8 * q, i = grp * 64 + lane, r = i / 49, c = i % 49, tt = t0 - 3 + r;
        const unsigned char* src = (c < 48 && tt >= 0) ? (const unsigned char*)(proj + (size_t)tt * NPROJ + (c >> 4) * 1024 + hd * 128 + 8 * (c & 15)) : zero16;
        if (i < 67 * 49) __builtin_amdgcn_global_load_lds((const unsigned*)src, (LAS unsigned*)(lds + grp * 1024), 16, 0, 0);
    }
    if (wave == 0) {
        const bf16* ap = proj + (size_t)(t0 + lane) * NPROJ + (hd & ~1);
        __builtin_amdgcn_global_load_lds((const unsigned*)(ap + PC_A), (LAS unsigned*)(lds + P_AB), 4, 0, 0);
        __builtin_amdgcn_global_load_lds((const unsigned*)(ap + PC_B), (LAS unsigned*)(lds + P_AB + 256), 4, 0, 0);
    }
}
__device__ __forceinline__ void delta_prep_unit(LAS unsigned char* lds, const bf16* proj, const float* convw  , float a_log, float dt_bias, unsigned char* dst  , float* gl_out, bf16* opb,
                                                int t0, int hd, int tid_in, const unsigned char* zero16, int next_t0) {
    const int tid = launder_v(tid_in);
    const int lane = tid & 63, wave = __builtin_amdgcn_readfirstlane(tid >> 6), fr = lane & 15, fq = lane >> 4;
    LAS bf16* Kk = (LAS bf16*)(lds + P_K); LAS bf16* Qq = (LAS bf16*)(lds + P_Q); LAS bf16* QD = (LAS bf16*)(lds + P_QD);
    LAS bf16* VBT = (LAS bf16*)(lds + P_VBT); LAS bf16* KBGT = (LAS bf16*)(lds + P_KBGT); LAS bf16* KDT = (LAS bf16*)(lds + P_KDT);
    LAS bf16* TINV = (LAS bf16*)(lds + P_TINV); LAS bf16* QK = (LAS bf16*)(lds + P_QK); LAS bf16* T11T = (LAS bf16*)(lds + P_T11T); LAS bf16* M1T = (LAS bf16*)(lds + P_M1T);
    LAS float* Lf = (LAS float*)(lds + P_Q); LAS float* gcs = (LAS float*)(lds + P_SM); LAS float* bts = gcs + 64;
    const float scale = 0.08838834764831845f;
    asm volatile("s_waitcnt lgkmcnt(0)" ::: "memory"); __builtin_amdgcn_s_barrier(); asm volatile("" ::: "memory");
    asm volatile("s_waitcnt vmcnt(16)" ::: "memory");
    if (wave == 0) {
        const unsigned aw = *(const LAS unsigned*)(lds + P_AB + lane * 4), bw = *(const LAS unsigned*)(lds + P_AB + 256 + lane * 4);
        const float a = (hd & 1) ? bf_hi(aw) : bf_lo(aw), b = (hd & 1) ? bf_hi(bw) : bf_lo(bw);
        float g = -__expf(a_log) * softplusf_(a + dt_bias);
#pragma unroll
        for (int off = 1; off < 64; off <<= 1) { const float nb = __shfl_up(g, off); if (lane >= off) g += nb; }
        gcs[lane] = g; bts[lane] = sigmoidf_(b);
        if (lane == 63) *gl_out = __expf(g);
    }
    asm volatile("s_waitcnt lgkmcnt(0)" ::: "memory"); __builtin_amdgcn_s_barrier(); asm volatile("" ::: "memory");
    LAS bf16* RAW = (LAS bf16*)lds;
    const LAS float* CW = (const LAS float*)(lds + P_CW);
    const int tok = lane, js = wave;
    LAS float* PS = (LAS float*)(lds + P_PS);
    float qv[16], kv[16], vv[16];
#pragma unroll
    for (int sec = 0; sec < 3; ++sec) {
        float acc[16];
#pragma unroll
        for (int i = 0; i < 16; ++i) acc[i] = 0.f;
#pragma unroll
        for (int tap = 0; tap < 4; ++tap) {
            const LAS bf16* rp = RAW + (tok + tap) * 392 + sec * 128 + 16 * js;
            const u32x4 r0 = *(const LAS u32x4*)rp, r1 = *(const LAS u32x4*)(rp + 8);
            const LAS float* wp = CW + tap * 384 + sec * 128 + 16 * js;
            const f32x4 w0 = *(const LAS f32x4*)(wp), w1 = *(const LAS f32x4*)(wp + 4), w2 = *(const LAS f32x4*)(wp + 8), w3 = *(const LAS f32x4*)(wp + 12);
            acc[0] += w0.x * bf_lo(r0.x); acc[1] += w0.y * bf_hi(r0.x); acc[2] += w0.z * bf_lo(r0.y); acc[3] += w0.w * bf_hi(r0.y);
            acc[4] += w1.x * bf_lo(r0.z); acc[5] += w1.y * bf_hi(r0.z); acc[6] += w1.z * bf_lo(r0.w); acc[7] += w1.w * bf_hi(r0.w);
            acc[8] += w2.x * bf_lo(r1.x); acc[9] += w2.y * bf_hi(r1.x); acc[10] += w2.z * bf_lo(r1.y); acc[11] += w2.w * bf_hi(r1.y);
            acc[12] += w3.x * bf_lo(r1.z); acc[13] += w3.y * bf_hi(r1.z); acc[14] += w3.z * bf_lo(r1.w); acc[15] += w3.w * bf_hi(r1.w);
        }
        float ss = 0.f;
#pragma unroll
        for (int i = 0; i < 16; ++i) { acc[i] = siluf_(acc[i]); ss += acc[i] * acc[i]; }
        if (sec < 2) PS[(sec * 8 + js) * 64 + tok] = ss;
#pragma unroll
        for (int i = 0; i < 16; ++i) { if (sec == 0) qv[i] = acc[i]; else if (sec == 1) kv[i] = acc[i]; else vv[i] = acc[i]; }
    }
    __syncthreads();
    {
        const float gc = gcs[tok], bt = bts[tok], gclast = gcs[63];
        const float eg = __expf(gc), sq = scale * eg, ekd = __expf(gclast - gc), bkg = bt * eg;
        { float sq2 = 0.f, sk2 = 0.f;
#pragma unroll
          for (int w8 = 0; w8 < 8; ++w8) { sq2 += PS[w8 * 64 + tok]; sk2 += PS[(8 + w8) * 64 + tok]; }
          const float rq = rsqrtf(sq2 + EPS_), rk = rsqrtf(sk2 + EPS_);
#pragma unroll
          for (int i = 0; i < 16; ++i) { qv[i] *= rq; kv[i] *= rk; } }
        u32x4 w;
        LAS bf16* kr = Kk + tok * LDK + 16 * js; LAS bf16* qr = Qq + tok * LDK + 16 * js; LAS bf16* qdr = QD + tok * LDK + 16 * js;
        w.x = pk2(kv[0], kv[1]); w.y = pk2(kv[2], kv[3]); w.z = pk2(kv[4], kv[5]); w.w = pk2(kv[6], kv[7]); *(LAS u32x4*)kr = w;
        w.x = pk2(kv[8], kv[9]); w.y = pk2(kv[10], kv[11]); w.z = pk2(kv[12], kv[13]); w.w = pk2(kv[14], kv[15]); *(LAS u32x4*)(kr + 8) = w;
        w.x = pk2(qv[0], qv[1]); w.y = pk2(qv[2], qv[3]); w.z = pk2(qv[4], qv[5]); w.w = pk2(qv[6], qv[7]); *(LAS u32x4*)qr = w;
        w.x = pk2(qv[8], qv[9]); w.y = pk2(qv[10], qv[11]); w.z = pk2(qv[12], qv[13]); w.w = pk2(qv[14], qv[15]); *(LAS u32x4*)(qr + 8) = w;
        w.x = pk2(sq * qv[0], sq * qv[1]); w.y = pk2(sq * qv[2], sq * qv[3]); w.z = pk2(sq * qv[4], sq * qv[5]); w.w = pk2(sq * qv[6], sq * qv[7]); *(LAS u32x4*)qdr = w;
        w.x = pk2(sq * qv[8], sq * qv[9]); w.y = pk2(sq * qv[10], sq * qv[11]); w.z = pk2(sq * qv[12], sq * qv[13]); w.w = pk2(sq * qv[14], sq * qv[15]); *(LAS u32x4*)(qdr + 8) = w;
#pragma unroll
        for (int i = 0; i < 16; ++i) {
            const int c = 16 * js + i;
            VBT[c * LDT + tok] = (bf16)(pk2(bt * vv[i], 0.f) & 0xffffu);
            KBGT[c * LDT + tok] = (bf16)(pk2(bkg * kv[i], 0.f) & 0xffffu);
            KDT[c * LDT + tok] = (bf16)(pk2(ekd * kv[i], 0.f) & 0xffffu);
        }
    }
    __syncthreads();
    const f32x4 z4 = {0.f, 0.f, 0.f, 0.f};
#pragma unroll
    for (int rep = 0; rep < 2; ++rep) {
        const int id = wave + 8 * rep, it = id >> 2, jt = id & 3;
        const int i = 16 * it + fr, j0 = 16 * jt + 4 * fq;
        u32x2 o = {0u, 0u};
        if (it >= jt) {
            f32x4 acc = z4;
#pragma unroll
            for (int ks = 0; ks < 4; ++ks) acc = MFMA16(ldfrag(Kk, LDK, 16 * jt, 32 * ks, fr, fq), ldfrag(Qq, LDK, 16 * it, 32 * ks, fr, fq), acc);
            const float gi = gcs[i]; float v[4];
#pragma unroll
            for (int r = 0; r < 4; ++r) v[r] = (i >= j0 + r) ? scale * acc[r] * __expf(gi - gcs[j0 + r]) : 0.f;
            o.x = pk2(v[0], v[1]); o.y = pk2(v[2], v[3]);
        }
        *(LAS u32x2*)(QK + i * LDT + j0) = o;
    }
    __syncthreads();
#pragma unroll
    for (int rep = 0; rep < 2; ++rep) {
        const int id = wave + 8 * rep, it = id >> 2, jt = id & 3;
        const int i = 16 * it + fr, j0 = 16 * jt + 4 * fq;
        f32x4 v = z4;
        if (it >= jt) {
            f32x4 acc = z4;
#pragma unroll
            for (int ks = 0; ks < 4; ++ks) acc = MFMA16(ldfrag(Kk, LDK, 16 * jt, 32 * ks, fr, fq), ldfrag(Kk, LDK, 16 * it, 32 * ks, fr, fq), acc);
            const float gi = gcs[i], bi = bts[i];
#pragma unroll
            for (int r = 0; r < 4; ++r) v[r] = (i > j0 + r) ? bi * acc[r] * __expf(gi - gcs[j0 + r]) : 0.f;
        }
        *(LAS f32x4*)(Lf + i * LDL + j0) = v;
        if ((it >= 2) != (jt >= 2)) { u32x2 o; o.x = pk2(v[0], v[1]); o.y = pk2(v[2], v[3]); *(LAS u32x2*)(TINV + i * LDT + j0) = o; }
    }
    __syncthreads();
    if (wave < 2) {
        const int off = 32 * wave, c = lane & 31;
        float A[32];
#pragma unroll
        for (int i = 0; i < 32; ++i) {
            float lrow = Lf[(off + i) * LDL + off + c];
            if (i > 0) asm volatile("" : "+v"(lrow) : "v"(A[i - 1]));
            float a0 = -lrow, a1 = 0.f;
#pragma unroll
            for (int j = 0; j < i; ++j) { const float s = __uint_as_float(__builtin_amdgcn_readlane(__float_as_uint(lrow), j)); if (j & 1) a1 -= s * A[j]; else a0 -= s * A[j]; }
            A[i] = a0 + a1;
        }
        if (lane < 32) {
#pragma unroll
            for (int j = 0; j < 32; ++j) TINV[(off + j) * LDT + off + c] = (bf16)(pk2(A[j] + (j == c ? 1.f : 0.f), 0.f) & 0xffffu);
            if (wave == 0) {
#pragma unroll
                for (int j = 0; j < 32; j += 2) *(LAS unsigned*)(T11T + c * LDS40 + j) = pk2(A[j] + (j == c ? 1.f : 0.f), A[j + 1] + (j + 1 == c ? 1.f : 0.f));
            }
        }
    }
    __syncthreads();
    if (wave < 4) {
        const int mt = wave >> 1, nt = wave & 1;
        const f32x4 acc = MFMA16(ldfrag(TINV, LDT, 32 + 16 * mt, 0, fr, fq), ldfrag(T11T, LDS40, 16 * nt, 0, fr, fq), z4);
        u32x2 o; o.x = pk2(acc[0], acc[1]); o.y = pk2(acc[2], acc[3]);
        *(LAS u32x2*)(M1T + (16 * nt + fr) * LDS40 + 16 * mt + 4 * fq) = o;
    }
    __syncthreads();
    if (wave < 4) {
        const int itl = wave >> 1, ct = wave & 1;
        const f32x4 acc = MFMA16(ldfrag(M1T, LDS40, 16 * ct, 0, fr, fq), ldfrag(TINV + 32, LDT, 32 + 16 * itl, 0, fr, fq), z4);
        u32x2 o; o.x = pk2(-acc[0], -acc[1]); o.y = pk2(-acc[2], -acc[3]);
        *(LAS u32x2*)(TINV + (32 + 16 * itl + fr) * LDT + 16 * ct + 4 * fq) = o;
    }
    __syncthreads();
    {
        bf16x8 at[4][2];
#pragma unroll
        for (int mt = 0; mt < 4; ++mt)
#pragma unroll
            for (int ks = 0; ks < 2; ++ks) at[mt][ks] = ldfrag(TINV, LDT, 16 * mt, 32 * ks, fr, fq);
        bf16x8 bv[2], bk[2];
#pragma unroll
        for (int ks = 0; ks < 2; ++ks) { bv[ks] = ldfrag(VBT, LDT, 16 * wave, 32 * ks, fr, fq); bk[ks] = ldfrag(KBGT, LDT, 16 * wave, 32 * ks, fr, fq); }
        f32x4 au[4], aw[4];
#pragma unroll
        for (int mt = 0; mt < 4; ++mt) { au[mt] = z4; aw[mt] = z4;
#pragma unroll
            for (int ks = 0; ks < 2; ++ks) { au[mt] = MFMA16(at[mt][ks], bv[ks], au[mt]); aw[mt] = MFMA16(at[mt][ks], bk[ks], aw[mt]); } }
#pragma unroll
        for (int mt = 0; mt < 4; ++mt) {
            u32x2 o; o.x = pk2(au[mt][0], au[mt][1]); o.y = pk2(au[mt][2], au[mt][3]); *(LAS u32x2*)(VBT + (16 * wave + fr) * LDT + 16 * mt + 4 * fq) = o;
            o.x = pk2(aw[mt][0], aw[mt][1]); o.y = pk2(aw[mt][2], aw[mt][3]); *(LAS u32x2*)(KBGT + (16 * wave + fr) * LDT + 16 * mt + 4 * fq) = o;
        }
    }
    __syncthreads();
    LAS bf16* UT = VBT; LAS bf16* WT = KBGT;
    if (next_t0 >= 0) {
        prep_stage_raw(lds, proj, zero16, next_t0, hd, tid);
    }
    asm volatile("" ::: "memory"); __builtin_amdgcn_sched_barrier(0);
    {
        bf16x8 kd[2];
#pragma unroll
        for (int ks = 0; ks < 2; ++ks) kd[ks] = ldfrag(KDT, LDT, 16 * wave, 32 * ks, fr, fq);
#pragma unroll 2
        for (int nt = 0; nt < 8; ++nt) {
            f32x4 an = z4, ab = z4;
#pragma unroll
            for (int ks = 0; ks < 2; ++ks) { an = MFMA16(ldfrag(WT, LDT, 16 * nt, 32 * ks, fr, fq), kd[ks], an); ab = MFMA16(kd[ks], ldfrag(UT, LDT, 16 * nt, 32 * ks, fr, fq), ab); }
            { const int m = 16 * wave + fr; u32x2 o; o.x = pk2(-an[0], -an[1]); o.y = pk2(-an[2], -an[3]);
              *(u32x2*)(dst + DU_NKW + ((((m >> 5) * 8 + nt) * 64 + (m & 31) + 32 * (fq & 1)) * 16) + 8 * (fq >> 1)) = o; }
            { const int dv = 16 * nt + fr, d = 16 * wave + 4 * fq, rr = d & 31; u32x2 o; o.x = pk2(ab[0], ab[1]); o.y = pk2(ab[2], ab[3]);
              *(u32x2*)(dst + DU_BM + (((((dv >> 5) * 4 + (d >> 5)) * 64 + (dv & 31) + 32 * ((rr >> 2) & 1)) * 16 + 4 * (rr >> 3)) * 2)) = o; }
        }
    }
    {
        bf16x8 wt[2], ut[2];
#pragma unroll
        for (int ks = 0; ks < 2; ++ks) { wt[ks] = ldfrag(WT, LDT, 16 * wave, 32 * ks, fr, fq); ut[ks] = ldfrag(UT, LDT, 16 * wave, 32 * ks, fr, fq); }
#pragma unroll 2
        for (int it = 0; it < 4; ++it) {
            f32x4 aq = z4, ao = z4;
#pragma unroll
            for (int ks = 0; ks < 2; ++ks) { const bf16x8 qf = ldfrag(QK, LDT, 16 * it, 32 * ks, fr, fq); aq = MFMA16(wt[ks], qf, aq); ao = MFMA16(ut[ks], qf, ao); }
            { const int i = 16 * it + fr; const u32x2 qd = *(const LAS u32x2*)(QD + i * LDK + 16 * wave + 4 * fq);
              u32x2 o; o.x = pk2(bf_lo(qd.x) - aq[0], bf_hi(qd.x) - aq[1]); o.y = pk2(bf_lo(qd.y) - aq[2], bf_hi(qd.y) - aq[3]);
              *(u32x2*)(dst + DU_QP + ((((i >> 5) * 8 + wave) * 64 + (i & 31) + 32 * (fq & 1)) * 16) + 8 * (fq >> 1)) = o; }
            { u32x2 o; o.x = pk2(ao[0], ao[1]); o.y = pk2(ao[2], ao[3]); *(u32x2*)(opb + (size_t)(t0 + 16 * it + fr) * 1024 + hd * 128 + 16 * wave + 4 * fq) = o; }
        }
    }
}

__device__ __forceinline__ void delta_scan_head(LAS unsigned char* lds, const unsigned char* dprep  , const float* gl, bf16* oraw, int hd, int tid) {
    const int lane = tid & 63, wave = __builtin_amdgcn_readfirstlane(tid >> 6);
    constexpr int NCH = S_ / 64, SLOT = 49152, OBUF = 3 * SLOT;
    const unsigned char* ub = dprep + (size_t)hd * (S_ / 64) * DU_BYTES;
    constexpr size_t CSTEP = (size_t)DU_BYTES;
    volatile LAS unsigned* MISCW = (volatile LAS unsigned*)(lds + MISC_OFF);
    __syncthreads();
    const unsigned sv0 = MISCW[8], sv1 = MISCW[9], sv2 = MISCW[10], sv3 = MISCW[11];
    __syncthreads();
#define SCAN_STAGE(n_, slot_) do { const unsigned char* src_ = ub + (size_t)(n_) * CSTEP + lane * 16; \
        _Pragma("unroll") for (int q_ = 0; q_ < 24; ++q_) { const int idx_ = (wave - 4) + 2 * q_; \
            __builtin_amdgcn_global_load_lds((const unsigned*)(src_ + idx_ * 1024), (LAS unsigned*)(lds + (slot_) * SLOT + idx_ * 1024), 16, 0, 0); } } while (0)
#define SCAN_FLUSH(n_) do { const int v_ = wave - 6; u32x4 t_[8]; \
        _Pragma("unroll") for (int i_ = 0; i_ < 8; ++i_) { const int tok_ = 32 * v_ + 4 * i_ + (lane >> 4), ck_ = (lane & 15) ^ (tok_ & 15); t_[i_] = *(const LAS u32x4*)(lds + OBUF + tok_ * 256 + ck_ * 16); } \
        _Pragma("unroll") for (int i_ = 0; i_ < 8; ++i_) { const int tok_ = 32 * v_ + 4 * i_ + (lane >> 4); *(u32x4*)(oraw + (size_t)(64 * (n_) + tok_) * 1024 + hd * 128 + 8 * (lane & 15)) = t_[i_]; } } while (0)
    if (wave >= 6) {
        __builtin_amdgcn_s_barrier(); asm volatile("" ::: "memory");
#pragma unroll 1
        for (int n = 0; n < NCH; ++n) {
            if (n > 0) SCAN_FLUSH(n - 1);
            asm volatile("s_waitcnt lgkmcnt(0)" ::: "memory");
            __builtin_amdgcn_s_barrier(); asm volatile("" ::: "memory");
            __builtin_amdgcn_s_barrier(); asm volatile("" ::: "memory");
        }
        SCAN_FLUSH(NCH - 1);
    } else if (wave >= 4) {
        SCAN_STAGE(0, 0); SCAN_STAGE(1, 1);
        asm volatile("s_waitcnt vmcnt(24)" ::: "memory");
        __builtin_amdgcn_s_barrier(); asm volatile("" ::: "memory");
#pragma unroll 1
        for (int n = 0; n < NCH; ++n) {
            if (n + 2 < NCH) { SCAN_STAGE(n + 2, (n + 2) % 3); asm volatile("s_waitcnt vmcnt(24)" ::: "memory"); }
            else asm volatile("s_waitcnt vmcnt(0)" ::: "memory");
            __builtin_amdgcn_s_barrier(); asm volatile("" ::: "memory");
            __builtin_amdgcn_s_barrier(); asm volatile("" ::: "memory");
        }
    } else {
        f32x16 Sacc[4];
#pragma unroll
        for (int mt = 0; mt < 4; ++mt)
#pragma unroll
            for (int r = 0; r < 16; ++r) Sacc[mt][r] = 0.f;
        u32x4 bc[16];
        float gq2[2];
#pragma unroll
        for (int par = 0; par < 2; ++par) {
            const u32x4* bp = (const u32x4*)(ub + (size_t)par * CSTEP + DU_BM + (size_t)(wave * 4 * 64 + lane) * 32);
#pragma unroll
            for (int mt = 0; mt < 4; ++mt) { bc[8 * par + 2 * mt] = bp[mt * 128]; bc[8 * par + 2 * mt + 1] = bp[mt * 128 + 1]; }
            gq2[par] = gl[par * 8 + hd];
        }
        asm volatile("" ::: "memory");
        __builtin_amdgcn_s_barrier(); asm volatile("" ::: "memory");
#pragma unroll 1
        for (int n2 = 0; n2 < NCH; n2 += 2) {
#pragma unroll
          for (int par = 0; par < 2; ++par) {
            const int n = n2 + par;
            const int slot = n % 3;
            const float g = gq2[par];
            bf16x8 Sb[8];
#define SCAN_PACK(k_) do { constexpr int mt_ = (k_) >> 1, s_ = (k_) & 1; u32x4 p_; p_.x = pk2(Sacc[mt_][8 * s_], Sacc[mt_][8 * s_ + 1]); p_.y = pk2(Sacc[mt_][8 * s_ + 2], Sacc[mt_][8 * s_ + 3]); \
                p_.z = pk2(Sacc[mt_][8 * s_ + 4], Sacc[mt_][8 * s_ + 5]); p_.w = pk2(Sacc[mt_][8 * s_ + 6], Sacc[mt_][8 * s_ + 7]); Sb[k_] = __builtin_bit_cast(bf16x8, p_); } while (0)
#define SCAN_CINIT(h_) do { const int p_ = (h_) >> 1, mt_ = p_ >> 1, h2_ = p_ & 1, hf_ = (h_) & 1, e_ = 8 * h2_ + 4 * hf_; const u32x4 b_ = bc[8 * par + 2 * mt_ + h2_]; const unsigned w0_ = hf_ ? b_.z : b_.x, w1_ = hf_ ? b_.w : b_.y; \
                Sacc[mt_][e_ + 0] = g * Sacc[mt_][e_ + 0] + bf_lo(w0_); Sacc[mt_][e_ + 1] = g * Sacc[mt_][e_ + 1] + bf_hi(w0_); \
                Sacc[mt_][e_ + 2] = g * Sacc[mt_][e_ + 2] + bf_lo(w1_); Sacc[mt_][e_ + 3] = g * Sacc[mt_][e_ + 3] + bf_hi(w1_); } while (0)
            SCAN_PACK(0); SCAN_PACK(1); SCAN_PACK(2); SCAN_PACK(3);
            const LAS bf16x8* fr0 = (const LAS bf16x8*)(lds + slot * SLOT + lane * 16);
            constexpr int PD = 4;
            bf16x8 fa[PD];
#define SCAN_FIDX(f_) (((f_) < 16) ? 32 + (f_) : (f_) - 16)
#pragma unroll
            for (int i = 0; i < PD; ++i) fa[i] = fr0[SCAN_FIDX(i) * 64];
            const int nn = (n + 2 < NCH) ? n + 2 : n;
            const u32x4* bpn = (const u32x4*)(ub + (size_t)nn * CSTEP + DU_BM + (size_t)(wave * 4 * 64 + lane) * 32);
            gq2[par] = gl[nn * 8 + hd];
            f32x16 oacc[2];
            __builtin_amdgcn_sched_barrier(0);
#pragma unroll
            for (int f = 0; f < 16; ++f) {
                const bf16x8 a = fa[f % PD];
                fa[f % PD] = fr0[SCAN_FIDX(f + PD) * 64];
                if ((f & 7) == 0) { f32x16 z16;
#pragma unroll
                    for (int r = 0; r < 16; ++r) z16[r] = 0.f;
                    oacc[f >> 3] = MFMA32(Sb[f & 7], a, z16); }
                else oacc[f >> 3] = MFMA32(Sb[f & 7], a, oacc[f >> 3]);
                if (f == 0) SCAN_PACK(4); if (f == 2) SCAN_PACK(5); if (f == 4) SCAN_PACK(6); if (f == 6) SCAN_PACK(7);
                SCAN_CINIT(f);
                if ((f & 3) == 3) { bc[8 * par + 2 * (f >> 2)] = bpn[(f >> 2) * 128]; bc[8 * par + 2 * (f >> 2) + 1] = bpn[(f >> 2) * 128 + 1]; }
                __builtin_amdgcn_sched_barrier(0);
            }
#pragma unroll
            for (int f = 16; f < 48; ++f) {
                const bf16x8 a = fa[f % PD];
                if (f + PD < 48) fa[f % PD] = fr0[SCAN_FIDX(f + PD) * 64];
                Sacc[(f - 16) >> 3] = MFMA32(a, Sb[f & 7], Sacc[(f - 16) >> 3]);
            }
#undef SCAN_FIDX
#undef SCAN_PACK
#undef SCAN_CINIT
#pragma unroll
            for (int f = 16; f < 48 - PD; ++f) { __builtin_amdgcn_sched_group_barrier(0x008, 1, 0); __builtin_amdgcn_sched_group_barrier(0x100, 1, 0); }
            __builtin_amdgcn_sched_group_barrier(0x008, PD, 0);
            asm volatile("s_waitcnt lgkmcnt(0)" ::: "memory");
            __builtin_amdgcn_s_barrier(); asm volatile("" ::: "memory");
#pragma unroll
            for (int mt = 0; mt < 2; ++mt) { const int tok = 32 * mt + (lane & 31);
#pragma unroll
                for (int gq = 0; gq < 4; ++gq) { u32x2 w; w.x = pk2(oacc[mt][4 * gq], oacc[mt][4 * gq + 1]); w.y = pk2(oacc[mt][4 * gq + 2], oacc[mt][4 * gq + 3]);
                    *(LAS u32x2*)(lds + OBUF + tok * 256 + (((4 * wave + gq) ^ (tok & 15)) * 16) + 8 * (lane >> 5)) = w; } }
            asm volatile("s_waitcnt lgkmcnt(0)" ::: "memory");
            __builtin_amdgcn_s_barrier(); asm volatile("" ::: "memory");
          }
        }
    }
    __syncthreads();
    if (tid == 0) { MISCW[8] = sv0; MISCW[9] = sv1; MISCW[10] = sv2; MISCW[11] = sv3; }
    __syncthreads();
#undef SCAN_STAGE
#undef SCAN_FLUSH
}

__device__ __forceinline__ int vt_pos(int key) { const int kk = key & 15; return (key & ~15) + 8 * ((kk >> 2) & 1) + 4 * (kk >> 3) + (kk & 3); }
template <int DH, int NKEYS>
__device__ __forceinline__ void stage_k(LAS bf16* Kl, const bf16* __restrict__ src, int gld, int kbase, int tid, bool zero) {
    constexpr int CPR = DH / 8, NIT = NKEYS * CPR / 512;
    u32x4 v[NIT];
#pragma unroll
    for (int it = 0; it < NIT; ++it) { const int ci = tid + 512 * it, r = ci / CPR, c = ci % CPR; const unsigned z0 = (unsigned)launder_v(0); v[it] = (u32x4){z0, z0, z0, z0}; if (!zero) v[it] = *(const u32x4*)(src + (size_t)r * gld + 8 * c); }
#pragma unroll
    for (int it = 0; it < NIT; ++it) { const int ci = tid + 512 * it, r = ci / CPR, c = ci % CPR; *(LAS u32x4*)(Kl + (kbase + r) * (DH + 8) + 8 * c) = v[it]; }
}
template <int DH, int NKEYS>
__device__ __forceinline__ void stage_vt(LAS bf16* Vt, int ldv, const bf16* __restrict__ src, int gld, int kbase, int tid, bool zero) {
    constexpr int CPR = DH / 8, NIT = NKEYS * CPR / 512;
    u32x4 v[NIT];
#pragma unroll
    for (int it = 0; it < NIT; ++it) { const int ci = tid + 512 * it, r = ci % NKEYS, c = ci / NKEYS; const unsigned z0 = (unsigned)launder_v(0); v[it] = (u32x4){z0, z0, z0, z0}; if (!zero) v[it] = *(const u32x4*)(src + (size_t)r * gld + 8 * c); }
#pragma unroll
    for (int it = 0; it < NIT; ++it) { const int ci = tid + 512 * it, r = ci % NKEYS, c = ci / NKEYS;
        LAS bf16* d = Vt + (8 * c) * ldv + vt_pos(kbase + r); const u32x4 w = v[it];
        d[0] = (bf16)(w.x & 0xffffu); d[ldv] = (bf16)(w.x >> 16); d[2 * ldv] = (bf16)(w.y & 0xffffu); d[3 * ldv] = (bf16)(w.y >> 16);
        d[4 * ldv] = (bf16)(w.z & 0xffffu); d[5 * ldv] = (bf16)(w.z >> 16); d[6 * ldv] = (bf16)(w.w & 0xffffu); d[7 * ldv] = (bf16)(w.w >> 16); }
}
template <int DH>
__device__ __forceinline__ void stage_k_loop(LAS bf16* Kl, const bf16* src, int gld, int nkeys, int kbase, int tid) {
    constexpr int CPR = DH / 8;
    for (int ci = tid; ci < nkeys * CPR; ci += 512) { const int r = ci / CPR, c = ci % CPR;
        const u32x4 v = *(const u32x4*)(src + (size_t)r * gld + 8 * c);
        *(LAS u32x4*)(Kl + (kbase + r) * (DH + 8) + 8 * c) = v; }
}
template <int DH>
__device__ __forceinline__ void stage_vt_loop(LAS bf16* Vt, int ldv, const bf16* src, int gld, int nkeys, int kbase, int tid) {
    constexpr int CPR = DH / 8;
    for (int ci = tid; ci < nkeys * CPR; ci += 512) { const int r = ci % nkeys, c = ci / nkeys;
        const u32x4 v = *(const u32x4*)(src + (size_t)r * gld + 8 * c);
        LAS bf16* d = Vt + (8 * c) * ldv + vt_pos(kbase + r);
        d[0] = (bf16)(v.x & 0xffffu); d[ldv] = (bf16)(v.x >> 16); d[2 * ldv] = (bf16)(v.y & 0xffffu); d[3 * ldv] = (bf16)(v.y >> 16);
        d[4 * ldv] = (bf16)(v.z & 0xffffu); d[5 * ldv] = (bf16)(v.z >> 16); d[6 * ldv] = (bf16)(v.w & 0xffffu); d[7 * ldv] = (bf16)(v.w >> 16); }
}
__device__ __forceinline__ bf16x8 pack8(const f32x16& x, int s) {
    u32x4 p; p.x = pk2(x[8 * s], x[8 * s + 1]); p.y = pk2(x[8 * s + 2], x[8 * s + 3]); p.z = pk2(x[8 * s + 4], x[8 * s + 5]); p.w = pk2(x[8 * s + 6], x[8 * s + 7]);
    return __builtin_bit_cast(bf16x8, p);
}
__device__ __forceinline__ int crow16(int reg, int h) { return (reg & 3) + 8 * (reg >> 2) + 4 * h; }
__device__ __forceinline__ void store_ot(bf16* orow  , const f32x16& o, float inv, int h) {
#pragma unroll
    for (int g = 0; g < 4; ++g) { u32x2 w; w.x = pk2(o[4 * g] * inv, o[4 * g + 1] * inv); w.y = pk2(o[4 * g + 2] * inv, o[4 * g + 3] * inv); *(u32x2*)(orow + 8 * g + 4 * h) = w; }
}

__device__ __forceinline__ void swa_unit(LAS unsigned char* lds, const bf16* proj, const float* sinks, bf16* y, int kvh, int b, int tid) {
    const int lane = tid & 63, wave = __builtin_amdgcn_readfirstlane(tid >> 6), c = lane & 31, h = lane >> 5;
    LAS bf16* Kl = (LAS bf16*)lds;
    LAS bf16* Vt = (LAS bf16*)(lds + 36864);
    constexpr int LDV = 264;
    __syncthreads();
    const bf16* kg = proj + PC_SWAK + kvh * 64; const bf16* vg = proj + PC_SWAV + kvh * 64;
    if (b > 0) { stage_k<64, 256>(Kl, kg + (size_t)(128 * (b - 1)) * NPROJ, NPROJ, 0, tid, false); stage_vt<64, 256>(Vt, LDV, vg + (size_t)(128 * (b - 1)) * NPROJ, NPROJ, 0, tid, false); }
    else { stage_k<64, 128>(Kl, kg, NPROJ, 0, tid, true); stage_vt<64, 128>(Vt, LDV, vg, NPROJ, 0, tid, true);
           stage_k<64, 128>(Kl, kg, NPROJ, 128, tid, false); stage_vt<64, 128>(Vt, LDV, vg, NPROJ, 128, tid, false); }
    __syncthreads();
#pragma unroll 1
    for (int rep = 0; rep < 2; ++rep) {
        const int id = wave + 8 * rep, qh = id >> 2, qo = 32 * (id & 3), hg = 4 * kvh + qh;
        const int cL = launder_v(c), hL = launder_v(h);
        const int t = 128 * b + qo + c;
        const float slope = exp2f(-(float)(hg + 1)), sink = sinks[hg];
        bf16x8 qf[4];
#pragma unroll
        for (int ks = 0; ks < 4; ++ks) qf[ks] = *(const bf16x8*)(proj + (size_t)t * NPROJ + PC_SWAQ + hg * 64 + 16 * ks + 8 * h);
        f32x16 sc[5];
        const int kt0 = qo >> 5;
        float mx = -INFINITY;
#pragma unroll
        for (int j5 = 0; j5 < 5; ++j5) {
            const int kt = kt0 + j5;
            f32x16 acc;
#pragma unroll
            for (int r = 0; r < 16; ++r) acc[r] = 0.f;
#pragma unroll
            for (int ks = 0; ks < 4; ++ks) acc = MFMA32(*(const LAS bf16x8*)(Kl + (32 * kt + c) * 72 + 16 * ks + 8 * h), qf[ks], acc);
            const int dbase = launder_v(cL + 128 - 32 * j5 - 4 * hL);
#pragma unroll
            for (int r = 0; r < 16; ++r) { const int dist = dbase - ((r & 3) + 8 * (r >> 2)); const int kl = qo + cL + 128 - dist;
                const bool valid = (dist >= 0) && (dist < 128) && (b > 0 || kl >= 128);
                const float s = valid ? acc[r] * 0.125f - slope * (float)dist : -INFINITY; acc[r] = s; mx = fmaxf(mx, s); }
            sc[j5] = acc;
        }
        mx = fmaxf(mx, __shfl_xor(mx, 32)); mx = fmaxf(mx, sink);
        float sum = 0.f;
#pragma unroll
        for (int j5 = 0; j5 < 5; ++j5)
#pragma unroll
            for (int r = 0; r < 16; ++r) { const float p = __expf(sc[j5][r] - mx); sc[j5][r] = p; sum += p; }
        sum += __shfl_xor(sum, 32); sum += __expf(sink - mx);
        f32x16 o[2];
#pragma unroll
        for (int mt = 0; mt < 2; ++mt)
#pragma unroll
            for (int r = 0; r < 16; ++r) o[mt][r] = 0.f;
#pragma unroll
        for (int j5 = 0; j5 < 5; ++j5)
#pragma unroll
            for (int s = 0; s < 2; ++s) { const bf16x8 pf = pack8(sc[j5], s); const int kstep = 2 * (kt0 + j5) + s;
#pragma unroll
                for (int mt = 0; mt < 2; ++mt) o[mt] = MFMA32(*(const LAS bf16x8*)(Vt + (32 * mt + c) * LDV + 16 * kstep + 8 * h), pf, o[mt]); }
        const float inv = 1.f / sum;
#pragma unroll
        for (int mt = 0; mt < 2; ++mt) store_ot(y + (size_t)t * 2048 + 1024 + hg * 64 + 32 * mt, o[mt], inv, h);
    }
}

__device__ __forceinline__ void xattn_unit(LAS unsigned char* lds, const bf16* xq, const bf16* kv  , bf16* xo, int hd, int qb, int tid) {
    const int lane = tid & 63, wave = __builtin_amdgcn_readfirstlane(tid >> 6), c = lane & 31, h = lane >> 5;
    LAS bf16* Kl = (LAS bf16*)lds;
    LAS bf16* Vt = (LAS bf16*)(lds + 69632);
    constexpr int LDV = 264;
    const float scale = 0.08838834764831845f;
    __syncthreads();
    stage_k<128, 128>(Kl, kv + hd * 128, 1024, 0, tid, false); stage_vt<128, 128>(Vt, LDV, kv + 512 + hd * 128, 1024, 0, tid, false);
    stage_k<128, 128>(Kl, kv + (size_t)128 * 1024 + hd * 128, 1024, 128, tid, false); stage_vt<128, 128>(Vt, LDV, kv + (size_t)128 * 1024 + 512 + hd * 128, 1024, 128, tid, false);
    __syncthreads();
    const int t = 256 * qb + 32 * wave + c;
    bf16x8 qf[8];
#pragma unroll
    for (int ks = 0; ks < 8; ++ks) qf[ks] = *(const bf16x8*)(xq + (size_t)t * 512 + hd * 128 + 16 * ks + 8 * h);
    f32x16 o[4];
#pragma unroll
    for (int mt = 0; mt < 4; ++mt)
#pragma unroll
        for (int r = 0; r < 16; ++r) o[mt][r] = 0.f;
    float mrun = -INFINITY, sum = 0.f;
#pragma unroll 1
    for (int half = 0; half < 2; ++half) {
        f32x16 sc[4]; float mx = -INFINITY;
#pragma unroll
        for (int j4 = 0; j4 < 4; ++j4) { const int kt = 4 * half + j4; f32x16 acc;
#pragma unroll
            for (int r = 0; r < 16; ++r) acc[r] = 0.f;
#pragma unroll
            for (int ks = 0; ks < 8; ++ks) acc = MFMA32(*(const LAS bf16x8*)(Kl + (32 * kt + c) * 136 + 16 * ks + 8 * h), qf[ks], acc);
#pragma unroll
            for (int r = 0; r < 16; ++r) { acc[r] *= scale; mx = fmaxf(mx, acc[r]); }
            sc[j4] = acc; }
        mx = fmaxf(mx, __shfl_xor(mx, 32));
        const float mnew = fmaxf(mrun, mx), resc = __expf(mrun - mnew);
        float ps = 0.f;
#pragma unroll
        for (int j4 = 0; j4 < 4; ++j4)
#pragma unroll
            for (int r = 0; r < 16; ++r) { const float p = __expf(sc[j4][r] - mnew); sc[j4][r] = p; ps += p; }
        ps += __shfl_xor(ps, 32);
        sum = sum * resc + ps; mrun = mnew;
#pragma unroll
        for (int mt = 0; mt < 4; ++mt)
#pragma unroll
            for (int r = 0; r < 16; ++r) o[mt][r] *= resc;
#pragma unroll
        for (int j4 = 0; j4 < 4; ++j4)
#pragma unroll
            for (int s = 0; s < 2; ++s) { const bf16x8 pf = pack8(sc[j4], s); const int kstep = 2 * (4 * half + j4) + s;
#pragma unroll
                for (int mt = 0; mt < 4; ++mt) o[mt] = MFMA32(*(const LAS bf16x8*)(Vt + (32 * mt + c) * LDV + 16 * kstep + 8 * h), pf, o[mt]); }
    }
    const float inv = 1.f / sum;
#pragma unroll
    for (int mt = 0; mt < 4; ++mt) store_ot(xo + (size_t)t * 512 + hd * 128 + 32 * mt, o[mt], inv, h);
}

__device__ __forceinline__ void sb_unit(LAS unsigned char* lds, const bf16* proj, float kmax2, bf16* y, int hd, int qb, int tid) {
    const int lane = tid & 63, wave = __builtin_amdgcn_readfirstlane(tid >> 6), c = lane & 31, h = lane >> 5;
    LAS bf16* Kl = (LAS bf16*)lds;
    LAS bf16* Vt = (LAS bf16*)(lds + 34816);
    LAS unsigned* flags = (LAS unsigned*)(lds + 69632);
    constexpr int LDV = 136;
    const float scale = 0.08838834764831845f;
    const int t = 256 * qb + 32 * wave + c;
    bf16x8 qf[8]; float qq = 0.f;
#pragma unroll
    for (int ks = 0; ks < 8; ++ks) { const u32x4 w = *(const u32x4*)(proj + (size_t)t * NPROJ + PC_SBQ + hd * 128 + 16 * ks + 8 * h); qq += dot8(w, w); qf[ks] = __builtin_bit_cast(bf16x8, w); }
    qq += __shfl_xor(qq, 32);
    const float zb = sqrtf(qq * kmax2) * scale;
    f32x16 o[4];
#pragma unroll
    for (int mt = 0; mt < 4; ++mt)
#pragma unroll
        for (int r = 0; r < 16; ++r) o[mt][r] = 0.f;
    float carry = 0.f; bool wdone = false;
    const int tmax = 256 * qb + 32 * wave + 31;
#pragma unroll 1
    for (int kb = 2 * qb + 1; kb >= 0; --kb) {
        __syncthreads();
        stage_k_loop<128>(Kl, proj + (size_t)(128 * kb) * NPROJ + PC_SBK + hd * 128, NPROJ, 128, 0, tid);
        stage_vt_loop<128>(Vt, LDV, proj + (size_t)(128 * kb) * NPROJ + PC_SBV + hd * 128, NPROJ, 128, 0, tid);
        __syncthreads();
        if (!wdone && 128 * kb < tmax) {
#pragma unroll 1
            for (int kt = 3; kt >= 0; --kt) {
                const int key0 = 128 * kb + 32 * kt;
                if (key0 >= tmax) continue;
                const int trel = launder_v(t - key0 - 4 * h);
                f32x16 acc;
#pragma unroll
                for (int r = 0; r < 16; ++r) acc[r] = 0.f;
#pragma unroll
                for (int ks = 0; ks < 8; ++ks) acc = MFMA32(*(const LAS bf16x8*)(Kl + (32 * kt + c) * 136 + 16 * ks + 8 * h), qf[ks], acc);
                float lg[16], gso[4], gst[4];
#pragma unroll
                for (int g = 0; g < 4; ++g) { float s = 0.f;
#pragma unroll
                    for (int r = 0; r < 4; ++r) { const int reg = 4 * g + r; const bool valid = (r + 8 * g) < trel; const float z = acc[reg] * scale; acc[reg] = z;
                        const float l = valid ? -(fmaxf(z, 0.f) + __logf(1.f + __expf(-fabsf(z)))) : 0.f; lg[reg] = l; s += l; }
                    gso[g] = s; const float oth = __shfl_xor(s, 32); gst[g] = (h == 0) ? oth : 0.f; gso[g] = s + oth; }
                float suf = carry;
#pragma unroll
                for (int g = 3; g >= 0; --g) { float R = suf + gst[g];
#pragma unroll
                    for (int r = 3; r >= 0; --r) { const int reg = 4 * g + r; R += lg[reg]; const bool valid = (r + 8 * g) < trel; acc[reg] = valid ? __expf(acc[reg] + R) : 0.f; }
                    suf += gso[g]; }
                carry = suf;
#pragma unroll
                for (int s = 0; s < 2; ++s) { const bf16x8 pf = pack8(acc, s); const int kstep = 2 * kt + s;
#pragma unroll
                    for (int mt = 0; mt < 4; ++mt) o[mt] = MFMA32(*(const LAS bf16x8*)(Vt + (32 * mt + c) * LDV + 16 * kstep + 8 * h), pf, o[mt]); }
            }
            wdone = __all(carry + zb < -110.f);
        }
        if (lane == 0) flags[wave] = (wdone || kb == 0) ? 0u : 1u;
        LDS_WAIT();
        __syncthreads();
        unsigned any = 0u;
#pragma unroll
        for (int w8 = 0; w8 < 8; ++w8) any |= flags[w8];
        if (any == 0u) break;
    }
#pragma unroll
    for (int mt = 0; mt < 4; ++mt) store_ot(y + (size_t)t * 2048 + 1536 + hd * 128 + 32 * mt, o[mt], 1.f, h);
}

__device__ __forceinline__ void dpost_token(const bf16* __restrict__ oraw, const bf16* __restrict__ opb, const bf16* __restrict__ proj, const float* __restrict__ gain, bf16* __restrict__ y, int t, int lane) {
#pragma unroll
    for (int p = 0; p < 2; ++p) {
        const int c = 512 * p + 8 * lane;
        const u32x4 ov = *(const u32x4*)(oraw + (size_t)t * 1024 + c), pv = *(const u32x4*)(opb + (size_t)t * 1024 + c);
        const f32x4 a = {bf_lo(ov.x) + bf_lo(pv.x), bf_hi(ov.x) + bf_hi(pv.x), bf_lo(ov.y) + bf_lo(pv.y), bf_hi(ov.y) + bf_hi(pv.y)},
                    b = {bf_lo(ov.z) + bf_lo(pv.z), bf_hi(ov.z) + bf_hi(pv.z), bf_lo(ov.w) + bf_lo(pv.w), bf_hi(ov.w) + bf_hi(pv.w)};
        float ss = (a.x * a.x + a.y * a.y) + (a.z * a.z + a.w * a.w) + (b.x * b.x + b.y * b.y) + (b.z * b.z + b.w * b.w);
        ss = red16(ss);
        const float r = rsqrtf(ss * (1.f / 128.f) + EPS_);
        const f32x4 g0 = *(const f32x4*)(gain + (c & 127)), g1 = *(const f32x4*)(gain + (c & 127) + 4);
        const u32x4 zz = *(const u32x4*)(proj + (size_t)t * NPROJ + PC_Z + c);
        u32x4 o;
        o.x = cvt_pk_bf16(a.x * r * g0.x * siluf_(bf_lo(zz.x)), a.y * r * g0.y * siluf_(bf_hi(zz.x)));
        o.y = cvt_pk_bf16(a.z * r * g0.z * siluf_(bf_lo(zz.y)), a.w * r * g0.w * siluf_(bf_hi(zz.y)));
        o.z = cvt_pk_bf16(b.x * r * g1.x * siluf_(bf_lo(zz.z)), b.y * r * g1.y * siluf_(bf_hi(zz.z)));
        o.w = cvt_pk_bf16(b.z * r * g1.z * siluf_(bf_lo(zz.w)), b.w * r * g1.w * siluf_(bf_hi(zz.w)));
        *(u32x4*)(y + (size_t)t * 2048 + c) = o;
    }
}

__device__ __forceinline__ void convact_item(const bf16* __restrict__ up, const float* __restrict__ cw  , bf16* __restrict__ act, int tb, int cb, int lane) {
    const int c = 512 * cb + 8 * lane;
    float wg[3][8], wv[3][8];
#pragma unroll
    for (int i = 0; i < 3; ++i) {
        const f32x4 a = *(const f32x4*)(cw + i * 8192 + c), b = *(const f32x4*)(cw + i * 8192 + c + 4);
        const f32x4 d = *(const f32x4*)(cw + i * 8192 + 4096 + c), e = *(const f32x4*)(cw + i * 8192 + 4096 + c + 4);
        wg[i][0] = a.x; wg[i][1] = a.y; wg[i][2] = a.z; wg[i][3] = a.w; wg[i][4] = b.x; wg[i][5] = b.y; wg[i][6] = b.z; wg[i][7] = b.w;
        wv[i][0] = d.x; wv[i][1] = d.y; wv[i][2] = d.z; wv[i][3] = d.w; wv[i][4] = e.x; wv[i][5] = e.y; wv[i][6] = e.z; wv[i][7] = e.w;
    }
    const int t0 = tb * 32;
    const u32x4 z4 = {0u, 0u, 0u, 0u};
    u32x4 gp0 = z4, vp0 = z4, gp1 = z4, vp1 = z4;
    if (t0 >= 2) { gp0 = *(const u32x4*)(up + (size_t)(t0 - 2) * 8192 + c); vp0 = *(const u32x4*)(up + (size_t)(t0 - 2) * 8192 + 4096 + c);
                   gp1 = *(const u32x4*)(up + (size_t)(t0 - 1) * 8192 + c); vp1 = *(const u32x4*)(up + (size_t)(t0 - 1) * 8192 + 4096 + c); }
#pragma unroll 1
    for (int bt = 0; bt < 4; ++bt) {
        u32x4 gr[10], vr[10];
        gr[0] = gp0; vr[0] = vp0; gr[1] = gp1; vr[1] = vp1;
#pragma unroll
        for (int r = 0; r < 8; ++r) { const int t = t0 + 8 * bt + r; gr[2 + r] = *(const u32x4*)(up + (size_t)t * 8192 + c); vr[2 + r] = *(const u32x4*)(up + (size_t)t * 8192 + 4096 + c); }
        u32x4 ov[8];
#pragma unroll
        for (int r = 0; r < 8; ++r) {
            float ga[8], va[8];
#define CA_TAP(i, G, V, OP) \
            ga[0] OP wg[i][0] * bf_lo(G.x); ga[1] OP wg[i][1] * bf_hi(G.x); ga[2] OP wg[i][2] * bf_lo(G.y); ga[3] OP wg[i][3] * bf_hi(G.y); \
            ga[4] OP wg[i][4] * bf_lo(G.z); ga[5] OP wg[i][5] * bf_hi(G.z); ga[6] OP wg[i][6] * bf_lo(G.w); ga[7] OP wg[i][7] * bf_hi(G.w); \
            va[0] OP wv[i][0] * bf_lo(V.x); va[1] OP wv[i][1] * bf_hi(V.x); va[2] OP wv[i][2] * bf_lo(V.y); va[3] OP wv[i][3] * bf_hi(V.y); \
            va[4] OP wv[i][4] * bf_lo(V.z); va[5] OP wv[i][5] * bf_hi(V.z); va[6] OP wv[i][6] * bf_lo(V.w); va[7] OP wv[i][7] * bf_hi(V.w);
            CA_TAP(0, gr[r], vr[r], =) CA_TAP(1, gr[r + 1], vr[r + 1], +=) CA_TAP(2, gr[r + 2], vr[r + 2], +=)
#undef CA_TAP
            u32x4 o;
            o.x = cvt_pk_bf16(siluf_(ga[0]) * va[0], siluf_(ga[1]) * va[1]); o.y = cvt_pk_bf16(siluf_(ga[2]) * va[2], siluf_(ga[3]) * va[3]);
            o.z = cvt_pk_bf16(siluf_(ga[4]) * va[4], siluf_(ga[5]) * va[5]); o.w = cvt_pk_bf16(siluf_(ga[6]) * va[6], siluf_(ga[7]) * va[7]);
            ov[r] = o;
        }
#pragma unroll
        for (int r = 0; r < 8; ++r) *(u32x4*)(act + (size_t)(t0 + 8 * bt + r) * 4096 + c) = ov[r];
        gp0 = gr[8]; vp0 = vr[8]; gp1 = gr[9]; vp1 = vr[9];
    }
}

__device__ __forceinline__ const void* arg_ptr(int i) {
    const int off = launder_s(i * 8);
    const __attribute__((address_space(4))) char* ka = (const __attribute__((address_space(4))) char*)__builtin_amdgcn_kernarg_segment_ptr();
    return *(const void* const __attribute__((address_space(4)))*)(ka + off);
}
#define AIN(i) ((const float*)arg_ptr(i))
struct Args { const float* in[23]; float* out; unsigned char* ws; };
static_assert(sizeof(Args) == 25 * 8, "Args has no padding");

__global__ void __launch_bounds__(NWAVES * 64, 2) fwd_kernel(Args args) {
    extern __shared__ __attribute__((aligned(16))) unsigned char lds_raw[];
    LAS unsigned char* lds = (LAS unsigned char*)lds_raw;
    const int tid0 = threadIdx.x;
    const int G = gridDim.x, bx = blockIdx.x;
    const int NGW = G * NWAVES;
    unsigned* ctl0 = (unsigned*)((unsigned char*)arg_ptr(24) + WS_CTL);
    for (int u = tid0; u < (LDS_BYTES - LDSCTL_OFF) / 4; u += NWAVES * 64) ((LAS unsigned*)(lds + LDSCTL_OFF))[u] = 0u;
    __syncthreads();
    volatile LAS unsigned* MISC = (volatile LAS unsigned*)(lds + MISC_OFF);
    (void)xcd_barrier_post(ctl0 + CW_BAR, MISC + 8);
    if (bx >= 8) (void)xcd_barrier_post(ctl0 + CW_BAR2, MISC + 10);
#define GRID_BAR() do { XcdBarrier b_; b_.bar = (unsigned*)((unsigned char*)arg_ptr(24) + WS_CTL) + CW_BAR; b_.x = xb_xcc_id(); b_.st = MISC + 8; b_.G = gridDim.x; xcd_barrier(b_); } while (0)
#define SUB_BAR() do { XcdBarrier b_; b_.bar = (unsigned*)((unsigned char*)arg_ptr(24) + WS_CTL) + CW_BAR2; b_.x = xb_xcc_id(); b_.st = MISC + 10; b_.G = gridDim.x - 8; xcd_barrier(b_); } while (0)
#define PHASE_IDS() const int tid = launder_v(threadIdx.x), lane = tid & 63, wave = __builtin_amdgcn_readfirstlane(tid >> 6), gw = bx * NWAVES + wave; (void)lane; (void)gw; (void)tid; WS_PTRS()

#define WS_PTRS() unsigned char* ws = (unsigned char*)arg_ptr(24); float* hbuf = (float*)arg_ptr(23); (void)hbuf; \
    bf16* Win_t = (bf16*)(ws + WS_WIN); bf16* Wup_t = (bf16*)(ws + WS_WUP); bf16* Wdn_t = (bf16*)(ws + WS_WDN); bf16* Wo_t = (bf16*)(ws + WS_WO); \
    bf16* Wbd_t = (bf16*)(ws + WS_WBD); bf16* Wbs_t = (bf16*)(ws + WS_WBS); bf16* Wbb_t = (bf16*)(ws + WS_WBB); \
    bf16* Wxq_t = (bf16*)(ws + WS_WXQ); bf16* Wxkv_t = (bf16*)(ws + WS_WXKV); bf16* Wxo_t = (bf16*)(ws + WS_WXO); \
    bf16* XN = (bf16*)(ws + WS_XN); bf16* PROJ = (bf16*)(ws + WS_PROJ); bf16* UP = (bf16*)(ws + WS_UP); bf16* ACT = (bf16*)(ws + WS_ACT); \
    unsigned char* DPREP = ws + WS_DPREP; bf16* ORAW = (bf16*)(ws + WS_ORAW); bf16* OPB = (bf16*)(ws + WS_OPB); (void)OPB; bf16* Y = (bf16*)(ws + WS_Y); \
    unsigned char* GATES = ws + WS_MRG; (void)GATES; bf16* MRGB = (bf16*)(ws + WS_MRGB); bf16* XQ = (bf16*)(ws + WS_XQ); bf16* XO = (bf16*)(ws + WS_XO); \
    bf16* KV = (bf16*)(ws + WS_KV); bf16* MEMN = (bf16*)(ws + WS_MEMN); float* GL = (float*)(ws + WS_GL); unsigned* ctl = (unsigned*)(ws + WS_CTL); unsigned long long* SSQ = (unsigned long long*)(ws + WS_SSQ); (void)SSQ; \
    (void)Win_t; (void)Wup_t; (void)Wdn_t; (void)Wo_t; (void)Wbd_t; (void)Wbs_t; (void)Wbb_t; (void)Wxq_t; (void)Wxkv_t; (void)Wxo_t; (void)XN; (void)PROJ; (void)UP; (void)ACT; \
    (void)DPREP; (void)ORAW; (void)Y; (void)MRGB; (void)XQ; (void)XO; (void)KV; (void)MEMN; (void)GL; (void)ctl

#define CONVERT_WEIGHTS(LIN, LREST, W0_, NW_) do { \
        LAS float* scr = (LAS float*)(lds + wave * 16384); \
        constexpr int N_IN = 32 * 400, N_UP = 32 * 256, N_DN = 64 * 64, N_O = 32 * 64, N_BD = 16 * 64, N_BS = 8 * 64, N_XQ = 32 * 16, N_XKV = 32 * 32, N_XO = 8 * 64; \
        constexpr int N_REST = N_UP + N_DN + N_O + N_BD + 2 * N_BS + N_XQ + N_XKV + N_XO; \
        const int lin_ = (LIN), lrest_ = (LREST); \
        const int nitems_ = (lin_ >= 0 ? N_IN : 0) + (lrest_ >= 0 ? N_REST : 0); \
        _Pragma("unroll 1") for (int it = (W0_); it < nitems_; it += (NW_)) { \
            int r = it; \
            if (lin_ >= 0) { if (r < N_IN) { const int kb = r / 400, nb = r % 400; \
                transpose_item<1>(AIN(3) + (size_t)lin_ * 2048 * IN_COLS_SRC, 2048, IN_COLS_SRC, Win_t + (size_t)lin_ * NPROJ * 2048, scr, kb, nb, lane, AIN(2) + lin_ * 2048); continue; } r -= N_IN; } \
            TR_CASE(N_UP, 19, 2048, 8192, Wup_t, AIN(18) + lrest_ * 2048) TR_CASE(N_DN, 21, 4096, 2048, Wdn_t, nullptr) TR_CASE(N_O, 12, 2048, 2048, Wo_t, nullptr) TR_CASE(N_BD, 9, 1024, 2048, Wbd_t, nullptr) \
            TR_CASE(N_BS, 10, 512, 2048, Wbs_t, nullptr) TR_CASE(N_BS, 11, 512, 2048, Wbb_t, nullptr) TR_CASE(N_XQ, 15, 2048, 512, Wxq_t, AIN(13) + lrest_ * 2048) TR_CASE(N_XKV, 16, 2048, 1024, Wxkv_t, nullptr) TR_CASE(N_XO, 17, 512, 2048, Wxo_t, nullptr) \
        } } while (0)
#define TR_CASE(NPER, IDX, KK, NN, DSTP, GK) \
            if (r < (NPER)) { const int kb = r / ((NN) / 32), nb = r % ((NN) / 32); \
                transpose_item<0>(AIN(IDX) + (size_t)lrest_ * (KK) * (NN), KK, NN, (DSTP) + (size_t)lrest_ * (NN) * (KK), scr, kb, nb, lane, GK); continue; } r -= (NPER);
    {
        PHASE_IDS();
        CONVERT_WEIGHTS(0, -1, gw, NGW);
#pragma unroll 1
        for (int m = gw; m < S_; m += NGW) {
            const f32x4* xr = (const f32x4*)(AIN(0) + (size_t)m * D_) + lane; u32x2* o8 = (u32x2*)(XN + (size_t)m * D_) + lane; float ss = 0.f;
            f32x4 xv[8];
#pragma unroll
            for (int j = 0; j < 8; ++j) xv[j] = xr[64 * j];
#pragma unroll
            for (int j = 0; j < 8; ++j) { const f32x4 v = xv[j]; ss += (v.x * v.x + v.y * v.y) + (v.z * v.z + v.w * v.w); u32x2 w; w.x = cvt_pk_bf16(v.x, v.y); w.y = cvt_pk_bf16(v.z, v.w); o8[64 * j] = w; }
            ss = wave_sum(ss); if (lane == 0) SSQ[m] = (unsigned long long)(ss * 1048576.f); }
#pragma unroll 1
        for (int it = gw; it < 4 * MEML; it += NGW) { const int l = it / MEML, m = it % MEML;
            rms_row_bf16(AIN(1) + (size_t)m * D_, AIN(14) + l * D_, MEMN + ((size_t)l * MEML + m) * D_, lane); }
    }
    GRID_BAR();

#pragma unroll 1
    for (int l = 0; l < DEPTH_; ++l) {

        { WS_PTRS(); pg8::Gemm g{XN, Win_t + (size_t)l * NPROJ * D_, S_, NPART_A, D_, D_, D_}; pg8::StaticOrder SO; SO.init(S_, NPART_A, G, bx);
          pg8::EpiProj E{PROJ, NPROJ, SSQ + (size_t)(3 * l) * S_, GATES, PC_GATE, NPART_A};
          pg8::gemm_phase<pg8::EpiProj, pg8::StaticOrder, true>(lds, g, SO, E); }
        GRID_BAR();
        { PHASE_IDS(); float kmax = 0.f;
#pragma unroll 1
          for (int t = gw; t < S_; t += NGW) { const u32x4 r = *(const u32x4*)(PROJ + (size_t)t * NPROJ + PC_SBK + 8 * lane); float ss = dot8(r, r); ss = red16(ss); kmax = fmaxf(kmax, ss); }
          if ((lane & 15) == 0) atomicMax(ctl + CW_KMAX + l * 64 + (lane >> 4), __float_as_uint(kmax));
          const float* convw = AIN(4) + (size_t)l * 4 * 3072; const float* alog = AIN(5) + l * 8; const float* dtb = AIN(6) + l * 8;
          int cur_hd = -1;
          const unsigned char* zero16 = (const unsigned char*)(ctl + CW_ZERO16);
          float alog_c = 0.f, dtb_c = 0.f;
          if (bx < (S_ / 64) * 8) { const int u0 = bx, hd0 = u0 & 7, t00 = (u0 >> 3) * 64;
              __syncthreads();
              prep_stage_raw(lds, PROJ, zero16, t00, hd0, tid);
              asm volatile("s_waitcnt vmcnt(0)" ::: "memory"); }
#pragma unroll 1
          for (int u = bx; u < (S_ / 64) * 8; u += G) { const int hd = u & 7;
            if (hd != cur_hd) {
                __syncthreads();
                for (int i = tid; i < 4 * 384; i += NWAVES * 64) { const int tap = i / 384, c = i % 384; ((LAS float*)(lds + P_CW))[i] = convw[tap * 3072 + (c >> 7) * 1024 + hd * 128 + (c & 127)]; }
                alog_c = alog[hd]; dtb_c = dtb[hd];
                asm volatile("" : "+v"(alog_c), "+v"(dtb_c));
                cur_hd = hd; }
            delta_prep_unit(lds, PROJ, convw, alog_c, dtb_c, DPREP + ((size_t)hd * (S_ / 64) + (u >> 3)) * DU_BYTES, GL + u, OPB, (u >> 3) * 64, hd, tid, zero16, (u + G < (S_ / 64) * 8) ? ((u + G) >> 3) * 64 : -1); }
          __syncthreads(); }
        GRID_BAR();
        { PHASE_IDS();
        if (bx < 8) delta_scan_head(lds, DPREP, GL, ORAW, bx, tid);
        else {
            const int late = (bx >> 3) & 1;
            if (late) { CONVERT_WEIGHTS(-1, l, gw - 8 * NWAVES, NGW - 8 * NWAVES); __syncthreads(); }
            { pg8::Gemm g{XN, Win_t + (size_t)l * NPROJ * D_ + (size_t)PC_SWAQ * D_, S_, NPROJ - PC_SWAQ, D_, D_, D_}; pg8::StaticOrder SO; SO.init(S_, NPROJ - PC_SWAQ, G - 8, bx - 8);
              pg8::EpiBf16 E{PROJ + PC_SWAQ, NPROJ, SSQ + (size_t)(3 * l) * S_};
              pg8::gemm_phase<pg8::EpiBf16, pg8::StaticOrder, true>(lds, g, SO, E); }
            asm volatile("s_waitcnt vmcnt(0)" ::: "memory");
            __syncthreads();
            if (tid == 0) { __builtin_amdgcn_fence(__ATOMIC_RELEASE, "agent"); asm volatile("s_waitcnt vmcnt(0)" ::: "memory"); (void)xb_add(ctl + CW_B1CNT + l * 64, 1u); }
            { const int cB = (bx - 8 + 56) % (G - 8);
              pg8::Gemm g{XN, Win_t + (size_t)l * NPROJ * D_ + (size_t)NPART_A * D_, S_, PC_SWAQ - NPART_A, D_, D_, D_}; pg8::StaticOrder SO; SO.init(S_, PC_SWAQ - NPART_A, G - 8, cB);
              pg8::EpiProj E{PROJ + NPART_A, NPROJ, SSQ + (size_t)(3 * l) * S_, GATES + (NPART_A - PC_GATE), 0, PC_GATE + 6144 - NPART_A};
              pg8::gemm_phase<pg8::EpiProj, pg8::StaticOrder, true>(lds, g, SO, E); }
            if (tid == 0) { unsigned* bar0 = ctl + CW_BAR; XB_SPIN(xb_ld(ctl + CW_B1CNT + l * 64) < (unsigned)(G - 8), bar0); __builtin_amdgcn_fence(__ATOMIC_ACQUIRE, "agent"); asm volatile("s_waitcnt vmcnt(0)" ::: "memory"); }
            __syncthreads();
            {
              const int j = bx - 8, NSH = G - 8;
              const float* sinks = AIN(8) + l * 8;
              int u0, u1, u2;
              if (NSH == 248) {
                  const bool shortg = (j >= 184 && j < 192) || j >= 200;
                  if (shortg) { const int si = j < 192 ? j - 184 : 8 + (j - 200); u0 = 2 * si; u1 = 2 * si + 1; u2 = 256 + si; }
                  else { const int li = j < 184 ? j : j - 8;
                      if (li < 144) { u0 = 112 + li; u1 = 256 + 56 + li; u2 = -1; }
                      else { const int k2 = li - 144; u0 = 256 + 200 + k2; u1 = k2 < 8 ? 256 + 248 + k2 : -1; u2 = -1; } } }
              else { u0 = j; u1 = j + NSH; u2 = j + 2 * NSH; if (u1 >= 512) u1 = -1; if (u2 >= 512) u2 = -1; }
#pragma unroll 1
              for (int k = 0; k < 3; ++k) { const int u = (k == 0) ? u0 : (k == 1 ? u1 : u2);
                  if (u < 0) continue;
                  if (u < 256) sb_unit(lds, PROJ, __uint_as_float(ctl[CW_KMAX + l * 64 + (u & 3)]), Y, u & 3, u >> 2, tid);
                  else swa_unit(lds, PROJ, sinks, Y, (u - 256) & 1, (u - 256) >> 1, tid); }
            }
            __syncthreads();
            if (!late) { CONVERT_WEIGHTS(-1, l, gw - 8 * NWAVES, NGW - 8 * NWAVES); }
        } }
        GRID_BAR();
        { PHASE_IDS();
#pragma unroll 1
          for (int t = gw; t < S_; t += 2 * NGW) { dpost_token(ORAW, OPB, PROJ, AIN(7) + l * 128, Y, t, lane); dpost_token(ORAW, OPB, PROJ, AIN(7) + l * 128, Y, t + NGW, lane); } }
        GRID_BAR();
        { WS_PTRS(); pg8::StaticOrder SO; SO.init(S_, D_, G, bx);
          { pg8::Gemm g{Y, Wbd_t + (size_t)l * 2048 * 1024, S_, D_, 1024, 2048, 1024}; pg8::EpiGate<0> E{GATES, 6144, MRGB, D_};
            pg8::gemm_phase<pg8::EpiGate<0>, pg8::StaticOrder, true>(lds, g, SO, E); }
          { pg8::Gemm g{Y + 1024, Wbs_t + (size_t)l * 2048 * 512, S_, D_, 512, 2048, 512}; pg8::EpiGate<1> E{GATES + 2048, 6144, MRGB, D_};
            pg8::gemm_phase<pg8::EpiGate<1>, pg8::StaticOrder, true>(lds, g, SO, E); }
          { pg8::Gemm g{Y + 1536, Wbb_t + (size_t)l * 2048 * 512, S_, D_, 512, 2048, 512}; pg8::EpiGate<2> E{GATES + 4096, 6144, MRGB, D_};
            pg8::gemm_phase<pg8::EpiGate<2>, pg8::StaticOrder, true>(lds, g, SO, E); } }
        GRID_BAR();
        { WS_PTRS(); pg8::Gemm g{MRGB, Wo_t + (size_t)l * D_ * D_, S_, D_, D_, D_, D_}; pg8::StaticOrder SO; SO.init(S_, D_, G, bx);
          pg8::EpiRes E{XN, D_, SSQ + (size_t)(3 * l + 1) * S_};
          pg8::gemm_phase<pg8::EpiRes, pg8::StaticOrder, true>(lds, g, SO, E); }
        GRID_BAR();
        { WS_PTRS(); pg8::Gemm g{XN, Wxq_t + (size_t)l * 512 * D_, S_, 512, D_, D_, D_}; pg8::StaticOrder SO; SO.init(S_, 512, G, bx);
          pg8::EpiBf16 E{XQ, 512, SSQ + (size_t)(3 * l + 1) * S_};
          pg8::gemm_phase<pg8::EpiBf16, pg8::StaticOrder, true>(lds, g, SO, E); }
        { WS_PTRS(); pg8::Gemm g{MEMN + (size_t)l * MEML * D_, Wxkv_t + (size_t)l * 1024 * D_, MEML, 1024, D_, D_, D_}; pg8::StaticOrder SO; SO.init(MEML, 1024, G, (bx + G - 128) % G);
          pg8::EpiBf16 E{KV + (size_t)l * MEML * 1024, 1024, nullptr};
          pg8::gemm_phase<pg8::EpiBf16, pg8::StaticOrder, true>(lds, g, SO, E); }
        { PHASE_IDS(); if (bx >= 132 && l + 1 < DEPTH_) { CONVERT_WEIGHTS(l + 1, -1, gw - 132 * NWAVES, NGW - 132 * NWAVES); } }
        GRID_BAR();
        { PHASE_IDS();
#pragma unroll 1
          for (int u = bx; u < 256; u += G) xattn_unit(lds, XQ, KV + (size_t)l * MEML * 1024, XO, u & 3, u >> 2, tid);
          __syncthreads(); }
        GRID_BAR();
        { WS_PTRS(); pg8::Gemm g{XO, Wxo_t + (size_t)l * D_ * 512, S_, D_, 512, 512, 512}; pg8::StaticOrder SO; SO.init(S_, D_, G, bx);
          pg8::EpiRes E{XN, D_, SSQ + (size_t)(3 * l + 2) * S_};
          pg8::gemm_phase<pg8::EpiRes, pg8::StaticOrder, true>(lds, g, SO, E); }
        GRID_BAR();
        { WS_PTRS(); pg8::Gemm g{XN, Wup_t + (size_t)l * 8192 * D_, S_, 8192, D_, D_, D_}; pg8::StaticOrder SO; SO.init(S_, 8192, G, bx);
          pg8::EpiBf16 E{UP, 8192, SSQ + (size_t)(3 * l + 2) * S_};
          pg8::gemm_phase<pg8::EpiBf16, pg8::StaticOrder, true>(lds, g, SO, E); }
        GRID_BAR();
        { PHASE_IDS();
#pragma unroll 1
          for (int it = gw; it < (S_ / 32) * 8; it += NGW) convact_item(UP, AIN(20) + (size_t)l * 3 * 8192, ACT, it >> 3, it & 7, lane); }
        GRID_BAR();
        { WS_PTRS(); pg8::Gemm g{ACT, Wdn_t + (size_t)l * D_ * DFF, S_, D_, DFF, DFF, DFF}; pg8::StaticOrder SO; SO.init(S_, D_, G, bx);
          pg8::EpiRes E{XN, D_, SSQ + (size_t)(3 * l + 3) * S_};
          pg8::gemm_phase<pg8::EpiRes, pg8::StaticOrder, true>(lds, g, SO, E); }
        GRID_BAR();
    }
    { PHASE_IDS();
#pragma unroll 1
      for (int m = gw; m < S_; m += NGW) { const u32x2* hr = (const u32x2*)(XN + (size_t)m * D_) + lane; f32x4* orow = (f32x4*)(hbuf + (size_t)m * D_) + lane; const f32x4* gr = (const f32x4*)AIN(22) + lane;
          const float rstd = rsqrtf((float)SSQ[(size_t)(3 * DEPTH_) * S_ + m] * (1.f / (2048.f * 1048576.f)) + EPS_);
          u32x2 hv[8]; f32x4 gq[8];
#pragma unroll
          for (int j = 0; j < 8; ++j) { hv[j] = hr[64 * j]; gq[j] = gr[64 * j]; }
#pragma unroll
          for (int j = 0; j < 8; ++j) { const f32x4 v = {bf_lo(hv[j].x), bf_hi(hv[j].x), bf_lo(hv[j].y), bf_hi(hv[j].y)}; orow[64 * j] = v * rstd * gq[j]; } } }
}

extern "C" void kernel_launch(void* const* d_in, const int* in_sizes, int n_in, void* d_out, int out_size, void* d_ws, size_t ws_size, hipStream_t stream) {
    static int grid = 0;
    if (grid == 0) {
        if (n_in != 23 || out_size != S_ * D_ || ws_size < WS_END) { fprintf(stderr, "kernel_launch: unexpected shapes (n_in %d, out %d, ws %zu, need %zu)\n", n_in, out_size, ws_size, (size_t)WS_END); grid = -1; return; }
        int dev = 0, cus = 0, per_cu = 0;
        if (hipGetDevice(&dev) != hipSuccess || hipDeviceGetAttribute(&cus, hipDeviceAttributeMultiprocessorCount, dev) != hipSuccess) { grid = -1; return; }
        if (hipFuncSetAttribute((const void*)fwd_kernel, hipFuncAttributeMaxDynamicSharedMemorySize, LDS_BYTES) != hipSuccess) { fprintf(stderr, "kernel_launch: hipFuncSetAttribute failed\n"); grid = -1; return; }
        if (hipOccupancyMaxActiveBlocksPerMultiprocessor(&per_cu, (const void*)fwd_kernel, NWAVES * 64, LDS_BYTES) != hipSuccess || per_cu < 1)
            fprintf(stderr, "kernel_launch: occupancy query reports %d workgroups per CU\n", per_cu);
        (void)hipGetLastError();
        grid = cus;
    }
    if (grid < 0) return;
    if (hipMemsetAsync((char*)d_ws + WS_CTL, 0, CTL_ZERO_BYTES, stream) != hipSuccess || hipMemsetAsync((char*)d_ws + WS_SSQ, 0, SSQ_BYTES, stream) != hipSuccess) { fprintf(stderr, "kernel_launch: memset failed\n"); return; }
    Args a{};
    for (int i = 0; i < 23; ++i) a.in[i] = (const float*)d_in[i];
    a.out = (float*)d_out; a.ws = (unsigned char*)d_ws;
    hipLaunchKernelGGL(fwd_kernel, dim3(grid), dim3(NWAVES * 64), LDS_BYTES, stream, a);
    const hipError_t le = hipPeekAtLastError();
    if (le != hipSuccess) fprintf(stderr, "kernel_launch: launch failed: %s\n", hipGetErrorName(le));
}
```

```cpp
#include <hip/hip_runtime.h>
#include <cstdio>
#include <cstdint>

#define GAS __attribute__((address_space(1)))
#define LAS __attribute__((address_space(3)))
typedef unsigned short bf16;
typedef unsigned u32x4 __attribute__((ext_vector_type(4)));
typedef unsigned u32x2 __attribute__((ext_vector_type(2)));
typedef float f32x4 __attribute__((ext_vector_type(4)));
typedef float f32x2 __attribute__((ext_vector_type(2)));
typedef short bf16x8 __attribute__((ext_vector_type(8)));

constexpr int S_ = 16384, D_ = 2048, DEPTH_ = 4, MEML = 256, DFF = 4096;
constexpr int NPROJ = 12800;
constexpr int PC_DNQ = 0, PC_DNK = 1024, PC_DNV = 2048, PC_A = 3072, PC_B = 3080, PC_SBK = 3328, PC_GATE = 3840, PC_Z = 9984,
              PC_SWAQ = 11008, PC_SWAK = 11520, PC_SWAV = 11648, PC_SBQ = 11776, PC_SBV = 12288;
constexpr int NPART_A = 4096, NPART_B = NPROJ - NPART_A;
constexpr int IN_COLS_SRC = 12560;
constexpr float EPS_ = 1e-6f;

constexpr size_t MiB = 1u << 20;
constexpr size_t WS_CTL = 0, CTL_ZERO_BYTES = 1 * MiB;
constexpr size_t WS_WIN = 2 * MiB;
constexpr size_t WS_WUP = 202 * MiB;
constexpr size_t WS_WDN = 330 * MiB;
constexpr size_t WS_WO = 394 * MiB;
constexpr size_t WS_WBD = 426 * MiB;
constexpr size_t WS_WBS = 442 * MiB;
constexpr size_t WS_WBB = 450 * MiB;
constexpr size_t WS_WXQ = 458 * MiB;
constexpr size_t WS_WXKV = 466 * MiB;
constexpr size_t WS_WXO = 482 * MiB;
constexpr size_t WS_XN = 490 * MiB;
constexpr size_t WS_PROJ = 554 * MiB;
constexpr size_t WS_UP = 554 * MiB;
constexpr size_t WS_ACT = 810 * MiB;
constexpr size_t WS_DPREP = 954 * MiB;
constexpr size_t WS_ORAW = 1146 * MiB;
constexpr size_t WS_Y = 1210 * MiB;
constexpr size_t WS_MRG = 1274 * MiB;
constexpr size_t WS_MRGB = 1402 * MiB;
constexpr size_t WS_XQ = 1466 * MiB;
constexpr size_t WS_XO = 1482 * MiB;
constexpr size_t WS_KV = 1498 * MiB;
constexpr size_t WS_MEMN = 1500 * MiB;
constexpr size_t WS_GL = 1504 * MiB;
constexpr size_t WS_SSQ = 1506 * MiB, SSQ_BYTES = 2 * MiB;
constexpr size_t WS_OPB = 1508 * MiB;
constexpr size_t WS_END = 1540 * MiB;
constexpr int CW_BAR = 4096;
constexpr int CW_BAR2 = 8192;
constexpr int CW_B1CNT = 12288;
constexpr int CW_ZERO16 = 200000;
constexpr int CW_KMAX = 16384;

constexpr int RING_BYTES = 131072;
constexpr int LDSCTL_OFF = 162816, MISC_OFF = LDSCTL_OFF + 320;
constexpr int LDS_BYTES = 163840;
constexpr int NWAVES = 8;

#define LDS_WAIT() asm volatile("s_waitcnt lgkmcnt(0)" ::: "memory")
#define VM_WAIT() asm volatile("s_waitcnt vmcnt(0)" ::: "memory")
__device__ __forceinline__ unsigned cvt_pk_bf16(float lo, float hi) { unsigned r; asm volatile("v_cvt_pk_bf16_f32 %0, %1, %2" : "=v"(r) : "v"(lo), "v"(hi)); return r; }
__device__ __forceinline__ float bf_lo(unsigned w) { return __uint_as_float(w << 16); }
__device__ __forceinline__ float bf_hi(unsigned w) { return __uint_as_float(w & 0xffff0000u); }
__device__ __forceinline__ float bf2f(bf16 b) { return __uint_as_float(((unsigned)b) << 16); }
__device__ __forceinline__ float wave_sum(float v) {
#pragma unroll
    for (int o = 1; o < 64; o <<= 1) v += __shfl_xor(v, o);
    return v;
}
__device__ __forceinline__ float wave_max(float v) {
#pragma unroll
    for (int o = 1; o < 64; o <<= 1) v = fmaxf(v, __shfl_xor(v, o));
    return v;
}
__device__ __forceinline__ float sigmoidf_(float x) { return 1.0f / (1.0f + __expf(-x)); }
__device__ __forceinline__ float siluf_(float x) { return x / (1.0f + __expf(-x)); }
__device__ __forceinline__ float softplusf_(float x) { return fmaxf(x, 0.f) + log1pf(__expf(-fabsf(x))); }
__device__ __forceinline__ float dot8(u32x4 a, u32x4 b) {
    float s = bf_lo(a.x) * bf_lo(b.x);
    s += bf_hi(a.x) * bf_hi(b.x);
    s += bf_lo(a.y) * bf_lo(b.y); s += bf_hi(a.y) * bf_hi(b.y);
    s += bf_lo(a.z) * bf_lo(b.z); s += bf_hi(a.z) * bf_hi(b.z);
    s += bf_lo(a.w) * bf_lo(b.w); s += bf_hi(a.w) * bf_hi(b.w);
    return s;
}

__device__ __forceinline__ int launder_v(int x) { asm volatile("" : "+v"(x)); return x; }
__device__ __forceinline__ int launder_s(int x) { asm volatile("" : "+s"(x)); return x; }
namespace pg8 {
#define PG8_LAS __attribute__((address_space(3)))
typedef unsigned short bf16_t;
constexpr int BM = 256, BK = 64, HALF = 128, HTB = HALF * BK * 2, STAGE_BYTES = 8 * HTB, NXCD = 8, WGM = 8;
__host__ __device__ __forceinline__ int lds_byte(int r, int c) { const int st = (r >> 4) * 2 + (c >> 5), rr = r & 15, cc = c & 31, ob = rr * 64 + cc * 2; return st * 1024 + (ob ^ (((ob >> 9) & 1) << 5)); }
__host__ __device__ __forceinline__ void stage_rc(int b, int& R, int& C) { const int st = b / 1024, sb = b % 1024, swz = sb ^ (((sb >> 9) & 1) << 5); R = (st >> 1) * 16 + swz / 64; C = (st & 1) * 32 + (swz % 64) / 2; }
__host__ __device__ __forceinline__ int perm32(int rho) { const int n = rho >> 4, i = rho & 15; return 8 * (i >> 2) + 4 * n + (i & 3); }
struct Unit { int pm, pn; };
struct Gemm { const bf16_t* A; const bf16_t* Bt; int M, N, K, lda, ldb; };
struct StaticOrder {
    int nM, nN, nwg, G, c;
    __host__ __device__ void init(int M, int N, int G_, int c_) { nM = M / BM; nN = N / BM; nwg = nM * nN; G = G_; c = c_; }
    __host__ __device__ bool next(int i, Unit& u) const {
        const long L = (long)i * G + c; if (L >= nwg) return false;
        int wgid = (int)L; { const int q = nwg / NXCD, r = nwg % NXCD, xcd = wgid % NXCD, off = wgid / NXCD; wgid = (xcd < r ? xcd * (q + 1) : r * (q + 1) + (xcd - r) * q) + off; }
        const int nig = WGM * nN, gid = wgid / nig, fm = gid * WGM, gsz = (nM - fm) < WGM ? (nM - fm) : WGM;
        u.pm = fm + ((wgid % nig) % gsz); u.pn = (wgid % nig) / gsz; return true;
    }
    __device__ __forceinline__ void a_ready(const Unit&) const {}
    __device__ __forceinline__ void done(const Unit&) const {}
};
struct EpiBf16 {
    static constexpr bool PERM = true, AFTER_DRAIN = false, HAS_MID = false;
    bf16_t* O; int ldc; const unsigned long long* ssq;
    __device__ __forceinline__ void operator()(const f32x4 (&acc)[2][2][4][2], const Unit& u, int wr, int wc, int fr, int fq) const {
        const int row0 = u.pm * BM + wr * 64 + fr, col0 = u.pn * BM + wc * 64 + 8 * fq;
        float rs[2][4];
        if (ssq) { unsigned long long q[2][4];
#pragma unroll
            for (int ai = 0; ai < 2; ++ai)
#pragma unroll
                for (int m = 0; m < 4; ++m) q[ai][m] = ssq[row0 + ai * HALF + m * 16];
#pragma unroll
            for (int ai = 0; ai < 2; ++ai)
#pragma unroll
                for (int m = 0; m < 4; ++m) rs[ai][m] = rsqrtf((float)q[ai][m] * (1.f / (2048.f * 1048576.f)) + 1e-6f);
        } else {
#pragma unroll
            for (int ai = 0; ai < 2; ++ai)
#pragma unroll
                for (int m = 0; m < 4; ++m) rs[ai][m] = 1.f; }
#pragma unroll
        for (int ai = 0; ai < 2; ++ai)
#pragma unroll
            for (int m = 0; m < 4; ++m) { const int row = row0 + ai * HALF + m * 16; bf16_t* rowp = O + (size_t)row * ldc + col0;
#pragma unroll
                for (int bj = 0; bj < 2; ++bj) { const f32x4 v0 = acc[ai][bj][m][0] * rs[ai][m], v1 = acc[ai][bj][m][1] * rs[ai][m];
                    u32x4 w; w.x = cvt_pk_bf16(v0[0], v0[1]); w.y = cvt_pk_bf16(v0[2], v0[3]); w.z = cvt_pk_bf16(v1[0], v1[1]); w.w = cvt_pk_bf16(v1[2], v1[3]);
                    *(u32x4*)(rowp + bj * 32) = w; } }
    }
};
struct EpiProj {
    static constexpr bool PERM = true, AFTER_DRAIN = false, HAS_MID = false;
    bf16_t* O; int ldc; const unsigned long long* ssq; unsigned char* gq; int glo, ghi;
    __device__ __forceinline__ void operator()(const f32x4 (&acc)[2][2][4][2], const Unit& u, int wr, int wc, int fr, int fq) const {
        const int row0 = u.pm * BM + wr * 64 + fr, col0 = u.pn * BM + wc * 64 + 8 * fq;
        float rs[2][4];
        { unsigned long long q[2][4];
#pragma unroll
            for (int ai = 0; ai < 2; ++ai)
#pragma unroll
                for (int m = 0; m < 4; ++m) q[ai][m] = ssq[row0 + ai * HALF + m * 16];
#pragma unroll
            for (int ai = 0; ai < 2; ++ai)
#pragma unroll
                for (int m = 0; m < 4; ++m) rs[ai][m] = rsqrtf((float)q[ai][m] * (1.f / (2048.f * 1048576.f)) + 1e-6f); }
        const bool isg = (u.pn * BM >= glo) && (u.pn * BM < ghi);
        if (!isg) {
#pragma unroll
            for (int ai = 0; ai < 2; ++ai)
#pragma unroll
                for (int m = 0; m < 4; ++m) { const int row = row0 + ai * HALF + m * 16; bf16_t* rowp = O + (size_t)row * ldc + col0;
#pragma unroll
                    for (int bj = 0; bj < 2; ++bj) { const f32x4 v0 = acc[ai][bj][m][0] * rs[ai][m], v1 = acc[ai][bj][m][1] * rs[ai][m];
                        u32x4 w; w.x = cvt_pk_bf16(v0[0], v0[1]); w.y = cvt_pk_bf16(v0[2], v0[3]); w.z = cvt_pk_bf16(v1[0], v1[1]); w.w = cvt_pk_bf16(v1[2], v1[3]);
                        *(u32x4*)(rowp + bj * 32) = w; } }
        } else {
#define SGQ(x) (max((unsigned)(__builtin_amdgcn_rcpf(1.f + __expf(-(x))) * 255.f + 0.5f), 1u))
#pragma unroll
            for (int ai = 0; ai < 2; ++ai)
#pragma unroll
                for (int m = 0; m < 4; ++m) { const int row = row0 + ai * HALF + m * 16; unsigned char* rowp = gq + (size_t)row * 6144 + (col0 - glo);
#pragma unroll
                    for (int bj = 0; bj < 2; ++bj) { const f32x4 v0 = acc[ai][bj][m][0] * rs[ai][m], v1 = acc[ai][bj][m][1] * rs[ai][m];
                        u32x2 w; w.x = SGQ(v0[0]) | (SGQ(v0[1]) << 8) | (SGQ(v0[2]) << 16) | (SGQ(v0[3]) << 24); w.y = SGQ(v1[0]) | (SGQ(v1[1]) << 8) | (SGQ(v1[2]) << 16) | (SGQ(v1[3]) << 24);
                        *(u32x2*)(rowp + bj * 32) = w; } }
#undef SGQ
        }
    }
};
struct EpiRes {
    static constexpr bool PERM = true, AFTER_DRAIN = false, HAS_MID = false;
    bf16_t* hb; int ldc; unsigned long long* ssq;
    __device__ __forceinline__ void operator()(const f32x4 (&acc)[2][2][4][2], const Unit& u, int wr, int wc, int fr, int fq) const {
        const int row0 = u.pm * BM + wr * 64 + fr, col0 = u.pn * BM + wc * 64 + 8 * fq;
        u32x4 bs[2][4][2];
#pragma unroll
        for (int ai = 0; ai < 2; ++ai)
#pragma unroll
            for (int m = 0; m < 4; ++m)
#pragma unroll
                for (int bj = 0; bj < 2; ++bj) bs[ai][m][bj] = *(const u32x4*)(hb + (size_t)(row0 + ai * HALF + m * 16) * ldc + col0 + bj * 32);
#pragma unroll
        for (int ai = 0; ai < 2; ++ai)
#pragma unroll
            for (int m = 0; m < 4; ++m) { const int row = row0 + ai * HALF + m * 16; const size_t off = (size_t)row * ldc + col0; float ss = 0.f;
#pragma unroll
                for (int bj = 0; bj < 2; ++bj) { const u32x4 b = bs[ai][m][bj]; const f32x4 a0 = acc[ai][bj][m][0], a1 = acc[ai][bj][m][1];
                    const float v0 = bf_lo(b.x) + a0[0], v1 = bf_hi(b.x) + a0[1], v2 = bf_lo(b.y) + a0[2], v3 = bf_hi(b.y) + a0[3];
                    const float v4 = bf_lo(b.z) + a1[0], v5 = bf_hi(b.z) + a1[1], v6 = bf_lo(b.w) + a1[2], v7 = bf_hi(b.w) + a1[3];
                    ss += (v0 * v0 + v1 * v1) + (v2 * v2 + v3 * v3) + (v4 * v4 + v5 * v5) + (v6 * v6 + v7 * v7);
                    u32x4 w; w.x = cvt_pk_bf16(v0, v1); w.y = cvt_pk_bf16(v2, v3); w.z = cvt_pk_bf16(v4, v5); w.w = cvt_pk_bf16(v6, v7);
                    *(u32x4*)(hb + off + bj * 32) = w; }
                ss += __shfl_xor(ss, 16); ss += __shfl_xor(ss, 32);
                if (fq == 0) atomicAdd(ssq + row, (unsigned long long)(ss * 1048576.f)); }
    }
};
template <int MODE> struct EpiGate {
    static constexpr bool PERM = true, AFTER_DRAIN = false, HAS_MID = false;
    const unsigned char* gate; int ldg; bf16_t* mrgb; int ldc;
    __device__ __forceinline__ void operator()(const f32x4 (&acc)[2][2][4][2], const Unit& u, int wr, int wc, int fr, int fq) const {
        const int row0 = u.pm * BM + wr * 64 + fr, col0 = u.pn * BM + wc * 64 + 8 * fq;
#pragma unroll
        for (int ai = 0; ai < 2; ++ai) {
            u32x2 gw[4][2]; u32x4 pv[4][2];
#pragma unroll
            for (int m = 0; m < 4; ++m)
#pragma unroll
                for (int bj = 0; bj < 2; ++bj) { const int row = row0 + ai * HALF + m * 16;
                    gw[m][bj] = *(const u32x2*)(gate + (size_t)row * ldg + col0 + bj * 32);
                    if (MODE != 0) pv[m][bj] = *(const u32x4*)(mrgb + (size_t)row * ldc + col0 + bj * 32); }
#pragma unroll
            for (int m = 0; m < 4; ++m)
#pragma unroll
                for (int bj = 0; bj < 2; ++bj) { const size_t off = (size_t)(row0 + ai * HALF + m * 16) * ldc + col0 + bj * 32;
                    const u32x2 g2 = gw[m][bj]; const f32x4 a0 = acc[ai][bj][m][0], a1 = acc[ai][bj][m][1];
                    const float k255 = 1.f / 255.f;
                    float v[8];
                    v[0] = (float)(g2.x & 255u) * k255 * a0[0]; v[1] = (float)((g2.x >> 8) & 255u) * k255 * a0[1]; v[2] = (float)((g2.x >> 16) & 255u) * k255 * a0[2]; v[3] = (float)(g2.x >> 24) * k255 * a0[3];
                    v[4] = (float)(g2.y & 255u) * k255 * a1[0]; v[5] = (float)((g2.y >> 8) & 255u) * k255 * a1[1]; v[6] = (float)((g2.y >> 16) & 255u) * k255 * a1[2]; v[7] = (float)(g2.y >> 24) * k255 * a1[3];
                    if (MODE != 0) { const u32x4 p = pv[m][bj]; v[0] += bf_lo(p.x); v[1] += bf_hi(p.x); v[2] += bf_lo(p.y); v[3] += bf_hi(p.y); v[4] += bf_lo(p.z); v[5] += bf_hi(p.z); v[6] += bf_lo(p.w); v[7] += bf_hi(p.w); }
                    u32x4 w; w.x = cvt_pk_bf16(v[0], v[1]); w.y = cvt_pk_bf16(v[2], v[3]); w.z = cvt_pk_bf16(v[4], v[5]); w.w = cvt_pk_bf16(v[6], v[7]);
                    *(u32x4*)(mrgb + off) = w; }
        }
    }
};

struct EpiMerge {
    static constexpr bool PERM = true, AFTER_DRAIN = false, HAS_MID = true;
    const unsigned char* gate; int ldg; bf16_t* mrgb; int ldc;
    __device__ __forceinline__ bool is_mid(int ktiles_done) const { return ktiles_done == 16 || ktiles_done == 24; }
    __device__ __forceinline__ void mid(f32x4 (&acc)[2][2][4][2], const Unit& u, int wr, int wc, int fr, int fq, int ktiles_done) const {
        const int row0 = launder_v(u.pm * BM + wr * 64 + fr), col0 = launder_v(u.pn * BM + wc * 64 + 8 * fq);
        const unsigned char* gnum = gate + (ktiles_done == 16 ? 0 : 2048); const unsigned char* gden = gnum + 2048;
#pragma unroll
        for (int ai = 0; ai < 2; ++ai)
#pragma unroll
          for (int mh = 0; mh < 2; ++mh) {
            u32x2 gn[2][2], gd[2][2];
#pragma unroll
            for (int m2 = 0; m2 < 2; ++m2)
#pragma unroll
                for (int bj = 0; bj < 2; ++bj) { const size_t off = (size_t)(row0 + ai * HALF + (2 * mh + m2) * 16) * ldg + col0 + bj * 32; gn[m2][bj] = *(const u32x2*)(gnum + off); gd[m2][bj] = *(const u32x2*)(gden + off); }
#pragma unroll
            for (int m2 = 0; m2 < 2; ++m2)
#pragma unroll
                for (int bj = 0; bj < 2; ++bj) { const u32x2 a = gn[m2][bj], b = gd[m2][bj]; const int m = 2 * mh + m2;
#define MRG_R(w_, sh_) ((float)(((a.w_) >> (sh_)) & 255u) * __builtin_amdgcn_rcpf((float)(((b.w_) >> (sh_)) & 255u)))
                    acc[ai][bj][m][0][0] *= MRG_R(x, 0); acc[ai][bj][m][0][1] *= MRG_R(x, 8); acc[ai][bj][m][0][2] *= MRG_R(x, 16); acc[ai][bj][m][0][3] *= MRG_R(x, 24);
                    acc[ai][bj][m][1][0] *= MRG_R(y, 0); acc[ai][bj][m][1][1] *= MRG_R(y, 8); acc[ai][bj][m][1][2] *= MRG_R(y, 16); acc[ai][bj][m][1][3] *= MRG_R(y, 24);
#undef MRG_R
                }
          }
    }
    __device__ __forceinline__ void operator()(const f32x4 (&acc)[2][2][4][2], const Unit& u, int wr, int wc, int fr, int fq) const {
        const int row0 = launder_v(u.pm * BM + wr * 64 + fr), col0 = launder_v(u.pn * BM + wc * 64 + 8 * fq);
        const unsigned char* g3 = gate + 4096;
#pragma unroll
        for (int ai = 0; ai < 2; ++ai) {
            u32x2 gw[4][2];
#pragma unroll
            for (int m = 0; m < 4; ++m)
#pragma unroll
                for (int bj = 0; bj < 2; ++bj) gw[m][bj] = *(const u32x2*)(g3 + (size_t)(row0 + ai * HALF + m * 16) * ldg + col0 + bj * 32);
#pragma unroll
            for (int m = 0; m < 4; ++m)
#pragma unroll
                for (int bj = 0; bj < 2; ++bj) { const size_t off = (size_t)(row0 + ai * HALF + m * 16) * ldc + col0 + bj * 32;
                    const u32x2 g2 = gw[m][bj]; const f32x4 a0 = acc[ai][bj][m][0], a1 = acc[ai][bj][m][1];
                    const float k255 = 1.f / 255.f;
                    float v[8];
                    v[0] = (float)(g2.x & 255u) * k255 * a0[0]; v[1] = (float)((g2.x >> 8) & 255u) * k255 * a0[1]; v[2] = (float)((g2.x >> 16) & 255u) * k255 * a0[2]; v[3] = (float)(g2.x >> 24) * k255 * a0[3];
                    v[4] = (float)(g2.y & 255u) * k255 * a1[0]; v[5] = (float)((g2.y >> 8) & 255u) * k255 * a1[1]; v[6] = (float)((g2.y >> 16) & 255u) * k255 * a1[2]; v[7] = (float)(g2.y >> 24) * k255 * a1[3];
                    u32x4 w; w.x = cvt_pk_bf16(v[0], v[1]); w.y = cvt_pk_bf16(v[2], v[3]); w.z = cvt_pk_bf16(v[4], v[5]); w.w = cvt_pk_bf16(v[6], v[7]);
                    *(u32x4*)(mrgb + off) = w; }
        }
    }
};

template <class Epi, class Sched, bool ALIGN_EPI = true>
__device__ __forceinline__ void gemm_phase(PG8_LAS unsigned char* lds, const Gemm g, const Sched& S, const Epi& E) {
    const int tid = launder_v(threadIdx.x), wid = __builtin_amdgcn_readfirstlane(tid >> 6), lane = tid & 63, wr = wid >> 2, wc = wid & 3, fr = lane & 15, fq = lane >> 4;
    const int K = g.K, nt = K / BK;
    unsigned voffA[2], voffB[2];
#pragma unroll
    for (int i = 0; i < 2; ++i) { int R, C; stage_rc(tid * 16 + i * 8192, R, C); const int Rb = 64 * (R >> 5) + perm32(R & 31);
        voffA[i] = (unsigned)(R * g.lda + C) * 2u; voffB[i] = (unsigned)(Rb * g.ldb + C) * 2u; }
    const size_t kstep = (size_t)(BK * 2);
    const size_t hstepA = (size_t)HALF * g.lda * 2, hstepB = (size_t)32 * g.ldb * 2;
    const size_t tstepA = 2 * hstepA, tstepB = (size_t)BM * g.ldb * 2;
    const unsigned ldsw = (unsigned)wid * 1024u;
    const int aoff = lds_byte(wr * 64 + fr, fq * 8), boff = lds_byte(wc * 32 + fr, fq * 8);
#define PG8_SA(b, h) (((b) * 2 + (h)) * HTB)
#define PG8_SB(b, h) ((4 + (b) * 2 + (h)) * HTB)
#define PG8_STAGE(bufoff, gbase, voff) do { _Pragma("unroll") for (int _i = 0; _i < 2; ++_i) \
        __builtin_amdgcn_global_load_lds((const unsigned*)((const char*)(gbase) + (voff)[_i]), (PG8_LAS unsigned*)(lds + (bufoff) + ldsw + _i * 8192), 16, 0, 0); } while (0)
#define PG8_LDA(dst, b, h) do { _Pragma("unroll") for (int m = 0; m < 4; ++m) _Pragma("unroll") for (int k = 0; k < 2; ++k) dst[m][k] = *(const PG8_LAS bf16x8*)(lds + PG8_SA(b, h) + aoff + m * 2048 + k * 1024); } while (0)
#define PG8_LDB(dst, b, h) do { _Pragma("unroll") for (int n = 0; n < 2; ++n) _Pragma("unroll") for (int k = 0; k < 2; ++k) dst[n][k] = *(const PG8_LAS bf16x8*)(lds + PG8_SB(b, h) + boff + n * 2048 + k * 1024); } while (0)
#define PG8_MMA(ai, bj, At, Bt) do { __builtin_amdgcn_s_setprio(1); _Pragma("unroll") for (int m = 0; m < 4; ++m) _Pragma("unroll") for (int n = 0; n < 2; ++n) _Pragma("unroll") for (int k = 0; k < 2; ++k) \
        acc[ai][bj][m][n] = __builtin_amdgcn_mfma_f32_16x16x32_bf16(Bt[n][k], At[m][k], acc[ai][bj][m][n], 0, 0, 0); __builtin_amdgcn_s_setprio(0); } while (0)
#define PG8_WAIT_V(n) asm volatile("s_waitcnt vmcnt(" #n ")" ::: "memory")
#define PG8_WAIT_L(n) asm volatile("s_waitcnt lgkmcnt(" #n ")" ::: "memory")
#define PG8_BAR __builtin_amdgcn_s_barrier()
#define PG8_SCHED __builtin_amdgcn_sched_barrier(0)
    Unit cur, nxt; int ui = 0;
    if (!S.next(0, cur)) return;
    f32x4 acc[2][2][4][2];
#pragma unroll
    for (int a = 0; a < 2; ++a)
#pragma unroll
        for (int b = 0; b < 2; ++b)
#pragma unroll
            for (int m = 0; m < 4; ++m)
#pragma unroll
                for (int n = 0; n < 2; ++n) acc[a][b][m][n] = (f32x4){0.f, 0.f, 0.f, 0.f};
    bf16x8 At[4][2], B0[2][2], B1[2][2];
    const char* cA = (const char*)g.A + (size_t)cur.pm * tstepA; const char* cB = (const char*)g.Bt + (size_t)cur.pn * tstepB;
    S.a_ready(cur);
    PG8_STAGE(PG8_SB(0, 0), cB, voffB); PG8_STAGE(PG8_SB(0, 1), cB + hstepB, voffB); PG8_STAGE(PG8_SA(0, 0), cA, voffA); PG8_STAGE(PG8_SA(0, 1), cA + hstepA, voffA);
    if (wr == 1) PG8_BAR;
    PG8_WAIT_V(2); PG8_BAR;
    PG8_STAGE(PG8_SB(1, 0), cB + kstep, voffB); PG8_STAGE(PG8_SA(1, 0), cA + kstep, voffA); PG8_STAGE(PG8_SB(1, 1), cB + hstepB + kstep, voffB);
    PG8_WAIT_V(6); PG8_BAR;
    for (;;) {
        const bool has_next = S.next(ui + 1, nxt);
        const char* nA = has_next ? (const char*)g.A + (size_t)nxt.pm * tstepA : cA; const char* nB = has_next ? (const char*)g.Bt + (size_t)nxt.pn * tstepB : cB;
        for (int t = 0; t < nt; t += 2) {
            const bool last = (t == nt - 2);
            const char* a1 = cA + (size_t)(t + 1) * kstep;
            const char* a2 = last ? nA : cA + (size_t)(t + 2) * kstep; const char* b2 = last ? nB : cB + (size_t)(t + 2) * kstep;
            const char* a3 = a2 + kstep; const char* b3 = b2 + kstep;
            if (last && has_next) S.a_ready(nxt);
            PG8_LDB(B0, 0, 0); PG8_LDB(B1, 0, 1); PG8_SCHED; PG8_LDA(At, 0, 0); PG8_STAGE(PG8_SA(1, 1), a1 + hstepA, voffA);
            PG8_WAIT_V(8); PG8_WAIT_L(0); PG8_BAR; PG8_MMA(0, 0, At, B0); PG8_MMA(0, 1, At, B1); PG8_BAR; PG8_SCHED;
            PG8_LDA(At, 0, 1); PG8_STAGE(PG8_SB(0, 0), b2, voffB); PG8_STAGE(PG8_SB(0, 1), b2 + hstepB, voffB); PG8_STAGE(PG8_SA(0, 0), a2, voffA);
            PG8_WAIT_V(8); PG8_WAIT_L(0); PG8_BAR; PG8_MMA(1, 0, At, B0); PG8_MMA(1, 1, At, B1); PG8_BAR; PG8_SCHED;
            PG8_LDB(B0, 1, 0); PG8_LDB(B1, 1, 1); PG8_SCHED; PG8_LDA(At, 1, 0); PG8_STAGE(PG8_SA(0, 1), a2 + hstepA, voffA);
            PG8_WAIT_V(8); PG8_WAIT_L(0); PG8_BAR; PG8_MMA(0, 0, At, B0); PG8_MMA(0, 1, At, B1); PG8_BAR; PG8_SCHED;
            PG8_LDA(At, 1, 1); PG8_STAGE(PG8_SB(1, 0), b3, voffB); PG8_STAGE(PG8_SB(1, 1), b3 + hstepB, voffB); PG8_STAGE(PG8_SA(1, 0), a3, voffA);
            PG8_WAIT_V(8); PG8_WAIT_L(0); PG8_BAR; PG8_MMA(1, 0, At, B0); PG8_MMA(1, 1, At, B1); PG8_BAR; PG8_SCHED;
            if constexpr (Epi::HAS_MID) { if (E.is_mid(t + 2)) { E.mid(acc, cur, wr, wc, fr, fq, t + 2); PG8_SCHED; } }
        }
        if constexpr (ALIGN_EPI) { if (wr == 0) PG8_BAR; }
        E(acc, cur, wr, wc, fr, fq);
        if (!has_next) break;
#pragma unroll
        for (int a = 0; a < 2; ++a)
#pragma unroll
            for (int b = 0; b < 2; ++b)
#pragma unroll
                for (int m = 0; m < 4; ++m)
#pragma unroll
                    for (int n = 0; n < 2; ++n) acc[a][b][m][n] = (f32x4){0.f, 0.f, 0.f, 0.f};
        cur = nxt; cA = nA; cB = nB; ++ui;
        if constexpr (ALIGN_EPI) { if (wr == 1) PG8_BAR; }
    }
    PG8_WAIT_V(0);
    if constexpr (!ALIGN_EPI) { if (wr == 0) PG8_BAR; }
    PG8_BAR;
#undef PG8_SA
#undef PG8_SB
#undef PG8_STAGE
#undef PG8_LDA
#undef PG8_LDB
#undef PG8_MMA
#undef PG8_WAIT_V
#undef PG8_WAIT_L
#undef PG8_BAR
#undef PG8_SCHED
}
}

#define XB_TMO      128
#define XB_XCNT(j)  (256  + 64 * (j))
#define XB_XSUB(j)  (1280 + 64 * (j))
#define XB_XGEN(j)  (2304 + 64 * (j))
#define XB_TOP      3328
#define XB_TOPGEN   3392
#define XCD_BAR_WORDS 3456
#define XB_SPIN_CAP (1u << 22)
__device__ __forceinline__ unsigned xb_ld(unsigned* p)              { return __hip_atomic_load(p, __ATOMIC_RELAXED, __HIP_MEMORY_SCOPE_AGENT); }
__device__ __forceinline__ unsigned xb_add(unsigned* p, unsigned v) { return __hip_atomic_fetch_add(p, v, __ATOMIC_RELAXED, __HIP_MEMORY_SCOPE_AGENT); }
__device__ __forceinline__ unsigned xb_xcc_id() { return (unsigned)__builtin_amdgcn_s_getreg((3 << 11) | 20) & 0xFu; }
#define XB_SPIN(cond, bar) do { unsigned _sp = 0; while (cond) { __builtin_amdgcn_s_sleep(8); \
    if ((++_sp & 255u) == 0u) { if (xb_ld(&(bar)[XB_TMO])) break; if (_sp > XB_SPIN_CAP) { atomicAdd(&(bar)[XB_TMO], 1u); break; } } } } while (0)
struct XcdBarrier { unsigned* bar; unsigned x; volatile LAS unsigned* st; unsigned G; };
__device__ __forceinline__ XcdBarrier xcd_barrier_post(unsigned* bar, volatile LAS unsigned* st) {
    XcdBarrier b; b.bar = bar; b.x = xb_xcc_id(); b.st = st; b.G = 0;
    if (threadIdx.x == 0) (void)xb_add(&bar[XB_XCNT(b.x)], 1u);
    return b;
}
__device__ __forceinline__ void xcd_barrier_complete(unsigned* bar, unsigned x, unsigned G, unsigned& nloc, unsigned& nx) {
    unsigned sum, cnt, mine, sp = 0u;
    for (;;) {
        sum = 0u; cnt = 0u; mine = 0u;
#pragma unroll
        for (unsigned j = 0; j < 16; ++j) { const unsigned c = xb_ld(&bar[XB_XCNT(j)]); sum += c; cnt += (c > 0u) ? 1u : 0u; mine = (j == x) ? c : mine; }
        if (sum == G) break;
        __builtin_amdgcn_s_sleep(1);
        if ((++sp & 255u) == 0u) { if (xb_ld(&bar[XB_TMO])) break; if (sp > XB_SPIN_CAP) { atomicAdd(&bar[XB_TMO], 1u); break; } }
    }
    nloc = mine > 0u ? mine : 1u; nx = cnt > 0u ? cnt : 1u;
}
__device__ __forceinline__ void xcd_barrier(const XcdBarrier& b) {
    asm volatile("s_waitcnt vmcnt(0)" ::: "memory");
    __syncthreads();
    if (threadIdx.x == 0) {
        unsigned* bar = b.bar;
        __builtin_amdgcn_s_waitcnt(0);
        unsigned nloc = b.st[0], nx = b.st[1];
        if (nloc == 0u) { xcd_barrier_complete(bar, b.x, b.G, nloc, nx); b.st[0] = nloc; b.st[1] = nx; }
        const unsigned old = xb_add(&bar[XB_XSUB(b.x)], 1u);
        const unsigned gen = old / nloc;
        if (old + 1u == (gen + 1u) * nloc) {
            __builtin_amdgcn_fence(__ATOMIC_RELEASE, "agent");
            asm volatile("s_waitcnt vmcnt(0)" ::: "memory");
            const unsigned og = xb_add(&bar[XB_TOP], 1u);
            const unsigned tg = og / nx;
            if (og + 1u == (tg + 1u) * nx) xb_add(&bar[XB_TOPGEN], 1u);
            else XB_SPIN(xb_ld(&bar[XB_TOPGEN]) == tg, bar);
            __builtin_amdgcn_fence(__ATOMIC_ACQUIRE, "agent");
            xb_add(&bar[XB_XGEN(b.x)], 1u);
            asm volatile("s_waitcnt vmcnt(0)" ::: "memory");
        } else {
            XB_SPIN(xb_ld(&bar[XB_XGEN(b.x)]) == gen, bar);
            __builtin_amdgcn_fence(__ATOMIC_ACQUIRE, "agent");
            asm volatile("s_waitcnt vmcnt(0)" ::: "memory");
        }
    }
    __syncthreads();
}

template <int MODE>
__device__ __forceinline__ void transpose_item(const float* __restrict__ W, int K, int Nsrc, bf16* __restrict__ WT, LAS float* scr, int kb, int nb, int lane, const float* __restrict__ gk, int ldw = 0  ) {
    const int k0 = 64 * kb, n0 = 32 * nb;
    const int dstc = n0 + (lane & 31);
    int srcc = dstc;
    if (MODE == 1) srcc = dstc < 3072 ? dstc : (dstc < 3088 ? dstc - 3072 + 4096 : (dstc < 3328 ? -1 : (dstc < 3840 ? dstc - 3328 + 5392 : (dstc < 9984 ? dstc - 3840 + 6416 : (dstc < 11008 ? dstc - 9984 + 3072 :
                          (dstc < 11520 ? dstc - 11008 + 4112 : (dstc < 11776 ? dstc - 11520 + 4624 : (dstc < 12288 ? dstc - 11776 + 4880 : dstc - 12288 + 5904))))))));
    const bool ok = srcc >= 0; const int sc = ok ? srcc : 0;
    const float* wp = W + (size_t)(k0 + (lane >> 5)) * Nsrc + sc;
    float v[32];
#pragma unroll
    for (int i = 0; i < 32; ++i) v[i] = wp[(size_t)(2 * i) * Nsrc];
    if (gk) { float gv[32];
#pragma unroll
        for (int i = 0; i < 32; ++i) gv[i] = gk[k0 + 2 * i + (lane >> 5)];
#pragma unroll
        for (int i = 0; i < 32; ++i) v[i] *= gv[i]; }
#pragma unroll
    for (int i = 0; i < 32; ++i) scr[(2 * i + (lane >> 5)) * 33 + (lane & 31)] = ok ? v[i] : 0.f;
    LDS_WAIT(); asm volatile("" ::: "memory");
    const int c = lane & 7;
#pragma unroll
    for (int j = 0; j < 4; ++j) { const int n = (lane >> 3) + 8 * j; const LAS float* s = scr + (8 * c) * 33 + n;
        u32x4 o; o.x = cvt_pk_bf16(s[0 * 33], s[1 * 33]); o.y = cvt_pk_bf16(s[2 * 33], s[3 * 33]); o.z = cvt_pk_bf16(s[4 * 33], s[5 * 33]); o.w = cvt_pk_bf16(s[6 * 33], s[7 * 33]);
        *(u32x4*)(WT + (size_t)(n0 + n) * (ldw ? ldw : K) + k0 + 8 * c) = o; }
    LDS_WAIT(); asm volatile("" ::: "memory");
}
__device__ __forceinline__ void rms_row_bf16(const float* xrow, const float* g, bf16* orow, int lane) {
    const f32x4* xr = (const f32x4*)xrow + lane; f32x4 v[8]; float s = 0.f;
#pragma unroll
    for (int j = 0; j < 8; ++j) { v[j] = xr[64 * j]; s += (v[j].x * v[j].x + v[j].y * v[j].y) + (v[j].z * v[j].z + v[j].w * v[j].w); }
    const float rstd = rsqrtf(wave_sum(s) * (1.f / D_) + EPS_);
    const f32x4* gr = (const f32x4*)g + lane;
    u32x2* o8 = (u32x2*)orow + lane;
    f32x4 gq[8];
#pragma unroll
    for (int j = 0; j < 8; ++j) gq[j] = gr[64 * j];
#pragma unroll
    for (int j = 0; j < 8; ++j) { const f32x4 gv = gq[j]; u32x2 w; w.x = cvt_pk_bf16(v[j].x * rstd * gv.x, v[j].y * rstd * gv.y); w.y = cvt_pk_bf16(v[j].z * rstd * gv.z, v[j].w * rstd * gv.w); o8[64 * j] = w; }
}
__device__ __forceinline__ void rms_row_f32_inplace(float* xrow, const float* g, int lane) {
    f32x4* xr = (f32x4*)xrow + lane; f32x4 v[8]; float s = 0.f;
#pragma unroll
    for (int j = 0; j < 8; ++j) { v[j] = xr[64 * j]; s += (v[j].x * v[j].x + v[j].y * v[j].y) + (v[j].z * v[j].z + v[j].w * v[j].w); }
    const float rstd = rsqrtf(wave_sum(s) * (1.f / D_) + EPS_);
    const f32x4* gr = (const f32x4*)g + lane;
#pragma unroll
    for (int j = 0; j < 8; ++j) { const f32x4 gv = gr[64 * j]; xr[64 * j] = v[j] * rstd * gv; }
}
__device__ __forceinline__ float red16(float v) { v += __shfl_xor(v, 1); v += __shfl_xor(v, 2); v += __shfl_xor(v, 4); v += __shfl_xor(v, 8); return v; }

typedef float f32x16 __attribute__((ext_vector_type(16)));
typedef __bf16 bf2v __attribute__((ext_vector_type(2)));
__device__ __forceinline__ unsigned pk2(float lo, float hi) { const f32x2 v = {lo, hi}; return __builtin_bit_cast(unsigned, __builtin_convertvector(v, bf2v)); }
#define MFMA16(a, b, c) __builtin_amdgcn_mfma_f32_16x16x32_bf16((a), (b), (c), 0, 0, 0)
#define MFMA32(a, b, c) __builtin_amdgcn_mfma_f32_32x32x16_bf16((a), (b), (c), 0, 0, 0)
constexpr int DU_NKW = 0, DU_QP = 32768, DU_BM = 49152, DU_OP = 81920, DU_BYTES = 98304;
constexpr int P_K = 0, P_Q = 17408, P_VBT = 52736, P_KBGT = 71168, P_KDT = 89600, P_TINV = 108032, P_QK = 117248, P_T11T = 126464, P_M1T = 129024, P_SM = 131584, P_CW = 132096, P_PS = 138240, P_QD = 142336, P_AB = 159744;
constexpr int LDK = 136, LDT = 72, LDL = 68, LDS40 = 40;
__device__ __forceinline__ bf16x8 ldfrag(const LAS bf16* mat, int ld, int row0, int k0, int fr, int fq) { return *(const LAS bf16x8*)(mat + (row0 + fr) * ld + k0 + 8 * fq); }

__device__ __forceinline__ void prep_stage_raw(LAS unsigned char* lds, const bf16* proj, const unsigned char* zero16, int t0, int hd, int tid) {
    const int lane = tid & 63, wave = __builtin_amdgcn_readfirstlane(tid >> 6);
#pragma unroll
    for (int q = 0; q < 7; ++q) {
        const int grp = wave + 8 * q, i = grp * 64 + lane, r = i / 49, c = i % 49, tt = t0 - 3 + r;
        const unsigned char* src = (c < 48 && tt >= 0) ? (const unsigned char*)(proj + (size_t)tt * NPROJ + (c >> 4) * 1024 + hd * 128 + 8 * (c & 15)) : zero16;
        if (i < 67 * 49) __builtin_amdgcn_global_load_lds((const unsigned*)src, (LAS unsigned*)(lds + grp * 1024), 16, 0, 0);
    }
    if (wave == 0) {
        const bf16* ap = proj + (size_t)(t0 + lane) * NPROJ + (hd & ~1);
        __builtin_amdgcn_global_load_lds((const unsigned*)(ap + PC_A), (LAS unsigned*)(lds + P_AB), 4, 0, 0);
        __builtin_amdgcn_global_load_lds((const unsigned*)(ap + PC_B), (LAS unsigned*)(lds + P_AB + 256), 4, 0, 0);
    }
}
__device__ __forceinline__ void delta_prep_unit(LAS unsigned char* lds, const bf16* proj, const float* convw  , float a_log, float dt_bias, unsigned char* dst  , float* gl_out, bf16* opb,
                                                int t0, int hd, int tid_in, const unsigned char* zero16, int next_t0) {
    const int tid = launder_v(tid_in);
    const int lane = tid & 63, wave = __builtin_amdgcn_readfirstlane(tid >> 6), fr = lane & 15, fq = lane >> 4;
    LAS bf16* Kk = (LAS bf16*)(lds + P_K); LAS bf16* Qq = (LAS bf16*)(lds + P_Q); LAS bf16* QD = (LAS bf16*)(lds + P_QD);
    LAS bf16* VBT = (LAS bf16*)(lds + P_VBT); LAS bf16* KBGT = (LAS bf16*)(lds + P_KBGT); LAS bf16* KDT = (LAS bf16*)(lds + P_KDT);
    LAS bf16* TINV = (LAS bf16*)(lds + P_TINV); LAS bf16* QK = (LAS bf16*)(lds + P_QK); LAS bf16* T11T = (LAS bf16*)(lds + P_T11T); LAS bf16* M1T = (LAS bf16*)(lds + P_M1T);
    LAS float* Lf = (LAS float*)(lds + P_Q); LAS float* gcs = (LAS float*)(lds + P_SM); LAS float* bts = gcs + 64;
    const float scale = 0.08838834764831845f;
    asm volatile("s_waitcnt lgkmcnt(0)" ::: "memory"); __builtin_amdgcn_s_barrier(); asm volatile("" ::: "memory");
    asm volatile("s_waitcnt vmcnt(16)" ::: "memory");
    if (wave == 0) {
        const unsigned aw = *(const LAS unsigned*)(lds + P_AB + lane * 4), bw = *(const LAS unsigned*)(lds + P_AB + 256 + lane * 4);
        const float a = (hd & 1) ? bf_hi(aw) : bf_lo(aw), b = (hd & 1) ? bf_hi(bw) : bf_lo(bw);
        float g = -__expf(a_log) * softplusf_(a + dt_bias);
#pragma unroll
        for (int off = 1; off < 64; off <<= 1) { const float nb = __shfl_up(g, off); if (lane >= off) g += nb; }
        gcs[lane] = g; bts[lane] = sigmoidf_(b);
        if (lane == 63) *gl_out = __expf(g);
    }
    asm volatile("s_waitcnt lgkmcnt(0)" ::: "memory"); __builtin_amdgcn_s_barrier(); asm volatile("" ::: "memory");
    LAS bf16* RAW = (LAS bf16*)lds;
    const LAS float* CW = (const LAS float*)(lds + P_CW);
    const int tok = lane, js = wave;
    LAS float* PS = (LAS float*)(lds + P_PS);
    float qv[16], kv[16], vv[16];
#pragma unroll
    for (int sec = 0; sec < 3; ++sec) {
        float acc[16];
#pragma unroll
        for (int i = 0; i < 16; ++i) acc[i] = 0.f;
#pragma unroll
        for (int tap = 0; tap < 4; ++tap) {
            const LAS bf16* rp = RAW + (tok + tap) * 392 + sec * 128 + 16 * js;
            const u32x4 r0 = *(const LAS u32x4*)rp, r1 = *(const LAS u32x4*)(rp + 8);
            const LAS float* wp = CW + tap * 384 + sec * 128 + 16 * js;
            const f32x4 w0 = *(const LAS f32x4*)(wp), w1 = *(const LAS f32x4*)(wp + 4), w2 = *(const LAS f32x4*)(wp + 8), w3 = *(const LAS f32x4*)(wp + 12);
            acc[0] += w0.x * bf_lo(r0.x); acc[1] += w0.y * bf_hi(r0.x); acc[2] += w0.z * bf_lo(r0.y); acc[3] += w0.w * bf_hi(r0.y);
            acc[4] += w1.x * bf_lo(r0.z); acc[5] += w1.y * bf_hi(r0.z); acc[6] += w1.z * bf_lo(r0.w); acc[7] += w1.w * bf_hi(r0.w);
            acc[8] += w2.x * bf_lo(r1.x); acc[9] += w2.y * bf_hi(r1.x); acc[10] += w2.z * bf_lo(r1.y); acc[11] += w2.w * bf_hi(r1.y);
            acc[12] += w3.x * bf_lo(r1.z); acc[13] += w3.y * bf_hi(r1.z); acc[14] += w3.z * bf_lo(r1.w); acc[15] += w3.w * bf_hi(r1.w);
        }
        float ss = 0.f;
#pragma unroll
        for (int i = 0; i < 16; ++i) { acc[i] = siluf_(acc[i]); ss += acc[i] * acc[i]; }
        if (sec < 2) PS[(sec * 8 + js) * 64 + tok] = ss;
#pragma unroll
        for (int i = 0; i < 16; ++i) { if (sec == 0) qv[i] = acc[i]; else if (sec == 1) kv[i] = acc[i]; else vv[i] = acc[i]; }
    }
    __syncthreads();
    {
        const float gc = gcs[tok], bt = bts[tok], gclast = gcs[63];
        const float eg = __expf(gc), sq = scale * eg, ekd = __expf(gclast - gc), bkg = bt * eg;
        { float sq2 = 0.f, sk2 = 0.f;
#pragma unroll
          for (int w8 = 0; w8 < 8; ++w8) { sq2 += PS[w8 * 64 + tok]; sk2 += PS[(8 + w8) * 64 + tok]; }
          const float rq = rsqrtf(sq2 + EPS_), rk = rsqrtf(sk2 + EPS_);
#pragma unroll
          for (int i = 0; i < 16; ++i) { qv[i] *= rq; kv[i] *= rk; } }
        u32x4 w;
        LAS bf16* kr = Kk + tok * LDK + 16 * js; LAS bf16* qr = Qq + tok * LDK + 16 * js; LAS bf16* qdr = QD + tok * LDK + 16 * js;
        w.x = pk2(kv[0], kv[1]); w.y = pk2(kv[2], kv[3]); w.z = pk2(kv[4], kv[5]); w.w = pk2(kv[6], kv[7]); *(LAS u32x4*)kr = w;
        w.x = pk2(kv[8], kv[9]); w.y = pk2(kv[10], kv[11]); w.z = pk2(kv[12], kv[13]); w.w = pk2(kv[14], kv[15]); *(LAS u32x4*)(kr + 8) = w;
        w.x = pk2(qv[0], qv[1]); w.y = pk2(qv[2], qv[3]); w.z = pk2(qv[4], qv[5]); w.w = pk2(qv[6], qv[7]); *(LAS u32x4*)qr = w;
        w.x = pk2(qv[8], qv[9]); w.y = pk2(qv[10], qv[11]); w.z = pk2(qv[12], qv[13]); w.w = pk2(qv[14], qv[15]); *(LAS u32x4*)(qr + 8) = w;
        w.x = pk2(sq * qv[0], sq * qv[1]); w.y = pk2(sq * qv[2], sq * qv[3]); w.z = pk2(sq * qv[4], sq * qv[5]); w.w = pk2(sq * qv[6], sq * qv[7]); *(LAS u32x4*)qdr = w;
        w.x = pk2(sq * qv[8], sq * qv[9]); w.y = pk2(sq * qv[10], sq * qv[11]); w.z = pk2(sq * qv[12], sq * qv[13]); w.w = pk2(sq * qv[14], sq * qv[15]); *(LAS u32x4*)(qdr + 8) = w;
#pragma unroll
        for (int i = 0; i < 16; ++i) {
            const int c = 16 * js + i;
            VBT[c * LDT + tok] = (bf16)(pk2(bt * vv[i], 0.f) & 0xffffu);
            KBGT[c * LDT + tok] = (bf16)(pk2(bkg * kv[i], 0.f) & 0xffffu);
            KDT[c * LDT + tok] = (bf16)(pk2(ekd * kv[i], 0.f) & 0xffffu);
        }
    }
    __syncthreads();
    const f32x4 z4 = {0.f, 0.f, 0.f, 0.f};
#pragma unroll
    for (int rep = 0; rep < 2; ++rep) {
        const int id = wave + 8 * rep, it = id >> 2, jt = id & 3;
        const int i = 16 * it + fr, j0 = 16 * jt + 4 * fq;
        u32x2 o = {0u, 0u};
        if (it >= jt) {
            f32x4 acc = z4;
#pragma unroll
            for (int ks = 0; ks < 4; ++ks) acc = MFMA16(ldfrag(Kk, LDK, 16 * jt, 32 * ks, fr, fq), ldfrag(Qq, LDK, 16 * it, 32 * ks, fr, fq), acc);
            const float gi = gcs[i]; float v[4];
#pragma unroll
            for (int r = 0; r < 4; ++r) v[r] = (i >= j0 + r) ? scale * acc[r] * __expf(gi - gcs[j0 + r]) : 0.f;
            o.x = pk2(v[0], v[1]); o.y = pk2(v[2], v[3]);
        }
        *(LAS u32x2*)(QK + i * LDT + j0) = o;
    }
    __syncthreads();
#pragma unroll
    for (int rep = 0; rep < 2; ++rep) {
        const int id = wave + 8 * rep, it = id >> 2, jt = id & 3;
        const int i = 16 * it + fr, j0 = 16 * jt + 4 * fq;
        f32x4 v = z4;
        if (it >= jt) {
            f32x4 acc = z4;
#pragma unroll
            for (int ks = 0; ks < 4; ++ks) acc = MFMA16(ldfrag(Kk, LDK, 16 * jt, 32 * ks, fr, fq), ldfrag(Kk, LDK, 16 * it, 32 * ks, fr, fq), acc);
            const float gi = gcs[i], bi = bts[i];
#pragma unroll
            for (int r = 0; r < 4; ++r) v[r] = (i > j0 + r) ? bi * acc[r] * __expf(gi - gcs[j0 + r]) : 0.f;
        }
        *(LAS f32x4*)(Lf + i * LDL + j0) = v;
        if ((it >= 2) != (jt >= 2)) { u32x2 o; o.x = pk2(v[0], v[1]); o.y = pk2(v[2], v[3]); *(LAS u32x2*)(TINV + i * LDT + j0) = o; }
    }
    __syncthreads();
    if (wave < 2) {
        const int off = 32 * wave, c = lane & 31;
        float A[32];
#pragma unroll
        for (int i = 0; i < 32; ++i) {
            float lrow = Lf[(off + i) * LDL + off + c];
            if (i > 0) asm volatile("" : "+v"(lrow) : "v"(A[i - 1]));
            float a0 = -lrow, a1 = 0.f;
#pragma unroll
            for (int j = 0; j < i; ++j) { const float s = __uint_as_float(__builtin_amdgcn_readlane(__float_as_uint(lrow), j)); if (j & 1) a1 -= s * A[j]; else a0 -= s * A[j]; }
            A[i] = a0 + a1;
        }
        if (lane < 32) {
#pragma unroll
            for (int j = 0; j < 32; ++j) TINV[(off + j) * LDT + off + c] = (bf16)(pk2(A[j] + (j == c ? 1.f : 0.f), 0.f) & 0xffffu);
            if (wave == 0) {
#pragma unroll
                for (int j = 0; j < 32; j += 2) *(LAS unsigned*)(T11T + c * LDS40 + j) = pk2(A[j] + (j == c ? 1.f : 0.f), A[j + 1] + (j + 1 == c ? 1.f : 0.f));
            }
        }
    }
    __syncthreads();
    if (wave < 4) {
        const int mt = wave >> 1, nt = wave & 1;
        const f32x4 acc = MFMA16(ldfrag(TINV, LDT, 32 + 16 * mt, 0, fr, fq), ldfrag(T11T, LDS40, 16 * nt, 0, fr, fq), z4);
        u32x2 o; o.x = pk2(acc[0], acc[1]); o.y = pk2(acc[2], acc[3]);
        *(LAS u32x2*)(M1T + (16 * nt + fr) * LDS40 + 16 * mt + 4 * fq) = o;
    }
    __syncthreads();
    if (wave < 4) {
        const int itl = wave >> 1, ct = wave & 1;
        const f32x4 acc = MFMA16(ldfrag(M1T, LDS40, 16 * ct, 0, fr, fq), ldfrag(TINV + 32, LDT, 32 + 16 * itl, 0, fr, fq), z4);
        u32x2 o; o.x = pk2(-acc[0], -acc[1]); o.y = pk2(-acc[2], -acc[3]);
        *(LAS u32x2*)(TINV + (32 + 16 * itl + fr) * LDT + 16 * ct + 4 * fq) = o;
    }
    __syncthreads();
    {
        bf16x8 at[4][2];
#pragma unroll
        for (int mt = 0; mt < 4; ++mt)
#pragma unroll
            for (int ks = 0; ks < 2; ++ks) at[mt][ks] = ldfrag(TINV, LDT, 16 * mt, 32 * ks, fr, fq);
        bf16x8 bv[2], bk[2];
#pragma unroll
        for (int ks = 0; ks < 2; ++ks) { bv[ks] = ldfrag(VBT, LDT, 16 * wave, 32 * ks, fr, fq); bk[ks] = ldfrag(KBGT, LDT, 16 * wave, 32 * ks, fr, fq); }
        f32x4 au[4], aw[4];
#pragma unroll
        for (int mt = 0; mt < 4; ++mt) { au[mt] = z4; aw[mt] = z4;
#pragma unroll
            for (int ks = 0; ks < 2; ++ks) { au[mt] = MFMA16(at[mt][ks], bv[ks], au[mt]); aw[mt] = MFMA16(at[mt][ks], bk[ks], aw[mt]); } }
#pragma unroll
        for (int mt = 0; mt < 4; ++mt) {
            u32x2 o; o.x = pk2(au[mt][0], au[mt][1]); o.y = pk2(au[mt][2], au[mt][3]); *(LAS u32x2*)(VBT + (16 * wave + fr) * LDT + 16 * mt + 4 * fq) = o;
            o.x = pk2(aw[mt][0], aw[mt][1]); o.y = pk2(aw[mt][2], aw[mt][3]); *(LAS u32x2*)(KBGT + (16 * wave + fr) * LDT + 16 * mt + 4 * fq) = o;
        }
    }
    __syncthreads();
    LAS bf16* UT = VBT; LAS bf16* WT = KBGT;
    if (next_t0 >= 0) {
        prep_stage_raw(lds, proj, zero16, next_t0, hd, tid);
    }
    asm volatile("" ::: "memory"); __builtin_amdgcn_sched_barrier(0);
    {
        bf16x8 kd[2];
#pragma unroll
        for (int ks = 0; ks < 2; ++ks) kd[ks] = ldfrag(KDT, LDT, 16 * wave, 32 * ks, fr, fq);
#pragma unroll 2
        for (int nt = 0; nt < 8; ++nt) {
            f32x4 an = z4, ab = z4;
#pragma unroll
            for (int ks = 0; ks < 2; ++ks) { an = MFMA16(ldfrag(WT, LDT, 16 * nt, 32 * ks, fr, fq), kd[ks], an); ab = MFMA16(kd[ks], ldfrag(UT, LDT, 16 * nt, 32 * ks, fr, fq), ab); }
            { const int m = 16 * wave + fr; u32x2 o; o.x = pk2(-an[0], -an[1]); o.y = pk2(-an[2], -an[3]);
              *(u32x2*)(dst + DU_NKW + ((((m >> 5) * 8 + nt) * 64 + (m & 31) + 32 * (fq & 1)) * 16) + 8 * (fq >> 1)) = o; }
            { const int dv = 16 * nt + fr, d = 16 * wave + 4 * fq, rr = d & 31; u32x2 o; o.x = pk2(ab[0], ab[1]); o.y = pk2(ab[2], ab[3]);
              *(u32x2*)(dst + DU_BM + (((((dv >> 5) * 4 + (d >> 5)) * 64 + (dv & 31) + 32 * ((rr >> 2) & 1)) * 16 + 4 * (rr >> 3)) * 2)) = o; }
        }
    }
    {
        bf16x8 wt[2], ut[2];
#pragma unroll
        for (int ks = 0; ks < 2; ++ks) { wt[ks] = ldfrag(WT, LDT, 16 * wave, 32 * ks, fr, fq); ut[ks] = ldfrag(UT, LDT, 16 * wave, 32 * ks, fr, fq); }
#pragma unroll 2
        for (int it = 0; it < 4; ++it) {
            f32x4 aq = z4, ao = z4;
#pragma unroll
            for (int ks = 0; ks < 2; ++ks) { const bf16x8 qf = ldfrag(QK, LDT, 16 * it, 32 * ks, fr, fq); aq = MFMA16(wt[ks], qf, aq); ao = MFMA16(ut[ks], qf, ao); }
            { const int i = 16 * it + fr; const u32x2 qd = *(const LAS u32x2*)(QD + i * LDK + 16 * wave + 4 * fq);
              u32x2 o; o.x = pk2(bf_lo(qd.x) - aq[0], bf_hi(qd.x) - aq[1]); o.y = pk2(bf_lo(qd.y) - aq[2], bf_hi(qd.y) - aq[3]);
              *(u32x2*)(dst + DU_QP + ((((i >> 5) * 8 + wave) * 64 + (i & 31) + 32 * (fq & 1)) * 16) + 8 * (fq >> 1)) = o; }
            { u32x2 o; o.x = pk2(ao[0], ao[1]); o.y = pk2(ao[2], ao[3]); *(u32x2*)(opb + (size_t)(t0 + 16 * it + fr) * 1024 + hd * 128 + 16 * wave + 4 * fq) = o; }
        }
    }
}

__device__ __forceinline__ void delta_scan_head(LAS unsigned char* lds, const unsigned char* dprep  , const float* gl, bf16* oraw, int hd, int tid) {
    const int lane = tid & 63, wave = __builtin_amdgcn_readfirstlane(tid >> 6);
    constexpr int NCH = S_ / 64, SLOT = 49152, OBUF = 3 * SLOT;
    const unsigned char* ub = dprep + (size_t)hd * (S_ / 64) * DU_BYTES;
    constexpr size_t CSTEP = (size_t)DU_BYTES;
    volatile LAS unsigned* MISCW = (volatile LAS unsigned*)(lds + MISC_OFF);
    __syncthreads();
    const unsigned sv0 = MISCW[8], sv1 = MISCW[9], sv2 = MISCW[10], sv3 = MISCW[11];
    __syncthreads();
#define SCAN_STAGE(n_, slot_) do { const unsigned char* src_ = ub + (size_t)(n_) * CSTEP + lane * 16; \
        _Pragma("unroll") for (int q_ = 0; q_ < 24; ++q_) { const int idx_ = (wave - 4) + 2 * q_; \
            __builtin_amdgcn_global_load_lds((const unsigned*)(src_ + idx_ * 1024), (LAS unsigned*)(lds + (slot_) * SLOT + idx_ * 1024), 16, 0, 0); } } while (0)
#define SCAN_FLUSH(n_) do { const int v_ = wave - 6; u32x4 t_[8]; \
        _Pragma("unroll") for (int i_ = 0; i_ < 8; ++i_) { const int tok_ = 32 * v_ + 4 * i_ + (lane >> 4), ck_ = (lane & 15) ^ (tok_ & 15); t_[i_] = *(const LAS u32x4*)(lds + OBUF + tok_ * 256 + ck_ * 16); } \
        _Pragma("unroll") for (int i_ = 0; i_ < 8; ++i_) { const int tok_ = 32 * v_ + 4 * i_ + (lane >> 4); *(u32x4*)(oraw + (size_t)(64 * (n_) + tok_) * 1024 + hd * 128 + 8 * (lane & 15)) = t_[i_]; } } while (0)
    if (wave >= 6) {
        __builtin_amdgcn_s_barrier(); asm volatile("" ::: "memory");
#pragma unroll 1
        for (int n = 0; n < NCH; ++n) {
            if (n > 0) SCAN_FLUSH(n - 1);
            asm volatile("s_waitcnt lgkmcnt(0)" ::: "memory");
            __builtin_amdgcn_s_barrier(); asm volatile("" ::: "memory");
            __builtin_amdgcn_s_barrier(); asm volatile("" ::: "memory");
        }
        SCAN_FLUSH(NCH - 1);
    } else if (wave >= 4) {
        SCAN_STAGE(0, 0); SCAN_STAGE(1, 1);
        asm volatile("s_waitcnt vmcnt(24)" ::: "memory");
        __builtin_amdgcn_s_barrier(); asm volatile("" ::: "memory");
#pragma unroll 1
        for (int n = 0; n < NCH; ++n) {
            if (n + 2 < NCH) { SCAN_STAGE(n + 2, (n + 2) % 3); asm volatile("s_waitcnt vmcnt(24)" ::: "memory"); }
            else asm volatile("s_waitcnt vmcnt(0)" ::: "memory");
            __builtin_amdgcn_s_barrier(); asm volatile("" ::: "memory");
            __builtin_amdgcn_s_barrier(); asm volatile("" ::: "memory");
        }
    } else {
        f32x16 Sacc[4];
#pragma unroll
        for (int mt = 0; mt < 4; ++mt)
#pragma unroll
            for (int r = 0; r < 16; ++r) Sacc[mt][r] = 0.f;
        u32x4 bc[16];
        float gq2[2];
#pragma unroll
        for (int par = 0; par < 2; ++par) {
            const u32x4* bp = (const u32x4*)(ub + (size_t)par * CSTEP + DU_BM + (size_t)(wave * 4 * 64 + lane) * 32);
#pragma unroll
            for (int mt = 0; mt < 4; ++mt) { bc[8 * par + 2 * mt] = bp[mt * 128]; bc[8 * par + 2 * mt + 1] = bp[mt * 128 + 1]; }
            gq2[par] = gl[par * 8 + hd];
        }
        asm volatile("" ::: "memory");
        __builtin_amdgcn_s_barrier(); asm volatile("" ::: "memory");
#pragma unroll 1
        for (int n2 = 0; n2 < NCH; n2 += 2) {
#pragma unroll
          for (int par = 0; par < 2; ++par) {
            const int n = n2 + par;
            const int slot = n % 3;
            const float g = gq2[par];
            bf16x8 Sb[8];
#define SCAN_PACK(k_) do { constexpr int mt_ = (k_) >> 1, s_ = (k_) & 1; u32x4 p_; p_.x = pk2(Sacc[mt_][8 * s_], Sacc[mt_][8 * s_ + 1]); p_.y = pk2(Sacc[mt_][8 * s_ + 2], Sacc[mt_][8 * s_ + 3]); \
                p_.z = pk2(Sacc[mt_][8 * s_ + 4], Sacc[mt_][8 * s_ + 5]); p_.w = pk2(Sacc[mt_][8 * s_ + 6], Sacc[mt_][8 * s_ + 7]); Sb[k_] = __builtin_bit_cast(bf16x8, p_); } while (0)
#define SCAN_CINIT(h_) do { const int p_ = (h_) >> 1, mt_ = p_ >> 1, h2_ = p_ & 1, hf_ = (h_) & 1, e_ = 8 * h2_ + 4 * hf_; const u32x4 b_ = bc[8 * par + 2 * mt_ + h2_]; const unsigned w0_ = hf_ ? b_.z : b_.x, w1_ = hf_ ? b_.w : b_.y; \
                Sacc[mt_][e_ + 0] = g * Sacc[mt_][e_ + 0] + bf_lo(w0_); Sacc[mt_][e_ + 1] = g * Sacc[mt_][e_ + 1] + bf_hi(w0_); \
                Sacc[mt_][e_ + 2] = g * Sacc[mt_][e_ + 2] + bf_lo(w1_); Sacc[mt_][e_ + 3] = g * Sacc[mt_][e_ + 3] + bf_hi(w1_); } while (0)
            SCAN_PACK(0); SCAN_PACK(1); SCAN_PACK(2); SCAN_PACK(3);
            const LAS bf16x8* fr0 = (const LAS bf16x8*)(lds + slot * SLOT + lane * 16);
            constexpr int PD = 4;
            bf16x8 fa[PD];
#define SCAN_FIDX(f_) (((f_) < 16) ? 32 + (f_) : (f_) - 16)
#pragma unroll
            for (int i = 0; i < PD; ++i) fa[i] = fr0[SCAN_FIDX(i) * 64];
            const int nn = (n + 2 < NCH) ? n + 2 : n;
            const u32x4* bpn = (const u32x4*)(ub + (size_t)nn * CSTEP + DU_BM + (size_t)(wave * 4 * 64 + lane) * 32);
            gq2[par] = gl[nn * 8 + hd];
            f32x16 oacc[2];
            __builtin_amdgcn_sched_barrier(0);
#pragma unroll
            for (int f = 0; f < 16; ++f) {
                const bf16x8 a = fa[f % PD];
                fa[f % PD] = fr0[SCAN_FIDX(f + PD) * 64];
                if ((f & 7) == 0) { f32x16 z16;
#pragma unroll
                    for (int r = 0; r < 16; ++r) z16[r] = 0.f;
                    oacc[f >> 3] = MFMA32(Sb[f & 7], a, z16); }
                else oacc[f >> 3] = MFMA32(Sb[f & 7], a, oacc[f >> 3]);
                if (f == 0) SCAN_PACK(4); if (f == 2) SCAN_PACK(5); if (f == 4) SCAN_PACK(6); if (f == 6) SCAN_PACK(7);
                SCAN_CINIT(f);
                if ((f & 3) == 3) { bc[8 * par + 2 * (f >> 2)] = bpn[(f >> 2) * 128]; bc[8 * par + 2 * (f >> 2) + 1] = bpn[(f >> 2) * 128 + 1]; }
                __builtin_amdgcn_sched_barrier(0);
            }
#pragma unroll
            for (int f = 16; f < 48; ++f) {
                const bf16x8 a = fa[f % PD];
                if (f + PD < 48) fa[f % PD] = fr0[SCAN_FIDX(f + PD) * 64];
                Sacc[(f - 16) >> 3] = MFMA32(a, Sb[f & 7], Sacc[(f - 16) >> 3]);
            }
#undef SCAN_FIDX
#undef SCAN_PACK
#undef SCAN_CINIT
#pragma unroll
            for (int f = 16; f < 48 - PD; ++f) { __builtin_amdgcn_sched_group_barrier(0x008, 1, 0); __builtin_amdgcn_sched_group_barrier(0x100, 1, 0); }
            __builtin_amdgcn_sched_group_barrier(0x008, PD, 0);
            asm volatile("s_waitcnt lgkmcnt(0)" ::: "memory");
            __builtin_amdgcn_s_barrier(); asm volatile("" ::: "memory");
#pragma unroll
            for (int mt = 0; mt < 2; ++mt) { const int tok = 32 * mt + (lane & 31);
#pragma unroll
                for (int gq = 0; gq < 4; ++gq) { u32x2 w; w.x = pk2(oacc[mt][4 * gq], oacc[mt][4 * gq + 1]); w.y = pk2(oacc[mt][4 * gq + 2], oacc[mt][4 * gq + 3]);
                    *(LAS u32x2*)(lds + OBUF + tok * 256 + (((4 * wave + gq) ^ (tok & 15)) * 16) + 8 * (lane >> 5)) = w; } }
            asm volatile("s_waitcnt lgkmcnt(0)" ::: "memory");
            __builtin_amdgcn_s_barrier(); asm volatile("" ::: "memory");
          }
        }
    }
    __syncthreads();
    if (tid == 0) { MISCW[8] = sv0; MISCW[9] = sv1; MISCW[10] = sv2; MISCW[11] = sv3; }
    __syncthreads();
#undef SCAN_STAGE
#undef SCAN_FLUSH
}

__device__ __forceinline__ int vt_pos(int key) { const int kk = key & 15; return (key & ~15) + 8 * ((kk >> 2) & 1) + 4 * (kk >> 3) + (kk & 3); }
template <int DH, int NKEYS>
__device__ __forceinline__ void stage_k(LAS bf16* Kl, const bf16* __restrict__ src, int gld, int kbase, int tid, bool zero) {
    constexpr int CPR = DH / 8, NIT = NKEYS * CPR / 512;
    u32x4 v[NIT];
#pragma unroll
    for (int it = 0; it < NIT; ++it) { const int ci = tid + 512 * it, r = ci / CPR, c = ci % CPR; const unsigned z0 = (unsigned)launder_v(0); v[it] = (u32x4){z0, z0, z0, z0}; if (!zero) v[it] = *(const u32x4*)(src + (size_t)r * gld + 8 * c); }
#pragma unroll
    for (int it = 0; it < NIT; ++it) { const int ci = tid + 512 * it, r = ci / CPR, c = ci % CPR; *(LAS u32x4*)(Kl + (kbase + r) * (DH + 8) + 8 * c) = v[it]; }
}
template <int DH, int NKEYS>
__device__ __forceinline__ void stage_vt(LAS bf16* Vt, int ldv, const bf16* __restrict__ src, int gld, int kbase, int tid, bool zero) {
    constexpr int CPR = DH / 8, NIT = NKEYS * CPR / 512;
    u32x4 v[NIT];
#pragma unroll
    for (int it = 0; it < NIT; ++it) { const int ci = tid + 512 * it, r = ci % NKEYS, c = ci / NKEYS; const unsigned z0 = (unsigned)launder_v(0); v[it] = (u32x4){z0, z0, z0, z0}; if (!zero) v[it] = *(const u32x4*)(src + (size_t)r * gld + 8 * c); }
#pragma unroll
    for (int it = 0; it < NIT; ++it) { const int ci = tid + 512 * it, r = ci % NKEYS, c = ci / NKEYS;
        LAS bf16* d = Vt + (8 * c) * ldv + vt_pos(kbase + r); const u32x4 w = v[it];
        d[0] = (bf16)(w.x & 0xffffu); d[ldv] = (bf16)(w.x >> 16); d[2 * ldv] = (bf16)(w.y & 0xffffu); d[3 * ldv] = (bf16)(w.y >> 16);
        d[4 * ldv] = (bf16)(w.z & 0xffffu); d[5 * ldv] = (bf16)(w.z >> 16); d[6 * ldv] = (bf16)(w.w & 0xffffu); d[7 * ldv] = (bf16)(w.w >> 16); }
}
template <int DH>
__device__ __forceinline__ void stage_k_loop(LAS bf16* Kl, const bf16* src, int gld, int nkeys, int kbase, int tid) {
    constexpr int CPR = DH / 8;
    for (int ci = tid; ci < nkeys * CPR; ci += 512) { const int r = ci / CPR, c = ci % CPR;
        const u32x4 v = *(const u32x4*)(src + (size_t)r * gld + 8 * c);
        *(LAS u32x4*)(Kl + (kbase + r) * (DH + 8) + 8 * c) = v; }
}
template <int DH>
__device__ __forceinline__ void stage_vt_loop(LAS bf16* Vt, int ldv, const bf16* src, int gld, int nkeys, int kbase, int tid) {
    constexpr int CPR = DH / 8;
    for (int ci = tid; ci < nkeys * CPR; ci += 512) { const int r = ci % nkeys, c = ci / nkeys;
        const u32x4 v = *(const u32x4*)(src + (size_t)r * gld + 8 * c);
        LAS bf16* d = Vt + (8 * c) * ldv + vt_pos(kbase + r);
        d[0] = (bf16)(v.x & 0xffffu); d[ldv] = (bf16)(v.x >> 16); d[2 * ldv] = (bf16)(v.y & 0xffffu); d[3 * ldv] = (bf16)(v.y >> 16);
        d[4 * ldv] = (bf16)(v.z & 0xffffu); d[5 * ldv] = (bf16)(v.z >> 16); d[6 * ldv] = (bf16)(v.w & 0xffffu); d[7 * ldv] = (bf16)(v.w >> 16); }
}
__device__ __forceinline__ bf16x8 pack8(const f32x16& x, int s) {
    u32x4 p; p.x = pk2(x[8 * s], x[8 * s + 1]); p.y = pk2(x[8 * s + 2], x[8 * s + 3]); p.z = pk2(x[8 * s + 4], x[8 * s + 5]); p.w = pk2(x[8 * s + 6], x[8 * s + 7]);
    return __builtin_bit_cast(bf16x8, p);
}
__device__ __forceinline__ int crow16(int reg, int h) { return (reg & 3) + 8 * (reg >> 2) + 4 * h; }
__device__ __forceinline__ void store_ot(bf16* orow  , const f32x16& o, float inv, int h) {
#pragma unroll
    for (int g = 0; g < 4; ++g) { u32x2 w; w.x = pk2(o[4 * g] * inv, o[4 * g + 1] * inv); w.y = pk2(o[4 * g + 2] * inv, o[4 * g + 3] * inv); *(u32x2*)(orow + 8 * g + 4 * h) = w; }
}

__device__ __forceinline__ void swa_unit(LAS unsigned char* lds, const bf16* proj, const float* sinks, bf16* y, int kvh, int b, int tid) {
    const int lane = tid & 63, wave = __builtin_amdgcn_readfirstlane(tid >> 6), c = lane & 31, h = lane >> 5;
    LAS bf16* Kl = (LAS bf16*)lds;
    LAS bf16* Vt = (LAS bf16*)(lds + 36864);
    constexpr int LDV = 264;
    __syncthreads();
    const bf16* kg = proj + PC_SWAK + kvh * 64; const bf16* vg = proj + PC_SWAV + kvh * 64;
    if (b > 0) { stage_k<64, 256>(Kl, kg + (size_t)(128 * (b - 1)) * NPROJ, NPROJ, 0, tid, false); stage_vt<64, 256>(Vt, LDV, vg + (size_t)(128 * (b - 1)) * NPROJ, NPROJ, 0, tid, false); }
    else { stage_k<64, 128>(Kl, kg, NPROJ, 0, tid, true); stage_vt<64, 128>(Vt, LDV, vg, NPROJ, 0, tid, true);
           stage_k<64, 128>(Kl, kg, NPROJ, 128, tid, false); stage_vt<64, 128>(Vt, LDV, vg, NPROJ, 128, tid, false); }
    __syncthreads();
#pragma unroll 1
    for (int rep = 0; rep < 2; ++rep) {
        const int id = wave + 8 * rep, qh = id >> 2, qo = 32 * (id & 3), hg = 4 * kvh + qh;
        const int cL = launder_v(c), hL = launder_v(h);
        const int t = 128 * b + qo + c;
        const float slope = exp2f(-(float)(hg + 1)), sink = sinks[hg];
        bf16x8 qf[4];
#pragma unroll
        for (int ks = 0; ks < 4; ++ks) qf[ks] = *(const bf16x8*)(proj + (size_t)t * NPROJ + PC_SWAQ + hg * 64 + 16 * ks + 8 * h);
        f32x16 sc[5];
        const int kt0 = qo >> 5;
        float mx = -INFINITY;
#pragma unroll
        for (int j5 = 0; j5 < 5; ++j5) {
            const int kt = kt0 + j5;
            f32x16 acc;
#pragma unroll
            for (int r = 0; r < 16; ++r) acc[r] = 0.f;
#pragma unroll
            for (int ks = 0; ks < 4; ++ks) acc = MFMA32(*(const LAS bf16x8*)(Kl + (32 * kt + c) * 72 + 16 * ks + 8 * h), qf[ks], acc);
            const int dbase = launder_v(cL + 128 - 32 * j5 - 4 * hL);
#pragma unroll
            for (int r = 0; r < 16; ++r) { const int dist = dbase - ((r & 3) + 8 * (r >> 2)); const int kl = qo + cL + 128 - dist;
                const bool valid = (dist >= 0) && (dist < 128) && (b > 0 || kl >= 128);
                const float s = valid ? acc[r] * 0.125f - slope * (float)dist : -INFINITY; acc[r] = s; mx = fmaxf(mx, s); }
            sc[j5] = acc;
        }
        mx = fmaxf(mx, __shfl_xor(mx, 32)); mx = fmaxf(mx, sink);
        float sum = 0.f;
#pragma unroll
        for (int j5 = 0; j5 < 5; ++j5)
#pragma unroll
            for (int r = 0; r < 16; ++r) { const float p = __expf(sc[j5][r] - mx); sc[j5][r] = p; sum += p; }
        sum += __shfl_xor(sum, 32); sum += __expf(sink - mx);
        f32x16 o[2];
#pragma unroll
        for (int mt = 0; mt < 2; ++mt)
#pragma unroll
            for (int r = 0; r < 16; ++r) o[mt][r] = 0.f;
#pragma unroll
        for (int j5 = 0; j5 < 5; ++j5)
#pragma unroll
            for (int s = 0; s < 2; ++s) { const bf16x8 pf = pack8(sc[j5], s); const int kstep = 2 * (kt0 + j5) + s;
#pragma unroll
                for (int mt = 0; mt < 2; ++mt) o[mt] = MFMA32(*(const LAS bf16x8*)(Vt + (32 * mt + c) * LDV + 16 * kstep + 8 * h), pf, o[mt]); }
        const float inv = 1.f / sum;
#pragma unroll
        for (int mt = 0; mt < 2; ++mt) store_ot(y + (size_t)t * 2048 + 1024 + hg * 64 + 32 * mt, o[mt], inv, h);
    }
}

__device__ __forceinline__ void xattn_unit(LAS unsigned char* lds, const bf16* xq, const bf16* kv  , bf16* xo, int hd, int qb, int tid) {
    const int lane = tid & 63, wave = __builtin_amdgcn_readfirstlane(tid >> 6), c = lane & 31, h = lane >> 5;
    LAS bf16* Kl = (LAS bf16*)lds;
    LAS bf16* Vt = (LAS bf16*)(lds + 69632);
    constexpr int LDV = 264;
    const float scale = 0.08838834764831845f;
    __syncthreads();
    stage_k<128, 128>(Kl, kv + hd * 128, 1024, 0, tid, false); stage_vt<128, 128>(Vt, LDV, kv + 512 + hd * 128, 1024, 0, tid, false);
    stage_k<128, 128>(Kl, kv + (size_t)128 * 1024 + hd * 128, 1024, 128, tid, false); stage_vt<128, 128>(Vt, LDV, kv + (size_t)128 * 1024 + 512 + hd * 128, 1024, 128, tid, false);
    __syncthreads();
    const int t = 256 * qb + 32 * wave + c;
    bf16x8 qf[8];
#pragma unroll
    for (int ks = 0; ks < 8; ++ks) qf[ks] = *(const bf16x8*)(xq + (size_t)t * 512 + hd * 128 + 16 * ks + 8 * h);
    f32x16 o[4];
#pragma unroll
    for (int mt = 0; mt < 4; ++mt)
#pragma unroll
        for (int r = 0; r < 16; ++r) o[mt][r] = 0.f;
    float mrun = -INFINITY, sum = 0.f;
#pragma unroll 1
    for (int half = 0; half < 2; ++half) {
        f32x16 sc[4]; float mx = -INFINITY;
#pragma unroll
        for (int j4 = 0; j4 < 4; ++j4) { const int kt = 4 * half + j4; f32x16 acc;
#pragma unroll
            for (int r = 0; r < 16; ++r) acc[r] = 0.f;
#pragma unroll
            for (int ks = 0; ks < 8; ++ks) acc = MFMA32(*(const LAS bf16x8*)(Kl + (32 * kt + c) * 136 + 16 * ks + 8 * h), qf[ks], acc);
#pragma unroll
            for (int r = 0; r < 16; ++r) { acc[r] *= scale; mx = fmaxf(mx, acc[r]); }
            sc[j4] = acc; }
        mx = fmaxf(mx, __shfl_xor(mx, 32));
        const float mnew = fmaxf(mrun, mx), resc = __expf(mrun - mnew);
        float ps = 0.f;
#pragma unroll
        for (int j4 = 0; j4 < 4; ++j4)
#pragma unroll
            for (int r = 0; r < 16; ++r) { const float p = __expf(sc[j4][r] - mnew); sc[j4][r] = p; ps += p; }
        ps += __shfl_xor(ps, 32);
        sum = sum * resc + ps; mrun = mnew;
#pragma unroll
        for (int mt = 0; mt < 4; ++mt)
#pragma unroll
            for (int r = 0; r < 16; ++r) o[mt][r] *= resc;
#pragma unroll
        for (int j4 = 0; j4 < 4; ++j4)
#pragma unroll
            for (int s = 0; s < 2; ++s) { const bf16x8 pf = pack8(sc[j4], s); const int kstep = 2 * (4 * half + j4) + s;
#pragma unroll
                for (int mt = 0; mt < 4; ++mt) o[mt] = MFMA32(*(const LAS bf16x8*)(Vt + (32 * mt + c) * LDV + 16 * kstep + 8 * h), pf, o[mt]); }
    }
    const float inv = 1.f / sum;
#pragma unroll
    for (int mt = 0; mt < 4; ++mt) store_ot(xo + (size_t)t * 512 + hd * 128 + 32 * mt, o[mt], inv, h);
}

__device__ __forceinline__ void sb_unit(LAS unsigned char* lds, const bf16* proj, float kmax2, bf16* y, int hd, int qb, int tid) {
    const int lane = tid & 63, wave = __builtin_amdgcn_readfirstlane(tid >> 6), c = lane & 31, h = lane >> 5;
    LAS bf16* Kl = (LAS bf16*)lds;
    LAS bf16* Vt = (LAS bf16*)(lds + 34816);
    LAS unsigned* flags = (LAS unsigned*)(lds + 69632);
    constexpr int LDV = 136;
    const float scale = 0.08838834764831845f;
    const int t = 256 * qb + 32 * wave + c;
    bf16x8 qf[8]; float qq = 0.f;
#pragma unroll
    for (int ks = 0; ks < 8; ++ks) { const u32x4 w = *(const u32x4*)(proj + (size_t)t * NPROJ + PC_SBQ + hd * 128 + 16 * ks + 8 * h); qq += dot8(w, w); qf[ks] = __builtin_bit_cast(bf16x8, w); }
    qq += __shfl_xor(qq, 32);
    const float zb = sqrtf(qq * kmax2) * scale;
    f32x16 o[4];
#pragma unroll
    for (int mt = 0; mt < 4; ++mt)
#pragma unroll
        for (int r = 0; r < 16; ++r) o[mt][r] = 0.f;
    float carry = 0.f; bool wdone = false;
    const int tmax = 256 * qb + 32 * wave + 31;
#pragma unroll 1
    for (int kb = 2 * qb + 1; kb >= 0; --kb) {
        __syncthreads();
        stage_k_loop<128>(Kl, proj + (size_t)(128 * kb) * NPROJ + PC_SBK + hd * 128, NPROJ, 128, 0, tid);
        stage_vt_loop<128>(Vt, LDV, proj + (size_t)(128 * kb) * NPROJ + PC_SBV + hd * 128, NPROJ, 128, 0, tid);
        __syncthreads();
        if (!wdone && 128 * kb < tmax) {
#pragma unroll 1
            for (int kt = 3; kt >= 0; --kt) {
                const int key0 = 128 * kb + 32 * kt;
                if (key0 >= tmax) continue;
                const int trel = launder_v(t - key0 - 4 * h);
                f32x16 acc;
#pragma unroll
                for (int r = 0; r < 16; ++r) acc[r] = 0.f;
#pragma unroll
                for (int ks = 0; ks < 8; ++ks) acc = MFMA32(*(const LAS bf16x8*)(Kl + (32 * kt + c) * 136 + 16 * ks + 8 * h), qf[ks], acc);
                float lg[16], gso[4], gst[4];
#pragma unroll
                for (int g = 0; g < 4; ++g) { float s = 0.f;
#pragma unroll
                    for (int r = 0; r < 4; ++r) { const int reg = 4 * g + r; const bool valid = (r + 8 * g) < trel; const float z = acc[reg] * scale; acc[reg] = z;
                        const float l = valid ? -(fmaxf(z, 0.f) + __logf(1.f + __expf(-fabsf(z)))) : 0.f; lg[reg] = l; s += l; }
                    gso[g] = s; const float oth = __shfl_xor(s, 32); gst[g] = (h == 0) ? oth : 0.f; gso[g] = s + oth; }
                float suf = carry;
#pragma unroll
                for (int g = 3; g >= 0; --g) { float R = suf + gst[g];
#pragma unroll
                    for (int r = 3; r >= 0; --r) { const int reg = 4 * g + r; R += lg[reg]; const bool valid = (r + 8 * g) < trel; acc[reg] = valid ? __expf(acc[reg] + R) : 0.f; }
                    suf += gso[g]; }
                carry = suf;
#pragma unroll
                for (int s = 0; s < 2; ++s) { const bf16x8 pf = pack8(acc, s); const int kstep = 2 * kt + s;
#pragma unroll
                    for (int mt = 0; mt < 4; ++mt) o[mt] = MFMA32(*(const LAS bf16x8*)(Vt + (32 * mt + c) * LDV + 16 * kstep + 8 * h), pf, o[mt]); }
            }
            wdone = __all(carry + zb < -110.f);
        }
        if (lane == 0) flags[wave] = (wdone || kb == 0) ? 0u : 1u;
        LDS_WAIT();
        __syncthreads();
        unsigned any = 0u;
#pragma unroll
        for (int w8 = 0; w8 < 8; ++w8) any |= flags[w8];
        if (any == 0u) break;
    }
#pragma unroll
    for (int mt = 0; mt < 4; ++mt) store_ot(y + (size_t)t * 2048 + 1536 + hd * 128 + 32 * mt, o[mt], 1.f, h);
}

__device__ __forceinline__ void dpost_token(const bf16* __restrict__ oraw, const bf16* __restrict__ opb, const bf16* __restrict__ proj, const float* __restrict__ gain, bf16* __restrict__ y, int t, int lane) {
#pragma unroll
    for (int p = 0; p < 2; ++p) {
        const int c = 512 * p + 8 * lane;
        const u32x4 ov = *(const u32x4*)(oraw + (size_t)t * 1024 + c), pv = *(const u32x4*)(opb + (size_t)t * 1024 + c);
        const f32x4 a = {bf_lo(ov.x) + bf_lo(pv.x), bf_hi(ov.x) + bf_hi(pv.x), bf_lo(ov.y) + bf_lo(pv.y), bf_hi(ov.y) + bf_hi(pv.y)},
                    b = {bf_lo(ov.z) + bf_lo(pv.z), bf_hi(ov.z) + bf_hi(pv.z), bf_lo(ov.w) + bf_lo(pv.w), bf_hi(ov.w) + bf_hi(pv.w)};
        float ss = (a.x * a.x + a.y * a.y) + (a.z * a.z + a.w * a.w) + (b.x * b.x + b.y * b.y) + (b.z * b.z + b.w * b.w);
        ss = red16(ss);
        const float r = rsqrtf(ss * (1.f / 128.f) + EPS_);
        const f32x4 g0 = *(const f32x4*)(gain + (c & 127)), g1 = *(const f32x4*)(gain + (c & 127) + 4);
        const u32x4 zz = *(const u32x4*)(proj + (size_t)t * NPROJ + PC_Z + c);
        u32x4 o;
        o.x = cvt_pk_bf16(a.x * r * g0.x * siluf_(bf_lo(zz.x)), a.y * r * g0.y * siluf_(bf_hi(zz.x)));
        o.y = cvt_pk_bf16(a.z * r * g0.z * siluf_(bf_lo(zz.y)), a.w * r * g0.w * siluf_(bf_hi(zz.y)));
        o.z = cvt_pk_bf16(b.x * r * g1.x * siluf_(bf_lo(zz.z)), b.y * r * g1.y * siluf_(bf_hi(zz.z)));
        o.w = cvt_pk_bf16(b.z * r * g1.z * siluf_(bf_lo(zz.w)), b.w * r * g1.w * siluf_(bf_hi(zz.w)));
        *(u32x4*)(y + (size_t)t * 2048 + c) = o;
    }
}

__device__ __forceinline__ void convact_item(const bf16* __restrict__ up, const float* __restrict__ cw  , bf16* __restrict__ act, int tb, int cb, int lane) {
    const int c = 512 * cb + 8 * lane;
    float wg[3][8], wv[3][8];
#pragma unroll
    for (int i = 0; i < 3; ++i) {
        const f32x4 a = *(const f32x4*)(cw + i * 8192 + c), b = *(const f32x4*)(cw + i * 8192 + c + 4);
        const f32x4 d = *(const f32x4*)(cw + i * 8192 + 4096 + c), e = *(const f32x4*)(cw + i * 8192 + 4096 + c + 4);
        wg[i][0] = a.x; wg[i][1] = a.y; wg[i][2] = a.z; wg[i][3] = a.w; wg[i][4] = b.x; wg[i][5] = b.y; wg[i][6] = b.z; wg[i][7] = b.w;
        wv[i][0] = d.x; wv[i][1] = d.y; wv[i][2] = d.z; wv[i][3] = d.w; wv[i][4] = e.x; wv[i][5] = e.y; wv[i][6] = e.z; wv[i][7] = e.w;
    }
    const int t0 = tb * 32;
    const u32x4 z4 = {0u, 0u, 0u, 0u};
    u32x4 gp0 = z4, vp0 = z4, gp1 = z4, vp1 = z4;
    if (t0 >= 2) { gp0 = *(const u32x4*)(up + (size_t)(t0 - 2) * 8192 + c); vp0 = *(const u32x4*)(up + (size_t)(t0 - 2) * 8192 + 4096 + c);
                   gp1 = *(const u32x4*)(up + (size_t)(t0 - 1) * 8192 + c); vp1 = *(const u32x4*)(up + (size_t)(t0 - 1) * 8192 + 4096 + c); }
#pragma unroll 1
    for (int bt = 0; bt < 4; ++bt) {
        u32x4 gr[10], vr[10];
        gr[0] = gp0; vr[0] = vp0; gr[1] = gp1; vr[1] = vp1;
#pragma unroll
        for (int r = 0; r < 8; ++r) { const int t = t0 + 8 * bt + r; gr[2 + r] = *(const u32x4*)(up + (size_t)t * 8192 + c); vr[2 + r] = *(const u32x4*)(up + (size_t)t * 8192 + 4096 + c); }
        u32x4 ov[8];
#pragma unroll
        for (int r = 0; r < 8; ++r) {
            float ga[8], va[8];
#define CA_TAP(i, G, V, OP) \
            ga[0] OP wg[i][0] * bf_lo(G.x); ga[1] OP wg[i][1] * bf_hi(G.x); ga[2] OP wg[i][2] * bf_lo(G.y); ga[3] OP wg[i][3] * bf_hi(G.y); \
            ga[4] OP wg[i][4] * bf_lo(G.z); ga[5] OP wg[i][5] * bf_hi(G.z); ga[6] OP wg[i][6] * bf_lo(G.w); ga[7] OP wg[i][7] * bf_hi(G.w); \
            va[0] OP wv[i][0] * bf_lo(V.x); va[1] OP wv[i][1] * bf_hi(V.x); va[2] OP wv[i][2] * bf_lo(V.y); va[3] OP wv[i][3] * bf_hi(V.y); \
            va[4] OP wv[i][4] * bf_lo(V.z); va[5] OP wv[i][5] * bf_hi(V.z); va[6] OP wv[i][6] * bf_lo(V.w); va[7] OP wv[i][7] * bf_hi(V.w);
            CA_TAP(0, gr[r], vr[r], =) CA_TAP(1, gr[r + 1], vr[r + 1], +=) CA_TAP(2, gr[r + 2], vr[r + 2], +=)
#undef CA_TAP
            u32x4 o;
            o.x = cvt_pk_bf16(siluf_(ga[0]) * va[0], siluf_(ga[1]) * va[1]); o.y = cvt_pk_bf16(siluf_(ga[2]) * va[2], siluf_(ga[3]) * va[3]);
            o.z = cvt_pk_bf16(siluf_(ga[4]) * va[4], siluf_(ga[5]) * va[5]); o.w = cvt_pk_bf16(siluf_(ga[6]) * va[6], siluf_(ga[7]) * va[7]);
            ov[r] = o;
        }
#pragma unroll
        for (int r = 0; r < 8; ++r) *(u32x4*)(act + (size_t)(t0 + 8 * bt + r) * 4096 + c) = ov[r];
        gp0 = gr[8]; vp0 = vr[8]; gp1 = gr[9]; vp1 = vr[9];
    }
}

__device__ __forceinline__ const void* arg_ptr(int i) {
    const int off = launder_s(i * 8);
    const __attribute__((address_space(4))) char* ka = (const __attribute__((address_space(4))) char*)__builtin_amdgcn_kernarg_segment_ptr();
    return *(const void* const __attribute__((address_space(4)))*)(ka + off);
}
#define AIN(i) ((const float*)arg_ptr(i))
struct Args { const float* in[23]; float* out; unsigned char* ws; };
static_assert(sizeof(Args) == 25 * 8, "Args has no padding");

__global__ void __launch_bounds__(NWAVES * 64, 2) fwd_kernel(Args args) {
    extern __shared__ __attribute__((aligned(16))) unsigned char lds_raw[];
    LAS unsigned char* lds = (LAS unsigned char*)lds_raw;
    const int tid0 = threadIdx.x;
    const int G = gridDim.x, bx = blockIdx.x;
    const int NGW = G * NWAVES;
    unsigned* ctl0 = (unsigned*)((unsigned char*)arg_ptr(24) + WS_CTL);
    for (int u = tid0; u < (LDS_BYTES - LDSCTL_OFF) / 4; u += NWAVES * 64) ((LAS unsigned*)(lds + LDSCTL_OFF))[u] = 0u;
    __syncthreads();
    volatile LAS unsigned* MISC = (volatile LAS unsigned*)(lds + MISC_OFF);
    (void)xcd_barrier_post(ctl0 + CW_BAR, MISC + 8);
    if (bx >= 8) (void)xcd_barrier_post(ctl0 + CW_BAR2, MISC + 10);
#define GRID_BAR() do { XcdBarrier b_; b_.bar = (unsigned*)((unsigned char*)arg_ptr(24) + WS_CTL) + CW_BAR; b_.x = xb_xcc_id(); b_.st = MISC + 8; b_.G = gridDim.x; xcd_barrier(b_); } while (0)
#define SUB_BAR() do { XcdBarrier b_; b_.bar = (unsigned*)((unsigned char*)arg_ptr(24) + WS_CTL) + CW_BAR2; b_.x = xb_xcc_id(); b_.st = MISC + 10; b_.G = gridDim.x - 8; xcd_barrier(b_); } while (0)
#define PHASE_IDS() const int tid = launder_v(threadIdx.x), lane = tid & 63, wave = __builtin_amdgcn_readfirstlane(tid >> 6), gw = bx * NWAVES + wave; (void)lane; (void)gw; (void)tid; WS_PTRS()

#define WS_PTRS() unsigned char* ws = (unsigned char*)arg_ptr(24); float* hbuf = (float*)arg_ptr(23); (void)hbuf; \
    bf16* Win_t = (bf16*)(ws + WS_WIN); bf16* Wup_t = (bf16*)(ws + WS_WUP); bf16* Wdn_t = (bf16*)(ws + WS_WDN); bf16* Wo_t = (bf16*)(ws + WS_WO); \
    bf16* Wbd_t = (bf16*)(ws + WS_WBD); bf16* Wbs_t = (bf16*)(ws + WS_WBS); bf16* Wbb_t = (bf16*)(ws + WS_WBB); \
    bf16* Wxq_t = (bf16*)(ws + WS_WXQ); bf16* Wxkv_t = (bf16*)(ws + WS_WXKV); bf16* Wxo_t = (bf16*)(ws + WS_WXO); \
    bf16* XN = (bf16*)(ws + WS_XN); bf16* PROJ = (bf16*)(ws + WS_PROJ); bf16* UP = (bf16*)(ws + WS_UP); bf16* ACT = (bf16*)(ws + WS_ACT); \
    unsigned char* DPREP = ws + WS_DPREP; bf16* ORAW = (bf16*)(ws + WS_ORAW); bf16* OPB = (bf16*)(ws + WS_OPB); (void)OPB; bf16* Y = (bf16*)(ws + WS_Y); \
    unsigned char* GATES = ws + WS_MRG; (void)GATES; bf16* MRGB = (bf16*)(ws + WS_MRGB); bf16* XQ = (bf16*)(ws + WS_XQ); bf16* XO = (bf16*)(ws + WS_XO); \
    bf16* KV = (bf16*)(ws + WS_KV); bf16* MEMN = (bf16*)(ws + WS_MEMN); float* GL = (float*)(ws + WS_GL); unsigned* ctl = (unsigned*)(ws + WS_CTL); unsigned long long* SSQ = (unsigned long long*)(ws + WS_SSQ); (void)SSQ; \
    (void)Win_t; (void)Wup_t; (void)Wdn_t; (void)Wo_t; (void)Wbd_t; (void)Wbs_t; (void)Wbb_t; (void)Wxq_t; (void)Wxkv_t; (void)Wxo_t; (void)XN; (void)PROJ; (void)UP; (void)ACT; \
    (void)DPREP; (void)ORAW; (void)Y; (void)MRGB; (void)XQ; (void)XO; (void)KV; (void)MEMN; (void)GL; (void)ctl

#define CONVERT_WEIGHTS(LIN, LREST, W0_, NW_) do { \
        LAS float* scr = (LAS float*)(lds + wave * 16384); \
        constexpr int N_IN = 32 * 400, N_UP = 32 * 256, N_DN = 64 * 64, N_O = 32 * 64, N_BD = 16 * 64, N_BS = 8 * 64, N_XQ = 32 * 16, N_XKV = 32 * 32, N_XO = 8 * 64; \
        constexpr int N_REST = N_UP + N_DN + N_O + N_BD + 2 * N_BS + N_XQ + N_XKV + N_XO; \
        const int lin_ = (LIN), lrest_ = (LREST); \
        const int nitems_ = (lin_ >= 0 ? N_IN : 0) + (lrest_ >= 0 ? N_REST : 0); \
        _Pragma("unroll 1") for (int it = (W0_); it < nitems_; it += (NW_)) { \
            int r = it; \
            if (lin_ >= 0) { if (r < N_IN) { const int kb = r / 400, nb = r % 400; \
                transpose_item<1>(AIN(3) + (size_t)lin_ * 2048 * IN_COLS_SRC, 2048, IN_COLS_SRC, Win_t + (size_t)lin_ * NPROJ * 2048, scr, kb, nb, lane, AIN(2) + lin_ * 2048); continue; } r -= N_IN; } \
            TR_CASE(N_UP, 19, 2048, 8192, Wup_t, AIN(18) + lrest_ * 2048) TR_CASE(N_DN, 21, 4096, 2048, Wdn_t, nullptr) TR_CASE(N_O, 12, 2048, 2048, Wo_t, nullptr) TR_CASEW(N_BD, 9, 1024, 2048, 0) \
            TR_CASEW(N_BS, 10, 512, 2048, 1024) TR_CASEW(N_BS, 11, 512, 2048, 1536) TR_CASE(N_XQ, 15, 2048, 512, Wxq_t, AIN(13) + lrest_ * 2048) TR_CASE(N_XKV, 16, 2048, 1024, Wxkv_t, nullptr) TR_CASE(N_XO, 17, 512, 2048, Wxo_t, nullptr) \
        } } while (0)
#define TR_CASEW(NPER, IDX, KK, NN, KOFF) \
            if (r < (NPER)) { const int kb = r / ((NN) / 32), nb = r % ((NN) / 32); \
                transpose_item<0>(AIN(IDX) + (size_t)lrest_ * (KK) * (NN), KK, NN, Wbd_t + (size_t)lrest_ * 2048 * 2048 + (KOFF), scr, kb, nb, lane, nullptr, 2048); continue; } r -= (NPER);
#define TR_CASE(NPER, IDX, KK, NN, DSTP, GK) \
            if (r < (NPER)) { const int kb = r / ((NN) / 32), nb = r % ((NN) / 32); \
                transpose_item<0>(AIN(IDX) + (size_t)lrest_ * (KK) * (NN), KK, NN, (DSTP) + (size_t)lrest_ * (NN) * (KK), scr, kb, nb, lane, GK); continue; } r -= (NPER);
    {
        PHASE_IDS();
        CONVERT_WEIGHTS(0, -1, gw, NGW);
#pragma unroll 1
        for (int m = gw; m < S_; m += NGW) {
            const f32x4* xr = (const f32x4*)(AIN(0) + (size_t)m * D_) + lane; u32x2* o8 = (u32x2*)(XN + (size_t)m * D_) + lane; float ss = 0.f;
            f32x4 xv[8];
#pragma unroll
            for (int j = 0; j < 8; ++j) xv[j] = xr[64 * j];
#pragma unroll
            for (int j = 0; j < 8; ++j) { const f32x4 v = xv[j]; ss += (v.x * v.x + v.y * v.y) + (v.z * v.z + v.w * v.w); u32x2 w; w.x = cvt_pk_bf16(v.x, v.y); w.y = cvt_pk_bf16(v.z, v.w); o8[64 * j] = w; }
            ss = wave_sum(ss); if (lane == 0) SSQ[m] = (unsigned long long)(ss * 1048576.f); }
#pragma unroll 1
        for (int it = gw; it < 4 * MEML; it += NGW) { const int l = it / MEML, m = it % MEML;
            rms_row_bf16(AIN(1) + (size_t)m * D_, AIN(14) + l * D_, MEMN + ((size_t)l * MEML + m) * D_, lane); }
    }
    GRID_BAR();

#pragma unroll 1
    for (int l = 0; l < DEPTH_; ++l) {

        { WS_PTRS(); pg8::Gemm g{XN, Win_t + (size_t)l * NPROJ * D_, S_, NPART_A, D_, D_, D_}; pg8::StaticOrder SO; SO.init(S_, NPART_A, G, bx);
          pg8::EpiProj E{PROJ, NPROJ, SSQ + (size_t)(3 * l) * S_, GATES, PC_GATE, NPART_A};
          pg8::gemm_phase<pg8::EpiProj, pg8::StaticOrder, true>(lds, g, SO, E); }
        GRID_BAR();
        { PHASE_IDS(); float kmax = 0.f;
#pragma unroll 1
          for (int t = gw; t < S_; t += NGW) { const u32x4 r = *(const u32x4*)(PROJ + (size_t)t * NPROJ + PC_SBK + 8 * lane); float ss = dot8(r, r); ss = red16(ss); kmax = fmaxf(kmax, ss); }
          if ((lane & 15) == 0) atomicMax(ctl + CW_KMAX + l * 64 + (lane >> 4), __float_as_uint(kmax));
          const float* convw = AIN(4) + (size_t)l * 4 * 3072; const float* alog = AIN(5) + l * 8; const float* dtb = AIN(6) + l * 8;
          int cur_hd = -1;
          const unsigned char* zero16 = (const unsigned char*)(ctl + CW_ZERO16);
          float alog_c = 0.f, dtb_c = 0.f;
          if (bx < (S_ / 64) * 8) { const int u0 = bx, hd0 = u0 & 7, t00 = (u0 >> 3) * 64;
              __syncthreads();
              prep_stage_raw(lds, PROJ, zero16, t00, hd0, tid);
              asm volatile("s_waitcnt vmcnt(0)" ::: "memory"); }
#pragma unroll 1
          for (int u = bx; u < (S_ / 64) * 8; u += G) { const int hd = u & 7;
            if (hd != cur_hd) {
                __syncthreads();
                for (int i = tid; i < 4 * 384; i += NWAVES * 64) { const int tap = i / 384, c = i % 384; ((LAS float*)(lds + P_CW))[i] = convw[tap * 3072 + (c >> 7) * 1024 + hd * 128 + (c & 127)]; }
                alog_c = alog[hd]; dtb_c = dtb[hd];
                asm volatile("" : "+v"(alog_c), "+v"(dtb_c));
                cur_hd = hd; }
            delta_prep_unit(lds, PROJ, convw, alog_c, dtb_c, DPREP + ((size_t)hd * (S_ / 64) + (u >> 3)) * DU_BYTES, GL + u, OPB, (u >> 3) * 64, hd, tid, zero16, (u + G < (S_ / 64) * 8) ? ((u + G) >> 3) * 64 : -1); }
          __syncthreads(); }
        GRID_BAR();
        { PHASE_IDS();
        if (bx < 8) delta_scan_head(lds, DPREP, GL, ORAW, bx, tid);
        else {
            const int late = (bx >> 3) & 1;
            if (late) { CONVERT_WEIGHTS(-1, l, gw - 8 * NWAVES, NGW - 8 * NWAVES); __syncthreads(); }
            { pg8::Gemm g{XN, Win_t + (size_t)l * NPROJ * D_ + (size_t)PC_SWAQ * D_, S_, NPROJ - PC_SWAQ, D_, D_, D_}; pg8::StaticOrder SO; SO.init(S_, NPROJ - PC_SWAQ, G - 8, bx - 8);
              pg8::EpiBf16 E{PROJ + PC_SWAQ, NPROJ, SSQ + (size_t)(3 * l) * S_};
              pg8::gemm_phase<pg8::EpiBf16, pg8::StaticOrder, true>(lds, g, SO, E); }
            asm volatile("s_waitcnt vmcnt(0)" ::: "memory");
            __syncthreads();
            if (tid == 0) { __builtin_amdgcn_fence(__ATOMIC_RELEASE, "agent"); asm volatile("s_waitcnt vmcnt(0)" ::: "memory"); (void)xb_add(ctl + CW_B1CNT + l * 64, 1u); }
            { const int cB = (bx - 8 + 56) % (G - 8);
              pg8::Gemm g{XN, Win_t + (size_t)l * NPROJ * D_ + (size_t)NPART_A * D_, S_, PC_SWAQ - NPART_A, D_, D_, D_}; pg8::StaticOrder SO; SO.init(S_, PC_SWAQ - NPART_A, G - 8, cB);
              pg8::EpiProj E{PROJ + NPART_A, NPROJ, SSQ + (size_t)(3 * l) * S_, GATES + (NPART_A - PC_GATE), 0, PC_GATE + 6144 - NPART_A};
              pg8::gemm_phase<pg8::EpiProj, pg8::StaticOrder, true>(lds, g, SO, E); }
            if (tid == 0) { unsigned* bar0 = ctl + CW_BAR; XB_SPIN(xb_ld(ctl + CW_B1CNT + l * 64) < (unsigned)(G - 8), bar0); __builtin_amdgcn_fence(__ATOMIC_ACQUIRE, "agent"); asm volatile("s_waitcnt vmcnt(0)" ::: "memory"); }
            __syncthreads();
            {
              const int j = bx - 8, NSH = G - 8;
              const float* sinks = AIN(8) + l * 8;
              int u0, u1, u2;
              if (NSH == 248) {
                  const bool shortg = (j >= 184 && j < 192) || j >= 200;
                  if (shortg) { const int si = j < 192 ? j - 184 : 8 + (j - 200); u0 = 2 * si; u1 = 2 * si + 1; u2 = 256 + si; }
                  else { const int li = j < 184 ? j : j - 8;
                      if (li < 144) { u0 = 112 + li; u1 = 256 + 56 + li; u2 = -1; }
                      else { const int k2 = li - 144; u0 = 256 + 200 + k2; u1 = k2 < 8 ? 256 + 248 + k2 : -1; u2 = -1; } } }
              else { u0 = j; u1 = j + NSH; u2 = j + 2 * NSH; if (u1 >= 512) u1 = -1; if (u2 >= 512) u2 = -1; }
#pragma unroll 1
              for (int k = 0; k < 3; ++k) { const int u = (k == 0) ? u0 : (k == 1 ? u1 : u2);
                  if (u < 0) continue;
                  if (u < 256) sb_unit(lds, PROJ, __uint_as_float(ctl[CW_KMAX + l * 64 + (u & 3)]), Y, u & 3, u >> 2, tid);
                  else swa_unit(lds, PROJ, sinks, Y, (u - 256) & 1, (u - 256) >> 1, tid); }
            }
            __syncthreads();
            if (!late) { CONVERT_WEIGHTS(-1, l, gw - 8 * NWAVES, NGW - 8 * NWAVES); }
        } }
        GRID_BAR();
        { PHASE_IDS();
#pragma unroll 1
          for (int t = gw; t < S_; t += 2 * NGW) { dpost_token(ORAW, OPB, PROJ, AIN(7) + l * 128, Y, t, lane); dpost_token(ORAW, OPB, PROJ, AIN(7) + l * 128, Y, t + NGW, lane); } }
        GRID_BAR();
        { WS_PTRS(); pg8::StaticOrder SO; SO.init(S_, D_, G, bx);
          pg8::Gemm g{Y, Wbd_t + (size_t)l * 2048 * 2048, S_, D_, 2048, 2048, 2048}; pg8::EpiMerge E{GATES, 6144, MRGB, D_};
          pg8::gemm_phase<pg8::EpiMerge, pg8::StaticOrder, true>(lds, g, SO, E); }
        GRID_BAR();
        { WS_PTRS(); pg8::Gemm g{MRGB, Wo_t + (size_t)l * D_ * D_, S_, D_, D_, D_, D_}; pg8::StaticOrder SO; SO.init(S_, D_, G, bx);
          pg8::EpiRes E{XN, D_, SSQ + (size_t)(3 * l + 1) * S_};
          pg8::gemm_phase<pg8::EpiRes, pg8::StaticOrder, true>(lds, g, SO, E); }
        GRID_BAR();
        { WS_PTRS(); pg8::Gemm g{XN, Wxq_t + (size_t)l * 512 * D_, S_, 512, D_, D_, D_}; pg8::StaticOrder SO; SO.init(S_, 512, G, bx);
          pg8::EpiBf16 E{XQ, 512, SSQ + (size_t)(3 * l + 1) * S_};
          pg8::gemm_phase<pg8::EpiBf16, pg8::StaticOrder, true>(lds, g, SO, E); }
        { WS_PTRS(); pg8::Gemm g{MEMN + (size_t)l * MEML * D_, Wxkv_t + (size_t)l * 1024 * D_, MEML, 1024, D_, D_, D_}; pg8::StaticOrder SO; SO.init(MEML, 1024, G, (bx + G - 128) % G);
          pg8::EpiBf16 E{KV + (size_t)l * MEML * 1024, 1024, nullptr};
          pg8::gemm_phase<pg8::EpiBf16, pg8::StaticOrder, true>(lds, g, SO, E); }
        { PHASE_IDS(); if (bx >= 132 && l + 1 < DEPTH_) { CONVERT_WEIGHTS(l + 1, -1, gw - 132 * NWAVES, NGW - 132 * NWAVES); } }
        GRID_BAR();
        { PHASE_IDS();
#pragma unroll 1
          for (int u = bx; u < 256; u += G) xattn_unit(lds, XQ, KV + (size_t)l * MEML * 1024, XO, u & 3, u >> 2, tid);
          __syncthreads(); }
        GRID_BAR();
        { WS_PTRS(); pg8::Gemm g{XO, Wxo_t + (size_t)l * D_ * 512, S_, D_, 512, 512, 512}; pg8::StaticOrder SO; SO.init(S_, D_, G, bx);
          pg8::EpiRes E{XN, D_, SSQ + (size_t)(3 * l + 2) * S_};
          pg8::gemm_phase<pg8::EpiRes, pg8::StaticOrder, true>(lds, g, SO, E); }
        GRID_BAR();
        { WS_PTRS(); pg8::Gemm g{XN, Wup_t + (size_t)l * 8192 * D_, S_, 8192, D_, D_, D_}; pg8::StaticOrder SO; SO.init(S_, 8192, G, bx);
          pg8::EpiBf16 E{UP, 8192, SSQ + (size_t)(3 * l + 2) * S_};
          pg8::gemm_phase<pg8::EpiBf16, pg8::StaticOrder, true>(lds, g, SO, E); }
        GRID_BAR();
        { PHASE_IDS();
#pragma unroll 1
          for (int it = gw; it < (S_ / 32) * 8; it += NGW) convact_item(UP, AIN(20) + (size_t)l * 3 * 8192, ACT, it >> 3, it & 7, lane); }
        GRID_BAR();
        { WS_PTRS(); pg8::Gemm g{ACT, Wdn_t + (size_t)l * D_ * DFF, S_, D_, DFF, DFF, DFF}; pg8::StaticOrder SO; SO.init(S_, D_, G, bx);
          pg8::EpiRes E{XN, D_, SSQ + (size_t)(3 * l + 3) * S_};
          pg8::gemm_phase<pg8::EpiRes, pg8::StaticOrder, true>(lds, g, SO, E); }
        GRID_BAR();
    }
    { PHASE_IDS();
#pragma unroll 1
      for (int m = gw; m < S_; m += NGW) { const u32x2* hr = (const u32x2*)(XN + (size_t)m * D_) + lane; f32x4* orow = (f32x4*)(hbuf + (size_t)m * D_) + lane; const f32x4* gr = (const f32x4*)AIN(22) + lane;
          const float rstd = rsqrtf((float)SSQ[(size_t)(3 * DEPTH_) * S_ + m] * (1.f / (2048.f * 1048576.f)) + EPS_);
          u32x2 hv[8]; f32x4 gq[8];
#pragma unroll
          for (int j = 0; j < 8; ++j) { hv[j] = hr[64 * j]; gq[j] = gr[64 * j]; }
#pragma unroll
          for (int j = 0; j < 8; ++j) { const f32x4 v = {bf_lo(hv[j].x), bf_hi(hv[j].x), bf_lo(hv[j].y), bf_hi(hv[j].y)}; orow[64 * j] = v * rstd * gq[j]; } } }
}

extern "C" void kernel_launch(void* const* d_in, const int* in_sizes, int n_in, void* d_out, int out_size, void* d_ws, size_t ws_size, hipStream_t stream) {
    static int grid = 0;
    if (grid == 0) {
        if (n_in != 23 || out_size != S_ * D_ || ws_size < WS_END) { fprintf(stderr, "kernel_launch: unexpected shapes (n_in %d, out %d, ws %zu, need %zu)\n", n_in, out_size, ws_size, (size_t)WS_END); grid = -1; return; }
        int dev = 0, cus = 0, per_cu = 0;
        if (hipGetDevice(&dev) != hipSuccess || hipDeviceGetAttribute(&cus, hipDeviceAttributeMultiprocessorCount, dev) != hipSuccess) { grid = -1; return; }
        if (hipFuncSetAttribute((const void*)fwd_kernel, hipFuncAttributeMaxDynamicSharedMemorySize, LDS_BYTES) != hipSuccess) { fprintf(stderr, "kernel_launch: hipFuncSetAttribute failed\n"); grid = -1; return; }
        if (hipOccupancyMaxActiveBlocksPerMultiprocessor(&per_cu, (const void*)fwd_kernel, NWAVES * 64, LDS_BYTES) != hipSuccess || per_cu < 1)
            fprintf(stderr, "kernel_launch: occupancy query reports %d workgroups per CU\n", per_cu);
        (void)hipGetLastError();
        grid = cus;
    }
    if (grid < 0) return;
    if (hipMemsetAsync((char*)d_ws + WS_CTL, 0, CTL_ZERO_BYTES, stream) != hipSuccess || hipMemsetAsync((char*)d_ws + WS_SSQ, 0, SSQ_BYTES, stream) != hipSuccess) { fprintf(stderr, "kernel_launch: memset failed\n"); return; }
    Args a{};
    for (int i = 0; i < 23; ++i) a.in[i] = (const float*)d_in[i];
    a.out = (float*)d_out; a.ws = (unsigned char*)d_ws;
    hipLaunchKernelGGL(fwd_kernel, dim3(grid), dim3(NWAVES * 64), LDS_BYTES, stream, a);
    const hipError_t le = hipPeekAtLastError();
    if (le != hipSuccess) fprintf(stderr, "kernel_launch: launch failed: %s\n", hipGetErrorName(le));
}
```

```cpp
#include <hip/hip_runtime.h>
#include <cstdio>
#include <cstdint>

#define GAS __attribute__((address_space(1)))
#define LAS __attribute__((address_space(3)))
typedef unsigned short bf16;
typedef unsigned u32x4 __attribute__((ext_vector_type(4)));
typedef unsigned u32x2 __attribute__((ext_vector_type(2)));
typedef float f32x4 __attribute__((ext_vector_type(4)));
typedef float f32x2 __attribute__((ext_vector_type(2)));
typedef short bf16x8 __attribute__((ext_vector_type(8)));

constexpr int S_ = 16384, D_ = 2048, DEPTH_ = 4, MEML = 256, DFF = 4096;
constexpr int NPROJ = 12800;
constexpr int PC_DNQ = 0, PC_DNK = 1024, PC_DNV = 2048, PC_A = 3072, PC_B = 3080, PC_SBK = 3328, PC_GATE = 3840, PC_Z = 9984,
              PC_SWAQ = 11008, PC_SWAK = 11520, PC_SWAV = 11648, PC_SBQ = 11776, PC_SBV = 12288;
constexpr int NPART_A = 4096, NPART_B = NPROJ - NPART_A;
constexpr int IN_COLS_SRC = 12560;
constexpr float EPS_ = 1e-6f;

constexpr size_t MiB = 1u << 20;
constexpr size_t WS_CTL = 0, CTL_ZERO_BYTES = 1 * MiB;
constexpr size_t WS_WIN = 2 * MiB;
constexpr size_t WS_WUP = 202 * MiB;
constexpr size_t WS_WDN = 330 * MiB;
constexpr size_t WS_WO = 394 * MiB;
constexpr size_t WS_WBD = 426 * MiB;
constexpr size_t WS_WBS = 442 * MiB;
constexpr size_t WS_WBB = 450 * MiB;
constexpr size_t WS_WXQ = 458 * MiB;
constexpr size_t WS_WXKV = 466 * MiB;
constexpr size_t WS_WXO = 482 * MiB;
constexpr size_t WS_XN = 490 * MiB;
constexpr size_t WS_PROJ = 554 * MiB;
constexpr size_t WS_UP = 554 * MiB;
constexpr size_t WS_ACT = 810 * MiB;
constexpr size_t WS_DPREP = 954 * MiB;
constexpr size_t WS_ORAW = 1146 * MiB;
constexpr size_t WS_Y = 1210 * MiB;
constexpr size_t WS_MRG = 1274 * MiB;
constexpr size_t WS_MRGB = 1402 * MiB;
constexpr size_t WS_XQ = 1466 * MiB;
constexpr size_t WS_XO = 1482 * MiB;
constexpr size_t WS_KV = 1498 * MiB;
constexpr size_t WS_MEMN = 1500 * MiB;
constexpr size_t WS_GL = 1504 * MiB;
constexpr size_t WS_SSQ = 1506 * MiB, SSQ_BYTES = 2 * MiB;
constexpr size_t WS_OPB = 1508 * MiB;
constexpr size_t WS_END = 1540 * MiB;
constexpr int CW_BAR = 4096;
constexpr int CW_BAR2 = 8192;
constexpr int CW_B1CNT = 12288;
constexpr int CW_ZERO16 = 200000;
constexpr int CW_KMAX = 16384;

constexpr int RING_BYTES = 131072;
constexpr int LDSCTL_OFF = 162816, MISC_OFF = LDSCTL_OFF + 320;
constexpr int LDS_BYTES = 163840;
constexpr int NWAVES = 8;

#define LDS_WAIT() asm volatile("s_waitcnt lgkmcnt(0)" ::: "memory")
#define VM_WAIT() asm volatile("s_waitcnt vmcnt(0)" ::: "memory")
__device__ __forceinline__ unsigned cvt_pk_bf16(float lo, float hi) { unsigned r; asm volatile("v_cvt_pk_bf16_f32 %0, %1, %2" : "=v"(r) : "v"(lo), "v"(hi)); return r; }
__device__ __forceinline__ float bf_lo(unsigned w) { return __uint_as_float(w << 16); }
__device__ __forceinline__ float bf_hi(unsigned w) { return __uint_as_float(w & 0xffff0000u); }
__device__ __forceinline__ float bf2f(bf16 b) { return __uint_as_float(((unsigned)b) << 16); }
__device__ __forceinline__ float wave_sum(float v) {
#pragma unroll
    for (int o = 1; o < 64; o <<= 1) v += __shfl_xor(v, o);
    return v;
}
__device__ __forceinline__ float wave_max(float v) {
#pragma unroll
    for (int o = 1; o < 64; o <<= 1) v = fmaxf(v, __shfl_xor(v, o));
    return v;
}
__device__ __forceinline__ float sigmoidf_(float x) { return 1.0f / (1.0f + __expf(-x)); }
__device__ __forceinline__ float siluf_(float x) { return x / (1.0f + __expf(-x)); }
__device__ __forceinline__ float softplusf_(float x) { return fmaxf(x, 0.f) + log1pf(__expf(-fabsf(x))); }
__device__ __forceinline__ float dot8(u32x4 a, u32x4 b) {
    float s = bf_lo(a.x) * bf_lo(b.x);
    s += bf_hi(a.x) * bf_hi(b.x);
    s += bf_lo(a.y) * bf_lo(b.y); s += bf_hi(a.y) * bf_hi(b.y);
    s += bf_lo(a.z) * bf_lo(b.z); s += bf_hi(a.z) * bf_hi(b.z);
    s += bf_lo(a.w) * bf_lo(b.w); s += bf_hi(a.w) * bf_hi(b.w);
    return s;
}

__device__ __forceinline__ int launder_v(int x) { asm volatile("" : "+v"(x)); return x; }
__device__ __forceinline__ int launder_s(int x) { asm volatile("" : "+s"(x)); return x; }
namespace pg8 {
#define PG8_LAS __attribute__((address_space(3)))
typedef unsigned short bf16_t;
constexpr int BM = 256, BK = 64, HALF = 128, HTB = HALF * BK * 2, STAGE_BYTES = 8 * HTB, NXCD = 8, WGM = 8;
__host__ __device__ __forceinline__ int lds_byte(int r, int c) { const int st = (r >> 4) * 2 + (c >> 5), rr = r & 15, cc = c & 31, ob = rr * 64 + cc * 2; return st * 1024 + (ob ^ (((ob >> 9) & 1) << 5)); }
__host__ __device__ __forceinline__ void stage_rc(int b, int& R, int& C) { const int st = b / 1024, sb = b % 1024, swz = sb ^ (((sb >> 9) & 1) << 5); R = (st >> 1) * 16 + swz / 64; C = (st & 1) * 32 + (swz % 64) / 2; }
__host__ __device__ __forceinline__ int perm32(int rho) { const int n = rho >> 4, i = rho & 15; return 8 * (i >> 2) + 4 * n + (i & 3); }
struct Unit { int pm, pn; };
struct Gemm { const bf16_t* A; const bf16_t* Bt; int M, N, K, lda, ldb; };
struct StaticOrder {
    int nM, nN, nwg, G, c;
    __host__ __device__ void init(int M, int N, int G_, int c_) { nM = M / BM; nN = N / BM; nwg = nM * nN; G = G_; c = c_; }
    __host__ __device__ bool next(int i, Unit& u) const {
        const long L = (long)i * G + c; if (L >= nwg) return false;
        int wgid = (int)L; { const int q = nwg / NXCD, r = nwg % NXCD, xcd = wgid % NXCD, off = wgid / NXCD; wgid = (xcd < r ? xcd * (q + 1) : r * (q + 1) + (xcd - r) * q) + off; }
        const int nig = WGM * nN, gid = wgid / nig, fm = gid * WGM, gsz = (nM - fm) < WGM ? (nM - fm) : WGM;
        u.pm = fm + ((wgid % nig) % gsz); u.pn = (wgid % nig) / gsz; return true;
    }
    __device__ __forceinline__ void a_ready(const Unit&) const {}
    __device__ __forceinline__ void done(const Unit&) const {}
};
struct EpiBf16 {
    static constexpr bool PERM = true, AFTER_DRAIN = false, HAS_MID = false;
    bf16_t* O; int ldc; const unsigned long long* ssq;
    __device__ __forceinline__ void operator()(const f32x4 (&acc)[2][2][4][2], const Unit& u, int wr, int wc, int fr, int fq) const {
        const int row0 = u.pm * BM + wr * 64 + fr, col0 = u.pn * BM + wc * 64 + 8 * fq;
        float rs[2][4];
        if (ssq) { unsigned long long q[2][4];
#pragma unroll
            for (int ai = 0; ai < 2; ++ai)
#pragma unroll
                for (int m = 0; m < 4; ++m) q[ai][m] = ssq[row0 + ai * HALF + m * 16];
#pragma unroll
            for (int ai = 0; ai < 2; ++ai)
#pragma unroll
                for (int m = 0; m < 4; ++m) rs[ai][m] = rsqrtf((float)q[ai][m] * (1.f / (2048.f * 1048576.f)) + 1e-6f);
        } else {
#pragma unroll
            for (int ai = 0; ai < 2; ++ai)
#pragma unroll
                for (int m = 0; m < 4; ++m) rs[ai][m] = 1.f; }
#pragma unroll
        for (int ai = 0; ai < 2; ++ai)
#pragma unroll
            for (int m = 0; m < 4; ++m) { const int row = row0 + ai * HALF + m * 16; bf16_t* rowp = O + (size_t)row * ldc + col0;
#pragma unroll
                for (int bj = 0; bj < 2; ++bj) { const f32x4 v0 = acc[ai][bj][m][0] * rs[ai][m], v1 = acc[ai][bj][m][1] * rs[ai][m];
                    u32x4 w; w.x = cvt_pk_bf16(v0[0], v0[1]); w.y = cvt_pk_bf16(v0[2], v0[3]); w.z = cvt_pk_bf16(v1[0], v1[1]); w.w = cvt_pk_bf16(v1[2], v1[3]);
                    *(u32x4*)(rowp + bj * 32) = w; } }
    }
};
struct EpiProj {
    static constexpr bool PERM = true, AFTER_DRAIN = false, HAS_MID = false;
    bf16_t* O; int ldc; const unsigned long long* ssq; unsigned char* gq; int glo, ghi;
    __device__ __forceinline__ void operator()(const f32x4 (&acc)[2][2][4][2], const Unit& u, int wr, int wc, int fr, int fq) const {
        const int row0 = u.pm * BM + wr * 64 + fr, col0 = u.pn * BM + wc * 64 + 8 * fq;
        float rs[2][4];
        { unsigned long long q[2][4];
#pragma unroll
            for (int ai = 0; ai < 2; ++ai)
#pragma unroll
                for (int m = 0; m < 4; ++m) q[ai][m] = ssq[row0 + ai * HALF + m * 16];
#pragma unroll
            for (int ai = 0; ai < 2; ++ai)
#pragma unroll
                for (int m = 0; m < 4; ++m) rs[ai][m] = rsqrtf((float)q[ai][m] * (1.f / (2048.f * 1048576.f)) + 1e-6f); }
        const bool isg = (u.pn * BM >= glo) && (u.pn * BM < ghi);
        if (!isg) {
#pragma unroll
            for (int ai = 0; ai < 2; ++ai)
#pragma unroll
                for (int m = 0; m < 4; ++m) { const int row = row0 + ai * HALF + m * 16; bf16_t* rowp = O + (size_t)row * ldc + col0;
#pragma unroll
                    for (int bj = 0; bj < 2; ++bj) { const f32x4 v0 = acc[ai][bj][m][0] * rs[ai][m], v1 = acc[ai][bj][m][1] * rs[ai][m];
                        u32x4 w; w.x = cvt_pk_bf16(v0[0], v0[1]); w.y = cvt_pk_bf16(v0[2], v0[3]); w.z = cvt_pk_bf16(v1[0], v1[1]); w.w = cvt_pk_bf16(v1[2], v1[3]);
                        *(u32x4*)(rowp + bj * 32) = w; } }
        } else {
#define SGQ(x) (max((unsigned)(__builtin_amdgcn_rcpf(1.f + __expf(-(x))) * 255.f + 0.5f), 1u))
#pragma unroll
            for (int ai = 0; ai < 2; ++ai)
#pragma unroll
                for (int m = 0; m < 4; ++m) { const int row = row0 + ai * HALF + m * 16; unsigned char* rowp = gq + (size_t)row * 6144 + (col0 - glo);
#pragma unroll
                    for (int bj = 0; bj < 2; ++bj) { const f32x4 v0 = acc[ai][bj][m][0] * rs[ai][m], v1 = acc[ai][bj][m][1] * rs[ai][m];
                        u32x2 w; w.x = SGQ(v0[0]) | (SGQ(v0[1]) << 8) | (SGQ(v0[2]) << 16) | (SGQ(v0[3]) << 24); w.y = SGQ(v1[0]) | (SGQ(v1[1]) << 8) | (SGQ(v1[2]) << 16) | (SGQ(v1[3]) << 24);
                        *(u32x2*)(rowp + bj * 32) = w; } }
#undef SGQ
        }
    }
};
struct EpiRes {
    static constexpr bool PERM = true, AFTER_DRAIN = false, HAS_MID = false;
    bf16_t* hb; int ldc; unsigned long long* ssq;
    __device__ __forceinline__ void operator()(const f32x4 (&acc)[2][2][4][2], const Unit& u, int wr, int wc, int fr, int fq) const {
        const int row0 = u.pm * BM + wr * 64 + fr, col0 = u.pn * BM + wc * 64 + 8 * fq;
        u32x4 bs[2][4][2];
#pragma unroll
        for (int ai = 0; ai < 2; ++ai)
#pragma unroll
            for (int m = 0; m < 4; ++m)
#pragma unroll
                for (int bj = 0; bj < 2; ++bj) bs[ai][m][bj] = *(const u32x4*)(hb + (size_t)(row0 + ai * HALF + m * 16) * ldc + col0 + bj * 32);
#pragma unroll
        for (int ai = 0; ai < 2; ++ai)
#pragma unroll
            for (int m = 0; m < 4; ++m) { const int row = row0 + ai * HALF + m * 16; const size_t off = (size_t)row * ldc + col0; float ss = 0.f;
#pragma unroll
                for (int bj = 0; bj < 2; ++bj) { const u32x4 b = bs[ai][m][bj]; const f32x4 a0 = acc[ai][bj][m][0], a1 = acc[ai][bj][m][1];
                    const float v0 = bf_lo(b.x) + a0[0], v1 = bf_hi(b.x) + a0[1], v2 = bf_lo(b.y) + a0[2], v3 = bf_hi(b.y) + a0[3];
                    const float v4 = bf_lo(b.z) + a1[0], v5 = bf_hi(b.z) + a1[1], v6 = bf_lo(b.w) + a1[2], v7 = bf_hi(b.w) + a1[3];
                    ss += (v0 * v0 + v1 * v1) + (v2 * v2 + v3 * v3) + (v4 * v4 + v5 * v5) + (v6 * v6 + v7 * v7);
                    u32x4 w; w.x = cvt_pk_bf16(v0, v1); w.y = cvt_pk_bf16(v2, v3); w.z = cvt_pk_bf16(v4, v5); w.w = cvt_pk_bf16(v6, v7);
                    *(u32x4*)(hb + off + bj * 32) = w; }
                ss += __shfl_xor(ss, 16); ss += __shfl_xor(ss, 32);
                if (fq == 0) atomicAdd(ssq + row, (unsigned long long)(ss * 1048576.f)); }
    }
};
template <int MODE> struct EpiGate {
    static constexpr bool PERM = true, AFTER_DRAIN = false, HAS_MID = false;
    const unsigned char* gate; int ldg; bf16_t* mrgb; int ldc;
    __device__ __forceinline__ void operator()(const f32x4 (&acc)[2][2][4][2], const Unit& u, int wr, int wc, int fr, int fq) const {
        const int row0 = u.pm * BM + wr * 64 + fr, col0 = u.pn * BM + wc * 64 + 8 * fq;
#pragma unroll
        for (int ai = 0; ai < 2; ++ai) {
            u32x2 gw[4][2]; u32x4 pv[4][2];
#pragma unroll
            for (int m = 0; m < 4; ++m)
#pragma unroll
                for (int bj = 0; bj < 2; ++bj) { const int row = row0 + ai * HALF + m * 16;
                    gw[m][bj] = *(const u32x2*)(gate + (size_t)row * ldg + col0 + bj * 32);
                    if (MODE != 0) pv[m][bj] = *(const u32x4*)(mrgb + (size_t)row * ldc + col0 + bj * 32); }
#pragma unroll
            for (int m = 0; m < 4; ++m)
#pragma unroll
                for (int bj = 0; bj < 2; ++bj) { const size_t off = (size_t)(row0 + ai * HALF + m * 16) * ldc + col0 + bj * 32;
                    const u32x2 g2 = gw[m][bj]; const f32x4 a0 = acc[ai][bj][m][0], a1 = acc[ai][bj][m][1];
                    const float k255 = 1.f / 255.f;
                    float v[8];
                    v[0] = (float)(g2.x & 255u) * k255 * a0[0]; v[1] = (float)((g2.x >> 8) & 255u) * k255 * a0[1]; v[2] = (float)((g2.x >> 16) & 255u) * k255 * a0[2]; v[3] = (float)(g2.x >> 24) * k255 * a0[3];
                    v[4] = (float)(g2.y & 255u) * k255 * a1[0]; v[5] = (float)((g2.y >> 8) & 255u) * k255 * a1[1]; v[6] = (float)((g2.y >> 16) & 255u) * k255 * a1[2]; v[7] = (float)(g2.y >> 24) * k255 * a1[3];
                    if (MODE != 0) { const u32x4 p = pv[m][bj]; v[0] += bf_lo(p.x); v[1] += bf_hi(p.x); v[2] += bf_lo(p.y); v[3] += bf_hi(p.y); v[4] += bf_lo(p.z); v[5] += bf_hi(p.z); v[6] += bf_lo(p.w); v[7] += bf_hi(p.w); }
                    u32x4 w; w.x = cvt_pk_bf16(v[0], v[1]); w.y = cvt_pk_bf16(v[2], v[3]); w.z = cvt_pk_bf16(v[4], v[5]); w.w = cvt_pk_bf16(v[6], v[7]);
                    *(u32x4*)(mrgb + off) = w; }
        }
    }
};

struct EpiMerge {
    static constexpr bool PERM = true, AFTER_DRAIN = false, HAS_MID = true;
    const unsigned char* gate; int ldg; bf16_t* mrgb; int ldc;
    __device__ __forceinline__ bool is_mid(int ktiles_done) const { return ktiles_done == 16 || ktiles_done == 24; }
    __device__ __forceinline__ void mid(f32x4 (&acc)[2][2][4][2], const Unit& u, int wr, int wc, int fr, int fq, int ktiles_done) const {
        const int row0 = launder_v(u.pm * BM + wr * 64 + fr), col0 = launder_v(u.pn * BM + wc * 64 + 8 * fq);
        const unsigned char* gnum = gate + (ktiles_done == 16 ? 0 : 2048); const unsigned char* gden = gnum + 2048;
#pragma unroll
        for (int ai = 0; ai < 2; ++ai)
#pragma unroll
          for (int mh = 0; mh < 2; ++mh) {
            u32x2 gn[2][2], gd[2][2];
#pragma unroll
            for (int m2 = 0; m2 < 2; ++m2)
#pragma unroll
                for (int bj = 0; bj < 2; ++bj) { const size_t off = (size_t)(row0 + ai * HALF + (2 * mh + m2) * 16) * ldg + col0 + bj * 32; gn[m2][bj] = *(const u32x2*)(gnum + off); gd[m2][bj] = *(const u32x2*)(gden + off); }
#pragma unroll
            for (int m2 = 0; m2 < 2; ++m2)
#pragma unroll
                for (int bj = 0; bj < 2; ++bj) { const u32x2 a = gn[m2][bj], b = gd[m2][bj]; const int m = 2 * mh + m2;
#define MRG_R(w_, sh_) ((float)(((a.w_) >> (sh_)) & 255u) * __builtin_amdgcn_rcpf((float)(((b.w_) >> (sh_)) & 255u)))
                    acc[ai][bj][m][0][0] *= MRG_R(x, 0); acc[ai][bj][m][0][1] *= MRG_R(x, 8); acc[ai][bj][m][0][2] *= MRG_R(x, 16); acc[ai][bj][m][0][3] *= MRG_R(x, 24);
                    acc[ai][bj][m][1][0] *= MRG_R(y, 0); acc[ai][bj][m][1][1] *= MRG_R(y, 8); acc[ai][bj][m][1][2] *= MRG_R(y, 16); acc[ai][bj][m][1][3] *= MRG_R(y, 24);
#undef MRG_R
                }
          }
    }
    __device__ __forceinline__ void operator()(const f32x4 (&acc)[2][2][4][2], const Unit& u, int wr, int wc, int fr, int fq) const {
        const int row0 = launder_v(u.pm * BM + wr * 64 + fr), col0 = launder_v(u.pn * BM + wc * 64 + 8 * fq);
        const unsigned char* g3 = gate + 4096;
#pragma unroll
        for (int ai = 0; ai < 2; ++ai) {
            u32x2 gw[4][2];
#pragma unroll
            for (int m = 0; m < 4; ++m)
#pragma unroll
                for (int bj = 0; bj < 2; ++bj) gw[m][bj] = *(const u32x2*)(g3 + (size_t)(row0 + ai * HALF + m * 16) * ldg + col0 + bj * 32);
#pragma unroll
            for (int m = 0; m < 4; ++m)
#pragma unroll
                for (int bj = 0; bj < 2; ++bj) { const size_t off = (size_t)(row0 + ai * HALF + m * 16) * ldc + col0 + bj * 32;
                    const u32x2 g2 = gw[m][bj]; const f32x4 a0 = acc[ai][bj][m][0], a1 = acc[ai][bj][m][1];
                    const float k255 = 1.f / 255.f;
                    float v[8];
                    v[0] = (float)(g2.x & 255u) * k255 * a0[0]; v[1] = (float)((g2.x >> 8) & 255u) * k255 * a0[1]; v[2] = (float)((g2.x >> 16) & 255u) * k255 * a0[2]; v[3] = (float)(g2.x >> 24) * k255 * a0[3];
                    v[4] = (float)(g2.y & 255u) * k255 * a1[0]; v[5] = (float)((g2.y >> 8) & 255u) * k255 * a1[1]; v[6] = (float)((g2.y >> 16) & 255u) * k255 * a1[2]; v[7] = (float)(g2.y >> 24) * k255 * a1[3];
                    u32x4 w; w.x = cvt_pk_bf16(v[0], v[1]); w.y = cvt_pk_bf16(v[2], v[3]); w.z = cvt_pk_bf16(v[4], v[5]); w.w = cvt_pk_bf16(v[6], v[7]);
                    *(u32x4*)(mrgb + off) = w; }
        }
    }
};

struct EpiConv {
    static constexpr bool PERM = true, AFTER_DRAIN = false, HAS_MID = false;
    bf16_t* act; const unsigned long long* ssq; const float* cw  ; bf16_t* halo  ;
    __device__ __forceinline__ void operator()(const f32x4 (&acc)[2][2][4][2], const Unit& u, int wr, int wc, int fr, int fq) const {
        const int row0 = launder_v(u.pm * BM + wr * 64 + fr), chb = launder_v(u.pn * 128 + wc * 32 + 8 * fq);
        float rs[2][4];
        { unsigned long long q[2][4];
#pragma unroll
            for (int ai = 0; ai < 2; ++ai)
#pragma unroll
                for (int m = 0; m < 4; ++m) q[ai][m] = ssq[row0 + ai * HALF + m * 16];
#pragma unroll
            for (int ai = 0; ai < 2; ++ai)
#pragma unroll
                for (int m = 0; m < 4; ++m) rs[ai][m] = rsqrtf((float)q[ai][m] * (1.f / (2048.f * 1048576.f)) + 1e-6f); }
        unsigned PK[2][4][2][4];
#pragma unroll
        for (int ai = 0; ai < 2; ++ai)
#pragma unroll
            for (int m = 0; m < 4; ++m)
#pragma unroll
                for (int bj = 0; bj < 2; ++bj) { const f32x4 v0 = acc[ai][bj][m][0] * rs[ai][m], v1 = acc[ai][bj][m][1] * rs[ai][m];
                    PK[ai][m][bj][0] = cvt_pk_bf16(v0[0], v0[1]); PK[ai][m][bj][1] = cvt_pk_bf16(v0[2], v0[3]); PK[ai][m][bj][2] = cvt_pk_bf16(v1[0], v1[1]); PK[ai][m][bj][3] = cvt_pk_bf16(v1[2], v1[3]); }
#pragma unroll
        for (int ai = 0; ai < 2; ++ai)
#pragma unroll
            for (int m = 0; m < 4; ++m)
#pragma unroll
                for (int bj = 0; bj < 2; ++bj)
#pragma unroll
                    for (int k = 0; k < 4; ++k) asm volatile("" : "+v"(PK[ai][m][bj][k]));
        float wg[3][8], wv[3][8];
#pragma unroll
        for (int i = 0; i < 3; ++i) { const f32x4 a = *(const f32x4*)(cw + i * 8192 + chb), b = *(const f32x4*)(cw + i * 8192 + chb + 4), c = *(const f32x4*)(cw + i * 8192 + 4096 + chb), d = *(const f32x4*)(cw + i * 8192 + 4096 + chb + 4);
            wg[i][0] = a[0]; wg[i][1] = a[1]; wg[i][2] = a[2]; wg[i][3] = a[3]; wg[i][4] = b[0]; wg[i][5] = b[1]; wg[i][6] = b[2]; wg[i][7] = b[3];
            wv[i][0] = c[0]; wv[i][1] = c[1]; wv[i][2] = c[2]; wv[i][3] = c[3]; wv[i][4] = d[0]; wv[i][5] = d[1]; wv[i][6] = d[2]; wv[i][7] = d[3]; }
#pragma unroll
        for (int ai = 0; ai < 2; ++ai) {
            const int grp = u.pm * 4 + ai * 2 + wr;
            unsigned r1p[2][4], r2p[2][4];
#pragma unroll
            for (int bj = 0; bj < 2; ++bj)
#pragma unroll
                for (int k = 0; k < 4; ++k) { r1p[bj][k] = 0u; r2p[bj][k] = 0u; }
#pragma unroll
            for (int m = 0; m < 4; ++m) {
                unsigned P[2][4], x1[2][4], x2[2][4];
#pragma unroll
                for (int bj = 0; bj < 2; ++bj)
#pragma unroll
                    for (int k = 0; k < 4; ++k) P[bj][k] = PK[ai][m][bj][k];
#pragma unroll
                for (int bj = 0; bj < 2; ++bj)
#pragma unroll
                    for (int k = 0; k < 4; ++k) {
                        const unsigned r1 = (unsigned)__builtin_amdgcn_update_dpp(0, (int)P[bj][k], 0x121, 0xf, 0xf, false);
                        const unsigned r2 = (unsigned)__builtin_amdgcn_update_dpp(0, (int)P[bj][k], 0x122, 0xf, 0xf, false);
                        x1[bj][k] = (fr >= 1) ? r1 : r1p[bj][k]; x2[bj][k] = (fr >= 2) ? r2 : r2p[bj][k];
                        r1p[bj][k] = r1; r2p[bj][k] = r2; }
                const int row = row0 + ai * HALF + m * 16;
                const bool first2 = (m == 0) && (fr < 2);
                if (first2 || ((m == 3) && (fr >= 14))) {
                    const int slot = first2 ? 2 + fr : fr - 14;
                    bf16_t* hp = halo + ((size_t)(grp * 4 + slot) * 2) * 4096 + chb;
                    u32x4 w0 = {P[0][0], P[0][1], P[0][2], P[0][3]}, w1 = {P[1][0], P[1][1], P[1][2], P[1][3]};
                    *(u32x4*)hp = w0; *(u32x4*)(hp + 4096) = w1; }
                if (!first2) {
                    unsigned o[4];
#pragma unroll
                    for (int k = 0; k < 4; ++k) {
                        const float g0 = wg[0][2 * k] * bf_lo(x2[0][k]) + wg[1][2 * k] * bf_lo(x1[0][k]) + wg[2][2 * k] * bf_lo(P[0][k]);
                        const float g1 = wg[0][2 * k + 1] * bf_hi(x2[0][k]) + wg[1][2 * k + 1] * bf_hi(x1[0][k]) + wg[2][2 * k + 1] * bf_hi(P[0][k]);
                        const float v0 = wv[0][2 * k] * bf_lo(x2[1][k]) + wv[1][2 * k] * bf_lo(x1[1][k]) + wv[2][2 * k] * bf_lo(P[1][k]);
                        const float v1 = wv[0][2 * k + 1] * bf_hi(x2[1][k]) + wv[1][2 * k + 1] * bf_hi(x1[1][k]) + wv[2][2 * k + 1] * bf_hi(P[1][k]);
                        o[k] = cvt_pk_bf16(g0 * __builtin_amdgcn_rcpf(1.f + __expf(-g0)) * v0, g1 * __builtin_amdgcn_rcpf(1.f + __expf(-g1)) * v1); }
                    u32x4 w = {o[0], o[1], o[2], o[3]};
                    *(u32x4*)(act + (size_t)row * 4096 + chb) = w; }
            }
        }
    }
};

template <class Epi, class Sched, bool ALIGN_EPI = true>
__device__ __forceinline__ void gemm_phase(PG8_LAS unsigned char* lds, const Gemm g, const Sched& S, const Epi& E) {
    const int tid = launder_v(threadIdx.x), wid = __builtin_amdgcn_readfirstlane(tid >> 6), lane = tid & 63, wr = wid >> 2, wc = wid & 3, fr = lane & 15, fq = lane >> 4;
    const int K = g.K, nt = K / BK;
    unsigned voffA[2], voffB[2];
#pragma unroll
    for (int i = 0; i < 2; ++i) { int R, C; stage_rc(tid * 16 + i * 8192, R, C); const int Rb = 64 * (R >> 5) + perm32(R & 31);
        voffA[i] = (unsigned)(R * g.lda + C) * 2u; voffB[i] = (unsigned)(Rb * g.ldb + C) * 2u; }
    const size_t kstep = (size_t)(BK * 2);
    const size_t hstepA = (size_t)HALF * g.lda * 2, hstepB = (size_t)32 * g.ldb * 2;
    const size_t tstepA = 2 * hstepA, tstepB = (size_t)BM * g.ldb * 2;
    const unsigned ldsw = (unsigned)wid * 1024u;
    const int aoff = lds_byte(wr * 64 + fr, fq * 8), boff = lds_byte(wc * 32 + fr, fq * 8);
#define PG8_SA(b, h) (((b) * 2 + (h)) * HTB)
#define PG8_SB(b, h) ((4 + (b) * 2 + (h)) * HTB)
#define PG8_STAGE(bufoff, gbase, voff) do { _Pragma("unroll") for (int _i = 0; _i < 2; ++_i) \
        __builtin_amdgcn_global_load_lds((const unsigned*)((const char*)(gbase) + (voff)[_i]), (PG8_LAS unsigned*)(lds + (bufoff) + ldsw + _i * 8192), 16, 0, 0); } while (0)
#define PG8_LDA(dst, b, h) do { _Pragma("unroll") for (int m = 0; m < 4; ++m) _Pragma("unroll") for (int k = 0; k < 2; ++k) dst[m][k] = *(const PG8_LAS bf16x8*)(lds + PG8_SA(b, h) + aoff + m * 2048 + k * 1024); } while (0)
#define PG8_LDB(dst, b, h) do { _Pragma("unroll") for (int n = 0; n < 2; ++n) _Pragma("unroll") for (int k = 0; k < 2; ++k) dst[n][k] = *(const PG8_LAS bf16x8*)(lds + PG8_SB(b, h) + boff + n * 2048 + k * 1024); } while (0)
#define PG8_MMA(ai, bj, At, Bt) do { __builtin_amdgcn_s_setprio(1); _Pragma("unroll") for (int m = 0; m < 4; ++m) _Pragma("unroll") for (int n = 0; n < 2; ++n) _Pragma("unroll") for (int k = 0; k < 2; ++k) \
        acc[ai][bj][m][n] = __builtin_amdgcn_mfma_f32_16x16x32_bf16(Bt[n][k], At[m][k], acc[ai][bj][m][n], 0, 0, 0); __builtin_amdgcn_s_setprio(0); } while (0)
#define PG8_WAIT_V(n) asm volatile("s_waitcnt vmcnt(" #n ")" ::: "memory")
#define PG8_WAIT_L(n) asm volatile("s_waitcnt lgkmcnt(" #n ")" ::: "memory")
#define PG8_BAR __builtin_amdgcn_s_barrier()
#define PG8_SCHED __builtin_amdgcn_sched_barrier(0)
    Unit cur, nxt; int ui = 0;
    if (!S.next(0, cur)) return;
    f32x4 acc[2][2][4][2];
#pragma unroll
    for (int a = 0; a < 2; ++a)
#pragma unroll
        for (int b = 0; b < 2; ++b)
#pragma unroll
            for (int m = 0; m < 4; ++m)
#pragma unroll
                for (int n = 0; n < 2; ++n) acc[a][b][m][n] = (f32x4){0.f, 0.f, 0.f, 0.f};
    bf16x8 At[4][2], B0[2][2], B1[2][2];
    const char* cA = (const char*)g.A + (size_t)cur.pm * tstepA; const char* cB = (const char*)g.Bt + (size_t)cur.pn * tstepB;
    S.a_ready(cur);
    PG8_STAGE(PG8_SB(0, 0), cB, voffB); PG8_STAGE(PG8_SB(0, 1), cB + hstepB, voffB); PG8_STAGE(PG8_SA(0, 0), cA, voffA); PG8_STAGE(PG8_SA(0, 1), cA + hstepA, voffA);
    if (wr == 1) PG8_BAR;
    PG8_WAIT_V(2); PG8_BAR;
    PG8_STAGE(PG8_SB(1, 0), cB + kstep, voffB); PG8_STAGE(PG8_SA(1, 0), cA + kstep, voffA); PG8_STAGE(PG8_SB(1, 1), cB + hstepB + kstep, voffB);
    PG8_WAIT_V(6); PG8_BAR;
    for (;;) {
        const bool has_next = S.next(ui + 1, nxt);
        const char* nA = has_next ? (const char*)g.A + (size_t)nxt.pm * tstepA : cA; const char* nB = has_next ? (const char*)g.Bt + (size_t)nxt.pn * tstepB : cB;
        for (int t = 0; t < nt; t += 2) {
            const bool last = (t == nt - 2);
            const char* a1 = cA + (size_t)(t + 1) * kstep;
            const char* a2 = last ? nA : cA + (size_t)(t + 2) * kstep; const char* b2 = last ? nB : cB + (size_t)(t + 2) * kstep;
            const char* a3 = a2 + kstep; const char* b3 = b2 + kstep;
            if (last && has_next) S.a_ready(nxt);
            PG8_LDB(B0, 0, 0); PG8_LDB(B1, 0, 1); PG8_SCHED; PG8_LDA(At, 0, 0); PG8_STAGE(PG8_SA(1, 1), a1 + hstepA, voffA);
            PG8_WAIT_V(8); PG8_WAIT_L(0); PG8_BAR; PG8_MMA(0, 0, At, B0); PG8_MMA(0, 1, At, B1); PG8_BAR; PG8_SCHED;
            PG8_LDA(At, 0, 1); PG8_STAGE(PG8_SB(0, 0), b2, voffB); PG8_STAGE(PG8_SB(0, 1), b2 + hstepB, voffB); PG8_STAGE(PG8_SA(0, 0), a2, voffA);
            PG8_WAIT_V(8); PG8_WAIT_L(0); PG8_BAR; PG8_MMA(1, 0, At, B0); PG8_MMA(1, 1, At, B1); PG8_BAR; PG8_SCHED;
            PG8_LDB(B0, 1, 0); PG8_LDB(B1, 1, 1); PG8_SCHED; PG8_LDA(At, 1, 0); PG8_STAGE(PG8_SA(0, 1), a2 + hstepA, voffA);
            PG8_WAIT_V(8); PG8_WAIT_L(0); PG8_BAR; PG8_MMA(0, 0, At, B0); PG8_MMA(0, 1, At, B1); PG8_BAR; PG8_SCHED;
            PG8_LDA(At, 1, 1); PG8_STAGE(PG8_SB(1, 0), b3, voffB); PG8_STAGE(PG8_SB(1, 1), b3 + hstepB, voffB); PG8_STAGE(PG8_SA(1, 0), a3, voffA);
            PG8_WAIT_V(8); PG8_WAIT_L(0); PG8_BAR; PG8_MMA(1, 0, At, B0); PG8_MMA(1, 1, At, B1); PG8_BAR; PG8_SCHED;
            if constexpr (Epi::HAS_MID) { if (E.is_mid(t + 2)) { E.mid(acc, cur, wr, wc, fr, fq, t + 2); PG8_SCHED; } }
        }
        if constexpr (ALIGN_EPI) { if (wr == 0) PG8_BAR; }
        E(acc, cur, wr, wc, fr, fq);
        if (!has_next) break;
#pragma unroll
        for (int a = 0; a < 2; ++a)
#pragma unroll
            for (int b = 0; b < 2; ++b)
#pragma unroll
                for (int m = 0; m < 4; ++m)
#pragma unroll
                    for (int n = 0; n < 2; ++n) acc[a][b][m][n] = (f32x4){0.f, 0.f, 0.f, 0.f};
        cur = nxt; cA = nA; cB = nB; ++ui;
        if constexpr (ALIGN_EPI) { if (wr == 1) PG8_BAR; }
    }
    PG8_WAIT_V(0);
    if constexpr (!ALIGN_EPI) { if (wr == 0) PG8_BAR; }
    PG8_BAR;
#undef PG8_SA
#undef PG8_SB
#undef PG8_STAGE
#undef PG8_LDA
#undef PG8_LDB
#undef PG8_MMA
#undef PG8_WAIT_V
#undef PG8_WAIT_L
#undef PG8_BAR
#undef PG8_SCHED
}
}

#define XB_TMO      128
#define XB_XCNT(j)  (256  + 64 * (j))
#define XB_XSUB(j)  (1280 + 64 * (j))
#define XB_XGEN(j)  (2304 + 64 * (j))
#define XB_TOP      3328
#define XB_TOPGEN   3392
#define XCD_BAR_WORDS 3456
#define XB_SPIN_CAP (1u << 22)
__device__ __forceinline__ unsigned xb_ld(unsigned* p)              { return __hip_atomic_load(p, __ATOMIC_RELAXED, __HIP_MEMORY_SCOPE_AGENT); }
__device__ __forceinline__ unsigned xb_add(unsigned* p, unsigned v) { return __hip_atomic_fetch_add(p, v, __ATOMIC_RELAXED, __HIP_MEMORY_SCOPE_AGENT); }
__device__ __forceinline__ unsigned xb_xcc_id() { return (unsigned)__builtin_amdgcn_s_getreg((3 << 11) | 20) & 0xFu; }
#define XB_SPIN(cond, bar) do { unsigned _sp = 0; while (cond) { __builtin_amdgcn_s_sleep(8); \
    if ((++_sp & 255u) == 0u) { if (xb_ld(&(bar)[XB_TMO])) break; if (_sp > XB_SPIN_CAP) { atomicAdd(&(bar)[XB_TMO], 1u); break; } } } } while (0)
struct XcdBarrier { unsigned* bar; unsigned x; volatile LAS unsigned* st; unsigned G; };
__device__ __forceinline__ XcdBarrier xcd_barrier_post(unsigned* bar, volatile LAS unsigned* st) {
    XcdBarrier b; b.bar = bar; b.x = xb_xcc_id(); b.st = st; b.G = 0;
    if (threadIdx.x == 0) (void)xb_add(&bar[XB_XCNT(b.x)], 1u);
    return b;
}
__device__ __forceinline__ void xcd_barrier_complete(unsigned* bar, unsigned x, unsigned G, unsigned& nloc, unsigned& nx) {
    unsigned sum, cnt, mine, sp = 0u;
    for (;;) {
        sum = 0u; cnt = 0u; mine = 0u;
#pragma unroll
        for (unsigned j = 0; j < 16; ++j) { const unsigned c = xb_ld(&bar[XB_XCNT(j)]); sum += c; cnt += (c > 0u) ? 1u : 0u; mine = (j == x) ? c : mine; }
        if (sum == G) break;
        __builtin_amdgcn_s_sleep(1);
        if ((++sp & 255u) == 0u) { if (xb_ld(&bar[XB_TMO])) break; if (sp > XB_SPIN_CAP) { atomicAdd(&bar[XB_TMO], 1u); break; } }
    }
    nloc = mine > 0u ? mine : 1u; nx = cnt > 0u ? cnt : 1u;
}
__device__ __forceinline__ void xcd_barrier(const XcdBarrier& b) {
    asm volatile("s_waitcnt vmcnt(0)" ::: "memory");
    __syncthreads();
    if (threadIdx.x == 0) {
        unsigned* bar = b.bar;
        __builtin_amdgcn_s_waitcnt(0);
        unsigned nloc = b.st[0], nx = b.st[1];
        if (nloc == 0u) { xcd_barrier_complete(bar, b.x, b.G, nloc, nx); b.st[0] = nloc; b.st[1] = nx; }
        const unsigned old = xb_add(&bar[XB_XSUB(b.x)], 1u);
        const unsigned gen = old / nloc;
        if (old + 1u == (gen + 1u) * nloc) {
            __builtin_amdgcn_fence(__ATOMIC_RELEASE, "agent");
            asm volatile("s_waitcnt vmcnt(0)" ::: "memory");
            const unsigned og = xb_add(&bar[XB_TOP], 1u);
            const unsigned tg = og / nx;
            if (og + 1u == (tg + 1u) * nx) xb_add(&bar[XB_TOPGEN], 1u);
            else XB_SPIN(xb_ld(&bar[XB_TOPGEN]) == tg, bar);
            __builtin_amdgcn_fence(__ATOMIC_ACQUIRE, "agent");
            xb_add(&bar[XB_XGEN(b.x)], 1u);
            asm volatile("s_waitcnt vmcnt(0)" ::: "memory");
        } else {
            XB_SPIN(xb_ld(&bar[XB_XGEN(b.x)]) == gen, bar);
            __builtin_amdgcn_fence(__ATOMIC_ACQUIRE, "agent");
            asm volatile("s_waitcnt vmcnt(0)" ::: "memory");
        }
    }
    __syncthreads();
}

template <int MODE>
__device__ __forceinline__ void transpose_item(const float* __restrict__ W, int K, int Nsrc, bf16* __restrict__ WT, LAS float* scr, int kb, int nb, int lane, const float* __restrict__ gk, int ldw = 0  ) {
    const int k0 = 64 * kb, n0 = 32 * nb;
    const int dstc = n0 + (lane & 31);
    int srcc = dstc;
    if (MODE == 1) srcc = dstc < 3072 ? dstc : (dstc < 3088 ? dstc - 3072 + 4096 : (dstc < 3328 ? -1 : (dstc < 3840 ? dstc - 3328 + 5392 : (dstc < 9984 ? dstc - 3840 + 6416 : (dstc < 11008 ? dstc - 9984 + 3072 :
                          (dstc < 11520 ? dstc - 11008 + 4112 : (dstc < 11776 ? dstc - 11520 + 4624 : (dstc < 12288 ? dstc - 11776 + 4880 : dstc - 12288 + 5904))))))));
    if (MODE == 2) srcc = ((dstc >> 5) & 1) * 4096 + (dstc >> 8) * 128 + ((dstc >> 6) & 3) * 32 + (dstc & 31);
    const bool ok = srcc >= 0; const int sc = ok ? srcc : 0;
    const float* wp = W + (size_t)(k0 + (lane >> 5)) * Nsrc + sc;
    float v[32];
#pragma unroll
    for (int i = 0; i < 32; ++i) v[i] = wp[(size_t)(2 * i) * Nsrc];
    if (gk) { float gv[32];
#pragma unroll
        for (int i = 0; i < 32; ++i) gv[i] = gk[k0 + 2 * i + (lane >> 5)];
#pragma unroll
        for (int i = 0; i < 32; ++i) v[i] *= gv[i]; }
#pragma unroll
    for (int i = 0; i < 32; ++i) scr[(2 * i + (lane >> 5)) * 33 + (lane & 31)] = ok ? v[i] : 0.f;
    LDS_WAIT(); asm volatile("" ::: "memory");
    const int c = lane & 7;
#pragma unroll
    for (int j = 0; j < 4; ++j) { const int n = (lane >> 3) + 8 * j; const LAS float* s = scr + (8 * c) * 33 + n;
        u32x4 o; o.x = cvt_pk_bf16(s[0 * 33], s[1 * 33]); o.y = cvt_pk_bf16(s[2 * 33], s[3 * 33]); o.z = cvt_pk_bf16(s[4 * 33], s[5 * 33]); o.w = cvt_pk_bf16(s[6 * 33], s[7 * 33]);
        *(u32x4*)(WT + (size_t)(n0 + n) * (ldw ? ldw : K) + k0 + 8 * c) = o; }
    LDS_WAIT(); asm volatile("" ::: "memory");
}
__device__ __forceinline__ void rms_row_bf16(const float* xrow, const float* g, bf16* orow, int lane) {
    const f32x4* xr = (const f32x4*)xrow + lane; f32x4 v[8]; float s = 0.f;
#pragma unroll
    for (int j = 0; j < 8; ++j) { v[j] = xr[64 * j]; s += (v[j].x * v[j].x + v[j].y * v[j].y) + (v[j].z * v[j].z + v[j].w * v[j].w); }
    const float rstd = rsqrtf(wave_sum(s) * (1.f / D_) + EPS_);
    const f32x4* gr = (const f32x4*)g + lane;
    u32x2* o8 = (u32x2*)orow + lane;
    f32x4 gq[8];
#pragma unroll
    for (int j = 0; j < 8; ++j) gq[j] = gr[64 * j];
#pragma unroll
    for (int j = 0; j < 8; ++j) { const f32x4 gv = gq[j]; u32x2 w; w.x = cvt_pk_bf16(v[j].x * rstd * gv.x, v[j].y * rstd * gv.y); w.y = cvt_pk_bf16(v[j].z * rstd * gv.z, v[j].w * rstd * gv.w); o8[64 * j] = w; }
}
__device__ __forceinline__ void rms_row_f32_inplace(float* xrow, const float* g, int lane) {
    f32x4* xr = (f32x4*)xrow + lane; f32x4 v[8]; float s = 0.f;
#pragma unroll
    for (int j = 0; j < 8; ++j) { v[j] = xr[64 * j]; s += (v[j].x * v[j].x + v[j].y * v[j].y) + (v[j].z * v[j].z + v[j].w * v[j].w); }
    const float rstd = rsqrtf(wave_sum(s) * (1.f / D_) + EPS_);
    const f32x4* gr = (const f32x4*)g + lane;
#pragma unroll
    for (int j = 0; j < 8; ++j) { const f32x4 gv = gr[64 * j]; xr[64 * j] = v[j] * rstd * gv; }
}
__device__ __forceinline__ float red16(float v) { v += __shfl_xor(v, 1); v += __shfl_xor(v, 2); v += __shfl_xor(v, 4); v += __shfl_xor(v, 8); return v; }

typedef float f32x16 __attribute__((ext_vector_type(16)));
typedef __bf16 bf2v __attribute__((ext_vector_type(2)));
__device__ __forceinline__ unsigned pk2(float lo, float hi) { const f32x2 v = {lo, hi}; return __builtin_bit_cast(unsigned, __builtin_convertvector(v, bf2v)); }
#define MFMA16(a, b, c) __builtin_amdgcn_mfma_f32_16x16x32_bf16((a), (b), (c), 0, 0, 0)
#define MFMA32(a, b, c) __builtin_amdgcn_mfma_f32_32x32x16_bf16((a), (b), (c), 0, 0, 0)
constexpr int DU_NKW = 0, DU_QP = 32768, DU_BM = 49152, DU_OP = 81920, DU_BYTES = 98304;
constexpr int P_K = 0, P_Q = 17408, P_VBT = 52736, P_KBGT = 71168, P_KDT = 89600, P_TINV = 108032, P_QK = 117248, P_T11T = 126464, P_M1T = 129024, P_SM = 131584, P_CW = 132096, P_PS = 138240, P_QD = 142336, P_AB = 159744;
constexpr int LDK = 136, LDT = 72, LDL = 68, LDS40 = 40;
__device__ __forceinline__ bf16x8 ldfrag(const LAS bf16* mat, int ld, int row0, int k0, int fr, int fq) { return *(const LAS bf16x8*)(mat + (row0 + fr) * ld + k0 + 8 * fq); }

__device__ __forceinline__ void prep_stage_raw(LAS unsigned char* lds, const bf16* proj, const unsigned char* zero16, int t0, int hd, int tid) {
    const int lane = tid & 63, wave = __builtin_amdgcn_readfirstlane(tid >> 6);
#pragma unroll
    for (int q = 0; q < 7; ++q) {
        const int grp = wave + 8 * q, i = grp * 64 + lane, r = i / 49, c = i % 49, tt = t0 - 3 + r;
        const unsigned char* src = (c < 48 && tt >= 0) ? (const unsigned char*)(proj + (size_t)tt * NPROJ + (c >> 4) * 1024 + hd * 128 + 8 * (c & 15)) : zero16;
        if (i < 67 * 49) __builtin_amdgcn_global_load_lds((const unsigned*)src, (LAS unsigned*)(lds + grp * 1024), 16, 0, 0);
    }
    if (wave == 0) {
        const bf16* ap = proj + (size_t)(t0 + lane) * NPROJ + (hd & ~1);
        __builtin_amdgcn_global_load_lds((const unsigned*)(ap + PC_A), (LAS unsigned*)(lds + P_AB), 4, 0, 0);
        __builtin_amdgcn_global_load_lds((const unsigned*)(ap + PC_B), (LAS unsigned*)(lds + P_AB + 256), 4, 0, 0);
    }
}
__device__ __forceinline__ void delta_prep_unit(LAS unsigned char* lds, const bf16* proj, const float* convw  , float a_log, float dt_bias, unsigned char* dst  , float* gl_out, bf16* opb,
                                                int t0, int hd, int tid_in, const unsigned char* zero16, int next_t0) {
    const int tid = launder_v(tid_in);
    const int lane = tid & 63, wave = __builtin_amdgcn_readfirstlane(tid >> 6), fr = lane & 15, fq = lane >> 4;
    LAS bf16* Kk = (LAS bf16*)(lds + P_K); LAS bf16* Qq = (LAS bf16*)(lds + P_Q); LAS bf16* QD = (LAS bf16*)(lds + P_QD);
    LAS bf16* VBT = (LAS bf16*)(lds + P_VBT); LAS bf16* KBGT = (LAS bf16*)(lds + P_KBGT); LAS bf16* KDT = (LAS bf16*)(lds + P_KDT);
    LAS bf16* TINV = (LAS bf16*)(lds + P_TINV); LAS bf16* QK = (LAS bf16*)(lds + P_QK); LAS bf16* T11T = (LAS bf16*)(lds + P_T11T); LAS bf16* M1T = (LAS bf16*)(lds + P_M1T);
    LAS float* Lf = (LAS float*)(lds + P_Q); LAS float* gcs = (LAS float*)(lds + P_SM); LAS float* bts = gcs + 64;
    const float scale = 0.08838834764831845f;
    asm volatile("s_waitcnt lgkmcnt(0)" ::: "memory"); __builtin_amdgcn_s_barrier(); asm volatile("" ::: "memory");
    asm volatile("s_waitcnt vmcnt(16)" ::: "memory");
    if (wave == 0) {
        const unsigned aw = *(const LAS unsigned*)(lds + P_AB + lane * 4), bw = *(const LAS unsigned*)(lds + P_AB + 256 + lane * 4);
        const float a = (hd & 1) ? bf_hi(aw) : bf_lo(aw), b = (hd & 1) ? bf_hi(bw) : bf_lo(bw);
        float g = -__expf(a_log) * softplusf_(a + dt_bias);
#pragma unroll
        for (int off = 1; off < 64; off <<= 1) { const float nb = __shfl_up(g, off); if (lane >= off) g += nb; }
        gcs[lane] = g; bts[lane] = sigmoidf_(b);
        if (lane == 63) *gl_out = __expf(g);
    }
    asm volatile("s_waitcnt lgkmcnt(0)" ::: "memory"); __builtin_amdgcn_s_barrier(); asm volatile("" ::: "memory");
    LAS bf16* RAW = (LAS bf16*)lds;
    const LAS float* CW = (const LAS float*)(lds + P_CW);
    const int tok = lane, js = wave;
    LAS float* PS = (LAS float*)(lds + P_PS);
    float qv[16], kv[16], vv[16];
#pragma unroll
    for (int sec = 0; sec < 3; ++sec) {
        float acc[16];
#pragma unroll
        for (int i = 0; i < 16; ++i) acc[i] = 0.f;
#pragma unroll
        for (int tap = 0; tap < 4; ++tap) {
            const LAS bf16* rp = RAW + (tok + tap) * 392 + sec * 128 + 16 * js;
            const u32x4 r0 = *(const LAS u32x4*)rp, r1 = *(const LAS u32x4*)(rp + 8);
            const LAS float* wp = CW + tap * 384 + sec * 128 + 16 * js;
            const f32x4 w0 = *(const LAS f32x4*)(wp), w1 = *(const LAS f32x4*)(wp + 4), w2 = *(const LAS f32x4*)(wp + 8), w3 = *(const LAS f32x4*)(wp + 12);
            acc[0] += w0.x * bf_lo(r0.x); acc[1] += w0.y * bf_hi(r0.x); acc[2] += w0.z * bf_lo(r0.y); acc[3] += w0.w * bf_hi(r0.y);
            acc[4] += w1.x * bf_lo(r0.z); acc[5] += w1.y * bf_hi(r0.z); acc[6] += w1.z * bf_lo(r0.w); acc[7] += w1.w * bf_hi(r0.w);
            acc[8] += w2.x * bf_lo(r1.x); acc[9] += w2.y * bf_hi(r1.x); acc[10] += w2.z * bf_lo(r1.y); acc[11] += w2.w * bf_hi(r1.y);
            acc[12] += w3.x * bf_lo(r1.z); acc[13] += w3.y * bf_hi(r1.z); acc[14] += w3.z * bf_lo(r1.w); acc[15] += w3.w * bf_hi(r1.w);
        }
        float ss = 0.f;
#pragma unroll
        for (int i = 0; i < 16; ++i) { acc[i] = siluf_(acc[i]); ss += acc[i] * acc[i]; }
        if (sec < 2) PS[(sec * 8 + js) * 64 + tok] = ss;
#pragma unroll
        for (int i = 0; i < 16; ++i) { if (sec == 0) qv[i] = acc[i]; else if (sec == 1) kv[i] = acc[i]; else vv[i] = acc[i]; }
    }
    __syncthreads();
    {
        const float gc = gcs[tok], bt = bts[tok], gclast = gcs[63];
        const float eg = __expf(gc), sq = scale * eg, ekd = __expf(gclast - gc), bkg = bt * eg;
        { float sq2 = 0.f, sk2 = 0.f;
#pragma unroll
          for (int w8 = 0; w8 < 8; ++w8) { sq2 += PS[w8 * 64 + tok]; sk2 += PS[(8 + w8) * 64 + tok]; }
          const float rq = rsqrtf(sq2 + EPS_), rk = rsqrtf(sk2 + EPS_);
#pragma unroll
          for (int i = 0; i < 16; ++i) { qv[i] *= rq; kv[i] *= rk; } }
        u32x4 w;
        LAS bf16* kr = Kk + tok * LDK + 16 * js; LAS bf16* qr = Qq + tok * LDK + 16 * js; LAS bf16* qdr = QD + tok * LDK + 16 * js;
        w.x = pk2(kv[0], kv[1]); w.y = pk2(kv[2], kv[3]); w.z = pk2(kv[4], kv[5]); w.w = pk2(kv[6], kv[7]); *(LAS u32x4*)kr = w;
        w.x = pk2(kv[8], kv[9]); w.y = pk2(kv[10], kv[11]); w.z = pk2(kv[12], kv[13]); w.w = pk2(kv[14], kv[15]); *(LAS u32x4*)(kr + 8) = w;
        w.x = pk2(qv[0], qv[1]); w.y = pk2(qv[2], qv[3]); w.z = pk2(qv[4], qv[5]); w.w = pk2(qv[6], qv[7]); *(LAS u32x4*)qr = w;
        w.x = pk2(qv[8], qv[9]); w.y = pk2(qv[10], qv[11]); w.z = pk2(qv[12], qv[13]); w.w = pk2(qv[14], qv[15]); *(LAS u32x4*)(qr + 8) = w;
        w.x = pk2(sq * qv[0], sq * qv[1]); w.y = pk2(sq * qv[2], sq * qv[3]); w.z = pk2(sq * qv[4], sq * qv[5]); w.w = pk2(sq * qv[6], sq * qv[7]); *(LAS u32x4*)qdr = w;
        w.x = pk2(sq * qv[8], sq * qv[9]); w.y = pk2(sq * qv[10], sq * qv[11]); w.z = pk2(sq * qv[12], sq * qv[13]); w.w = pk2(sq * qv[14], sq * qv[15]); *(LAS u32x4*)(qdr + 8) = w;
#pragma unroll
        for (int i = 0; i < 16; ++i) {
            const int c = 16 * js + i;
            VBT[c * LDT + tok] = (bf16)(pk2(bt * vv[i], 0.f) & 0xffffu);
            KBGT[c * LDT + tok] = (bf16)(pk2(bkg * kv[i], 0.f) & 0xffffu);
            KDT[c * LDT + tok] = (bf16)(pk2(ekd * kv[i], 0.f) & 0xffffu);
        }
    }
    __syncthreads();
    const f32x4 z4 = {0.f, 0.f, 0.f, 0.f};
#pragma unroll
    for (int rep = 0; rep < 2; ++rep) {
        const int id = wave + 8 * rep, it = id >> 2, jt = id & 3;
        const int i = 16 * it + fr, j0 = 16 * jt + 4 * fq;
        u32x2 o = {0u, 0u};
        if (it >= jt) {
            f32x4 acc = z4;
#pragma unroll
            for (int ks = 0; ks < 4; ++ks) acc = MFMA16(ldfrag(Kk, LDK, 16 * jt, 32 * ks, fr, fq), ldfrag(Qq, LDK, 16 * it, 32 * ks, fr, fq), acc);
            const float gi = gcs[i]; float v[4];
#pragma unroll
            for (int r = 0; r < 4; ++r) v[r] = (i >= j0 + r) ? scale * acc[r] * __expf(gi - gcs[j0 + r]) : 0.f;
            o.x = pk2(v[0], v[1]); o.y = pk2(v[2], v[3]);
        }
        *(LAS u32x2*)(QK + i * LDT + j0) = o;
    }
    __syncthreads();
#pragma unroll
    for (int rep = 0; rep < 2; ++rep) {
        const int id = wave + 8 * rep, it = id >> 2, jt = id & 3;
        const int i = 16 * it + fr, j0 = 16 * jt + 4 * fq;
        f32x4 v = z4;
        if (it >= jt) {
            f32x4 acc = z4;
#pragma unroll
            for (int ks = 0; ks < 4; ++ks) acc = MFMA16(ldfrag(Kk, LDK, 16 * jt, 32 * ks, fr, fq), ldfrag(Kk, LDK, 16 * it, 32 * ks, fr, fq), acc);
            const float gi = gcs[i], bi = bts[i];
#pragma unroll
            for (int r = 0; r < 4; ++r) v[r] = (i > j0 + r) ? bi * acc[r] * __expf(gi - gcs[j0 + r]) : 0.f;
        }
        *(LAS f32x4*)(Lf + i * LDL + j0) = v;
        if ((it >= 2) != (jt >= 2)) { u32x2 o; o.x = pk2(v[0], v[1]); o.y = pk2(v[2], v[3]); *(LAS u32x2*)(TINV + i * LDT + j0) = o; }
    }
    __syncthreads();
    if (wave < 2) {
        const int off = 32 * wave, c = lane & 31;
        float A[32];
#pragma unroll
        for (int i = 0; i < 32; ++i) {
            float lrow = Lf[(off + i) * LDL + off + c];
            if (i > 0) asm volatile("" : "+v"(lrow) : "v"(A[i - 1]));
            float a0 = -lrow, a1 = 0.f;
#pragma unroll
            for (int j = 0; j < i; ++j) { const float s = __uint_as_float(__builtin_amdgcn_readlane(__float_as_uint(lrow), j)); if (j & 1) a1 -= s * A[j]; else a0 -= s * A[j]; }
            A[i] = a0 + a1;
        }
        if (lane < 32) {
#pragma unroll
            for (int j = 0; j < 32; ++j) TINV[(off + j) * LDT + off + c] = (bf16)(pk2(A[j] + (j == c ? 1.f : 0.f), 0.f) & 0xffffu);
            if (wave == 0) {
#pragma unroll
                for (int j = 0; j < 32; j += 2) *(LAS unsigned*)(T11T + c * LDS40 + j) = pk2(A[j] + (j == c ? 1.f : 0.f), A[j + 1] + (j + 1 == c ? 1.f : 0.f));
            }
        }
    }
    __syncthreads();
    if (wave < 4) {
        const int mt = wave >> 1, nt = wave & 1;
        const f32x4 acc = MFMA16(ldfrag(TINV, LDT, 32 + 16 * mt, 0, fr, fq), ldfrag(T11T, LDS40, 16 * nt, 0, fr, fq), z4);
        u32x2 o; o.x = pk2(acc[0], acc[1]); o.y = pk2(acc[2], acc[3]);
        *(LAS u32x2*)(M1T + (16 * nt + fr) * LDS40 + 16 * mt + 4 * fq) = o;
    }
    __syncthreads();
    if (wave < 4) {
        const int itl = wave >> 1, ct = wave & 1;
        const f32x4 acc = MFMA16(ldfrag(M1T, LDS40, 16 * ct, 0, fr, fq), ldfrag(TINV + 32, LDT, 32 + 16 * itl, 0, fr, fq), z4);
        u32x2 o; o.x = pk2(-acc[0], -acc[1]); o.y = pk2(-acc[2], -acc[3]);
        *(LAS u32x2*)(TINV + (32 + 16 * itl + fr) * LDT + 16 * ct + 4 * fq) = o;
    }
    __syncthreads();
    {
        bf16x8 at[4][2];
#pragma unroll
        for (int mt = 0; mt < 4; ++mt)
#pragma unroll
            for (int ks = 0; ks < 2; ++ks) at[mt][ks] = ldfrag(TINV, LDT, 16 * mt, 32 * ks, fr, fq);
        bf16x8 bv[2], bk[2];
#pragma unroll
        for (int ks = 0; ks < 2; ++ks) { bv[ks] = ldfrag(VBT, LDT, 16 * wave, 32 * ks, fr, fq); bk[ks] = ldfrag(KBGT, LDT, 16 * wave, 32 * ks, fr, fq); }
        f32x4 au[4], aw[4];
#pragma unroll
        for (int mt = 0; mt < 4; ++mt) { au[mt] = z4; aw[mt] = z4;
#pragma unroll
            for (int ks = 0; ks < 2; ++ks) { au[mt] = MFMA16(at[mt][ks], bv[ks], au[mt]); aw[mt] = MFMA16(at[mt][ks], bk[ks], aw[mt]); } }
#pragma unroll
        for (int mt = 0; mt < 4; ++mt) {
            u32x2 o; o.x = pk2(au[mt][0], au[mt][1]); o.y = pk2(au[mt][2], au[mt][3]); *(LAS u32x2*)(VBT + (16 * wave + fr) * LDT + 16 * mt + 4 * fq) = o;
            o.x = pk2(aw[mt][0], aw[mt][1]); o.y = pk2(aw[mt][2], aw[mt][3]); *(LAS u32x2*)(KBGT + (16 * wave + fr) * LDT + 16 * mt + 4 * fq) = o;
        }
    }
    __syncthreads();
    LAS bf16* UT = VBT; LAS bf16* WT = KBGT;
    if (next_t0 >= 0) {
        prep_stage_raw(lds, proj, zero16, next_t0, hd, tid);
    }
    asm volatile("" ::: "memory"); __builtin_amdgcn_sched_barrier(0);
    {
        bf16x8 kd[2];
#pragma unroll
        for (int ks = 0; ks < 2; ++ks) kd[ks] = ldfrag(KDT, LDT, 16 * wave, 32 * ks, fr, fq);
#pragma unroll 2
        for (int nt = 0; nt < 8; ++nt) {
            f32x4 an = z4, ab = z4;
#pragma unroll
            for (int ks = 0; ks < 2; ++ks) { an = MFMA16(ldfrag(WT, LDT, 16 * nt, 32 * ks, fr, fq), kd[ks], an); ab = MFMA16(kd[ks], ldfrag(UT, LDT, 16 * nt, 32 * ks, fr, fq), ab); }
            { const int m = 16 * wave + fr; u32x2 o; o.x = pk2(-an[0], -an[1]); o.y = pk2(-an[2], -an[3]);
              *(u32x2*)(dst + DU_NKW + ((((m >> 5) * 8 + nt) * 64 + (m & 31) + 32 * (fq & 1)) * 16) + 8 * (fq >> 1)) = o; }
            { const int dv = 16 * nt + fr, d = 16 * wave + 4 * fq, rr = d & 31; u32x2 o; o.x = pk2(ab[0], ab[1]); o.y = pk2(ab[2], ab[3]);
              *(u32x2*)(dst + DU_BM + (((((dv >> 5) * 4 + (d >> 5)) * 64 + (dv & 31) + 32 * ((rr >> 2) & 1)) * 16 + 4 * (rr >> 3)) * 2)) = o; }
        }
    }
    {
        bf16x8 wt[2], ut[2];
#pragma unroll
        for (int ks = 0; ks < 2; ++ks) { wt[ks] = ldfrag(WT, LDT, 16 * wave, 32 * ks, fr, fq); ut[ks] = ldfrag(UT, LDT, 16 * wave, 32 * ks, fr, fq); }
#pragma unroll 2
        for (int it = 0; it < 4; ++it) {
            f32x4 aq = z4, ao = z4;
#pragma unroll
            for (int ks = 0; ks < 2; ++ks) { const bf16x8 qf = ldfrag(QK, LDT, 16 * it, 32 * ks, fr, fq); aq = MFMA16(wt[ks], qf, aq); ao = MFMA16(ut[ks], qf, ao); }
            { const int i = 16 * it + fr; const u32x2 qd = *(const LAS u32x2*)(QD + i * LDK + 16 * wave + 4 * fq);
              u32x2 o; o.x = pk2(bf_lo(qd.x) - aq[0], bf_hi(qd.x) - aq[1]); o.y = pk2(bf_lo(qd.y) - aq[2], bf_hi(qd.y) - aq[3]);
              *(u32x2*)(dst + DU_QP + ((((i >> 5) * 8 + wave) * 64 + (i & 31) + 32 * (fq & 1)) * 16) + 8 * (fq >> 1)) = o; }
            { u32x2 o; o.x = pk2(ao[0], ao[1]); o.y = pk2(ao[2], ao[3]); *(u32x2*)(opb + (size_t)(t0 + 16 * it + fr) * 1024 + hd * 128 + 16 * wave + 4 * fq) = o; }
        }
    }
}

__device__ __forceinline__ void delta_scan_head(LAS unsigned char* lds, const unsigned char* dprep  , const float* gl, bf16* oraw, int hd, int tid) {
    const int lane = tid & 63, wave = __builtin_amdgcn_readfirstlane(tid >> 6);
    constexpr int NCH = S_ / 64, SLOT = 49152, OBUF = 3 * SLOT;
    const unsigned char* ub = dprep + (size_t)hd * (S_ / 64) * DU_BYTES;
    constexpr size_t CSTEP = (size_t)DU_BYTES;
    volatile LAS unsigned* MISCW = (volatile LAS unsigned*)(lds + MISC_OFF);
    __syncthreads();
    const unsigned sv0 = MISCW[8], sv1 = MISCW[9], sv2 = MISCW[10], sv3 = MISCW[11];
    __syncthreads();
#define SCAN_STAGE(n_, slot_) do { const unsigned char* src_ = ub + (size_t)(n_) * CSTEP + lane * 16; \
        _Pragma("unroll") for (int q_ = 0; q_ < 24; ++q_) { const int idx_ = (wave - 4) + 2 * q_; \
            __builtin_amdgcn_global_load_lds((const unsigned*)(src_ + idx_ * 1024), (LAS unsigned*)(lds + (slot_) * SLOT + idx_ * 1024), 16, 0, 0); } } while (0)
#define SCAN_FLUSH(n_) do { const int v_ = wave - 6; u32x4 t_[8]; \
        _Pragma("unroll") for (int i_ = 0; i_ < 8; ++i_) { const int tok_ = 32 * v_ + 4 * i_ + (lane >> 4), ck_ = (lane & 15) ^ (tok_ & 15); t_[i_] = *(const LAS u32x4*)(lds + OBUF + tok_ * 256 + ck_ * 16); } \
        _Pragma("unroll") for (int i_ = 0; i_ < 8; ++i_) { const int tok_ = 32 * v_ + 4 * i_ + (lane >> 4); *(u32x4*)(oraw + (size_t)(64 * (n_) + tok_) * 1024 + hd * 128 + 8 * (lane & 15)) = t_[i_]; } } while (0)
    if (wave >= 6) {
        __builtin_amdgcn_s_barrier(); asm volatile("" ::: "memory");
#pragma unroll 1
        for (int n = 0; n < NCH; ++n) {
            if (n > 0) SCAN_FLUSH(n - 1);
            asm volatile("s_waitcnt lgkmcnt(0)" ::: "memory");
            __builtin_amdgcn_s_barrier(); asm volatile("" ::: "memory");
            __builtin_amdgcn_s_barrier(); asm volatile("" ::: "memory");
        }
        SCAN_FLUSH(NCH - 1);
    } else if (wave >= 4) {
        SCAN_STAGE(0, 0); SCAN_STAGE(1, 1);
        asm volatile("s_waitcnt vmcnt(24)" ::: "memory");
        __builtin_amdgcn_s_barrier(); asm volatile("" ::: "memory");
#pragma unroll 1
        for (int n = 0; n < NCH; ++n) {
            if (n + 2 < NCH) { SCAN_STAGE(n + 2, (n + 2) % 3); asm volatile("s_waitcnt vmcnt(24)" ::: "memory"); }
            else asm volatile("s_waitcnt vmcnt(0)" ::: "memory");
            __builtin_amdgcn_s_barrier(); asm volatile("" ::: "memory");
            __builtin_amdgcn_s_barrier(); asm volatile("" ::: "memory");
        }
    } else {
        f32x16 Sacc[4];
#pragma unroll
        for (int mt = 0; mt < 4; ++mt)
#pragma unroll
            for (int r = 0; r < 16; ++r) Sacc[mt][r] = 0.f;
        u32x4 bc[16];
        float gq2[2];
#pragma unroll
        for (int par = 0; par < 2; ++par) {
            const u32x4* bp = (const u32x4*)(ub + (size_t)par * CSTEP + DU_BM + (size_t)(wave * 4 * 64 + lane) * 32);
#pragma unroll
            for (int mt = 0; mt < 4; ++mt) { bc[8 * par + 2 * mt] = bp[mt * 128]; bc[8 * par + 2 * mt + 1] = bp[mt * 128 + 1]; }
            gq2[par] = gl[par * 8 + hd];
        }
        asm volatile("" ::: "memory");
        __builtin_amdgcn_s_barrier(); asm volatile("" ::: "memory");
#pragma unroll 1
        for (int n2 = 0; n2 < NCH; n2 += 2) {
#pragma unroll
          for (int par = 0; par < 2; ++par) {
            const int n = n2 + par;
            const int slot = n % 3;
            const float g = gq2[par];
            bf16x8 Sb[8];
#define SCAN_PACK(k_) do { constexpr int mt_ = (k_) >> 1, s_ = (k_) & 1; u32x4 p_; p_.x = pk2(Sacc[mt_][8 * s_], Sacc[mt_][8 * s_ + 1]); p_.y = pk2(Sacc[mt_][8 * s_ + 2], Sacc[mt_][8 * s_ + 3]); \
                p_.z = pk2(Sacc[mt_][8 * s_ + 4], Sacc[mt_][8 * s_ + 5]); p_.w = pk2(Sacc[mt_][8 * s_ + 6], Sacc[mt_][8 * s_ + 7]); Sb[k_] = __builtin_bit_cast(bf16x8, p_); } while (0)
#define SCAN_CINIT(h_) do { const int p_ = (h_) >> 1, mt_ = p_ >> 1, h2_ = p_ & 1, hf_ = (h_) & 1, e_ = 8 * h2_ + 4 * hf_; const u32x4 b_ = bc[8 * par + 2 * mt_ + h2_]; const unsigned w0_ = hf_ ? b_.z : b_.x, w1_ = hf_ ? b_.w : b_.y; \
                Sacc[mt_][e_ + 0] = g * Sacc[mt_][e_ + 0] + bf_lo(w0_); Sacc[mt_][e_ + 1] = g * Sacc[mt_][e_ + 1] + bf_hi(w0_); \
                Sacc[mt_][e_ + 2] = g * Sacc[mt_][e_ + 2] + bf_lo(w1_); Sacc[mt_][e_ + 3] = g * Sacc[mt_][e_ + 3] + bf_hi(w1_); } while (0)
            SCAN_PACK(0); SCAN_PACK(1); SCAN_PACK(2); SCAN_PACK(3);
            const LAS bf16x8* fr0 = (const LAS bf16x8*)(lds + slot * SLOT + lane * 16);
            constexpr int PD = 4;
            bf16x8 fa[PD];
#define SCAN_FIDX(f_) (((f_) < 16) ? 32 + (f_) : (f_) - 16)
#pragma unroll
            for (int i = 0; i < PD; ++i) fa[i] = fr0[SCAN_FIDX(i) * 64];
            const int nn = (n + 2 < NCH) ? n + 2 : n;
            const u32x4* bpn = (const u32x4*)(ub + (size_t)nn * CSTEP + DU_BM + (size_t)(wave * 4 * 64 + lane) * 32);
            gq2[par] = gl[nn * 8 + hd];
            f32x16 oacc[2];
            __builtin_amdgcn_sched_barrier(0);
#pragma unroll
            for (int f = 0; f < 16; ++f) {
                const bf16x8 a = fa[f % PD];
                fa[f % PD] = fr0[SCAN_FIDX(f + PD) * 64];
                if ((f & 7) == 0) { f32x16 z16;
#pragma unroll
                    for (int r = 0; r < 16; ++r) z16[r] = 0.f;
                    oacc[f >> 3] = MFMA32(Sb[f & 7], a, z16); }
                else oacc[f >> 3] = MFMA32(Sb[f & 7], a, oacc[f >> 3]);
                if (f == 0) SCAN_PACK(4); if (f == 2) SCAN_PACK(5); if (f == 4) SCAN_PACK(6); if (f == 6) SCAN_PACK(7);
                SCAN_CINIT(f);
                if ((f & 3) == 3) { bc[8 * par + 2 * (f >> 2)] = bpn[(f >> 2) * 128]; bc[8 * par + 2 * (f >> 2) + 1] = bpn[(f >> 2) * 128 + 1]; }
                __builtin_amdgcn_sched_barrier(0);
            }
#pragma unroll
            for (int f = 16; f < 48; ++f) {
                const bf16x8 a = fa[f % PD];
                if (f + PD < 48) fa[f % PD] = fr0[SCAN_FIDX(f + PD) * 64];
                Sacc[(f - 16) >> 3] = MFMA32(a, Sb[f & 7], Sacc[(f - 16) >> 3]);
            }
#undef SCAN_FIDX
#undef SCAN_PACK
#undef SCAN_CINIT
#pragma unroll
            for (int f = 16; f < 48 - PD; ++f) { __builtin_amdgcn_sched_group_barrier(0x008, 1, 0); __builtin_amdgcn_sched_group_barrier(0x100, 1, 0); }
            __builtin_amdgcn_sched_group_barrier(0x008, PD, 0);
            asm volatile("s_waitcnt lgkmcnt(0)" ::: "memory");
            __builtin_amdgcn_s_barrier(); asm volatile("" ::: "memory");
#pragma unroll
            for (int mt = 0; mt < 2; ++mt) { const int tok = 32 * mt + (lane & 31);
#pragma unroll
                for (int gq = 0; gq < 4; ++gq) { u32x2 w; w.x = pk2(oacc[mt][4 * gq], oacc[mt][4 * gq + 1]); w.y = pk2(oacc[mt][4 * gq + 2], oacc[mt][4 * gq + 3]);
                    *(LAS u32x2*)(lds + OBUF + tok * 256 + (((4 * wave + gq) ^ (tok & 15)) * 16) + 8 * (lane >> 5)) = w; } }
            asm volatile("s_waitcnt lgkmcnt(0)" ::: "memory");
            __builtin_amdgcn_s_barrier(); asm volatile("" ::: "memory");
          }
        }
    }
    __syncthreads();
    if (tid == 0) { MISCW[8] = sv0; MISCW[9] = sv1; MISCW[10] = sv2; MISCW[11] = sv3; }
    __syncthreads();
#undef SCAN_STAGE
#undef SCAN_FLUSH
}

__device__ __forceinline__ int vt_pos(int key) { const int kk = key & 15; return (key & ~15) + 8 * ((kk >> 2) & 1) + 4 * (kk >> 3) + (kk & 3); }
template <int DH, int NKEYS>
__device__ __forceinline__ void stage_k(LAS bf16* Kl, const bf16* __restrict__ src, int gld, int kbase, int tid, bool zero) {
    constexpr int CPR = DH / 8, NIT = NKEYS * CPR / 512;
    u32x4 v[NIT];
#pragma unroll
    for (int it = 0; it < NIT; ++it) { const int ci = tid + 512 * it, r = ci / CPR, c = ci % CPR; const unsigned z0 = (unsigned)launder_v(0); v[it] = (u32x4){z0, z0, z0, z0}; if (!zero) v[it] = *(const u32x4*)(src + (size_t)r * gld + 8 * c); }
#pragma unroll
    for (int it = 0; it < NIT; ++it) { const int ci = tid + 512 * it, r = ci / CPR, c = ci % CPR; *(LAS u32x4*)(Kl + (kbase + r) * (DH + 8) + 8 * c) = v[it]; }
}
template <int DH, int NKEYS>
__device__ __forceinline__ void stage_vt(LAS bf16* Vt, int ldv, const bf16* __restrict__ src, int gld, int kbase, int tid, bool zero) {
    constexpr int CPR = DH / 8, NIT = NKEYS * CPR / 512;
    u32x4 v[NIT];
#pragma unroll
    for (int it = 0; it < NIT; ++it) { const int ci = tid + 512 * it, r = ci % NKEYS, c = ci / NKEYS; const unsigned z0 = (unsigned)launder_v(0); v[it] = (u32x4){z0, z0, z0, z0}; if (!zero) v[it] = *(const u32x4*)(src + (size_t)r * gld + 8 * c); }
#pragma unroll
    for (int it = 0; it < NIT; ++it) { const int ci = tid + 512 * it, r = ci % NKEYS, c = ci / NKEYS;
        LAS bf16* d = Vt + (8 * c) * ldv + vt_pos(kbase + r); const u32x4 w = v[it];
        d[0] = (bf16)(w.x & 0xffffu); d[ldv] = (bf16)(w.x >> 16); d[2 * ldv] = (bf16)(w.y & 0xffffu); d[3 * ldv] = (bf16)(w.y >> 16);
        d[4 * ldv] = (bf16)(w.z & 0xffffu); d[5 * ldv] = (bf16)(w.z >> 16); d[6 * ldv] = (bf16)(w.w & 0xffffu); d[7 * ldv] = (bf16)(w.w >> 16); }
}
template <int DH>
__device__ __forceinline__ void stage_k_loop(LAS bf16* Kl, const bf16* src, int gld, int nkeys, int kbase, int tid) {
    constexpr int CPR = DH / 8;
    for (int ci = tid; ci < nkeys * CPR; ci += 512) { const int r = ci / CPR, c = ci % CPR;
        const u32x4 v = *(const u32x4*)(src + (size_t)r * gld + 8 * c);
        *(LAS u32x4*)(Kl + (kbase + r) * (DH + 8) + 8 * c) = v; }
}
template <int DH>
__device__ __forceinline__ void stage_vt_loop(LAS bf16* Vt, int ldv, const bf16* src, int gld, int nkeys, int kbase, int tid) {
    constexpr int CPR = DH / 8;
    for (int ci = tid; ci < nkeys * CPR; ci += 512) { const int r = ci % nkeys, c = ci / nkeys;
        const u32x4 v = *(const u32x4*)(src + (size_t)r * gld + 8 * c);
        LAS bf16* d = Vt + (8 * c) * ldv + vt_pos(kbase + r);
        d[0] = (bf16)(v.x & 0xffffu); d[ldv] = (bf16)(v.x >> 16); d[2 * ldv] = (bf16)(v.y & 0xffffu); d[3 * ldv] = (bf16)(v.y >> 16);
        d[4 * ldv] = (bf16)(v.z & 0xffffu); d[5 * ldv] = (bf16)(v.z >> 16); d[6 * ldv] = (bf16)(v.w & 0xffffu); d[7 * ldv] = (bf16)(v.w >> 16); }
}
__device__ __forceinline__ bf16x8 pack8(const f32x16& x, int s) {
    u32x4 p; p.x = pk2(x[8 * s], x[8 * s + 1]); p.y = pk2(x[8 * s + 2], x[8 * s + 3]); p.z = pk2(x[8 * s + 4], x[8 * s + 5]); p.w = pk2(x[8 * s + 6], x[8 * s + 7]);
    return __builtin_bit_cast(bf16x8, p);
}
__device__ __forceinline__ int crow16(int reg, int h) { return (reg & 3) + 8 * (reg >> 2) + 4 * h; }
__device__ __forceinline__ void store_ot(bf16* orow  , const f32x16& o, float inv, int h) {
#pragma unroll
    for (int g = 0; g < 4; ++g) { u32x2 w; w.x = pk2(o[4 * g] * inv, o[4 * g + 1] * inv); w.y = pk2(o[4 * g + 2] * inv, o[4 * g + 3] * inv); *(u32x2*)(orow + 8 * g + 4 * h) = w; }
}

__device__ __forceinline__ void swa_unit(LAS unsigned char* lds, const bf16* proj, const float* sinks, bf16* y, int kvh, int b, int tid) {
    const int lane = tid & 63, wave = __builtin_amdgcn_readfirstlane(tid >> 6), c = lane & 31, h = lane >> 5;
    LAS bf16* Kl = (LAS bf16*)lds;
    LAS bf16* Vt = (LAS bf16*)(lds + 36864);
    constexpr int LDV = 264;
    __syncthreads();
    const bf16* kg = proj + PC_SWAK + kvh * 64; const bf16* vg = proj + PC_SWAV + kvh * 64;
    if (b > 0) { stage_k<64, 256>(Kl, kg + (size_t)(128 * (b - 1)) * NPROJ, NPROJ, 0, tid, false); stage_vt<64, 256>(Vt, LDV, vg + (size_t)(128 * (b - 1)) * NPROJ, NPROJ, 0, tid, false); }
    else { stage_k<64, 128>(Kl, kg, NPROJ, 0, tid, true); stage_vt<64, 128>(Vt, LDV, vg, NPROJ, 0, tid, true);
           stage_k<64, 128>(Kl, kg, NPROJ, 128, tid, false); stage_vt<64, 128>(Vt, LDV, vg, NPROJ, 128, tid, false); }
    __syncthreads();
#pragma unroll 1
    for (int rep = 0; rep < 2; ++rep) {
        const int id = wave + 8 * rep, qh = id >> 2, qo = 32 * (id & 3), hg = 4 * kvh + qh;
        const int cL = launder_v(c), hL = launder_v(h);
        const int t = 128 * b + qo + c;
        const float slope = exp2f(-(float)(hg + 1)), sink = sinks[hg];
        bf16x8 qf[4];
#pragma unroll
        for (int ks = 0; ks < 4; ++ks) qf[ks] = *(const bf16x8*)(proj + (size_t)t * NPROJ + PC_SWAQ + hg * 64 + 16 * ks + 8 * h);
        f32x16 sc[5];
        const int kt0 = qo >> 5;
        float mx = -INFINITY;
#pragma unroll
        for (int j5 = 0; j5 < 5; ++j5) {
            const int kt = kt0 + j5;
            f32x16 acc;
#pragma unroll
            for (int r = 0; r < 16; ++r) acc[r] = 0.f;
#pragma unroll
            for (int ks = 0; ks < 4; ++ks) acc = MFMA32(*(const LAS bf16x8*)(Kl + (32 * kt + c) * 72 + 16 * ks + 8 * h), qf[ks], acc);
            const int dbase = launder_v(cL + 128 - 32 * j5 - 4 * hL);
#pragma unroll
            for (int r = 0; r < 16; ++r) { const int dist = dbase - ((r & 3) + 8 * (r >> 2)); const int kl = qo + cL + 128 - dist;
                const bool valid = (dist >= 0) && (dist < 128) && (b > 0 || kl >= 128);
                const float s = valid ? acc[r] * 0.125f - slope * (float)dist : -INFINITY; acc[r] = s; mx = fmaxf(mx, s); }
            sc[j5] = acc;
        }
        mx = fmaxf(mx, __shfl_xor(mx, 32)); mx = fmaxf(mx, sink);
        float sum = 0.f;
#pragma unroll
        for (int j5 = 0; j5 < 5; ++j5)
#pragma unroll
            for (int r = 0; r < 16; ++r) { const float p = __expf(sc[j5][r] - mx); sc[j5][r] = p; sum += p; }
        sum += __shfl_xor(sum, 32); sum += __expf(sink - mx);
        f32x16 o[2];
#pragma unroll
        for (int mt = 0; mt < 2; ++mt)
#pragma unroll
            for (int r = 0; r < 16; ++r) o[mt][r] = 0.f;
#pragma unroll
        for (int j5 = 0; j5 < 5; ++j5)
#pragma unroll
            for (int s = 0; s < 2; ++s) { const bf16x8 pf = pack8(sc[j5], s); const int kstep = 2 * (kt0 + j5) + s;
#pragma unroll
                for (int mt = 0; mt < 2; ++mt) o[mt] = MFMA32(*(const LAS bf16x8*)(Vt + (32 * mt + c) * LDV + 16 * kstep + 8 * h), pf, o[mt]); }
        const float inv = 1.f / sum;
#pragma unroll
        for (int mt = 0; mt < 2; ++mt) store_ot(y + (size_t)t * 2048 + 1024 + hg * 64 + 32 * mt, o[mt], inv, h);
    }
}

__device__ __forceinline__ void xattn_unit(LAS unsigned char* lds, const bf16* xq, const bf16* kv  , bf16* xo, int hd, int qb, int tid) {
    const int lane = tid & 63, wave = __builtin_amdgcn_readfirstlane(tid >> 6), c = lane & 31, h = lane >> 5;
    LAS bf16* Kl = (LAS bf16*)lds;
    LAS bf16* Vt = (LAS bf16*)(lds + 69632);
    constexpr int LDV = 264;
    const float scale = 0.08838834764831845f;
    __syncthreads();
    stage_k<128, 128>(Kl, kv + hd * 128, 1024, 0, tid, false); stage_vt<128, 128>(Vt, LDV, kv + 512 + hd * 128, 1024, 0, tid, false);
    stage_k<128, 128>(Kl, kv + (size_t)128 * 1024 + hd * 128, 1024, 128, tid, false); stage_vt<128, 128>(Vt, LDV, kv + (size_t)128 * 1024 + 512 + hd * 128, 1024, 128, tid, false);
    __syncthreads();
    const int t = 256 * qb + 32 * wave + c;
    bf16x8 qf[8];
#pragma unroll
    for (int ks = 0; ks < 8; ++ks) qf[ks] = *(const bf16x8*)(xq + (size_t)t * 512 + hd * 128 + 16 * ks + 8 * h);
    f32x16 o[4];
#pragma unroll
    for (int mt = 0; mt < 4; ++mt)
#pragma unroll
        for (int r = 0; r < 16; ++r) o[mt][r] = 0.f;
    float mrun = -INFINITY, sum = 0.f;
#pragma unroll 1
    for (int half = 0; half < 2; ++half) {
        f32x16 sc[4]; float mx = -INFINITY;
#pragma unroll
        for (int j4 = 0; j4 < 4; ++j4) { const int kt = 4 * half + j4; f32x16 acc;
#pragma unroll
            for (int r = 0; r < 16; ++r) acc[r] = 0.f;
#pragma unroll
            for (int ks = 0; ks < 8; ++ks) acc = MFMA32(*(const LAS bf16x8*)(Kl + (32 * kt + c) * 136 + 16 * ks + 8 * h), qf[ks], acc);
#pragma unroll
            for (int r = 0; r < 16; ++r) { acc[r] *= scale; mx = fmaxf(mx, acc[r]); }
            sc[j4] = acc; }
        mx = fmaxf(mx, __shfl_xor(mx, 32));
        const float mnew = fmaxf(mrun, mx), resc = __expf(mrun - mnew);
        float ps = 0.f;
#pragma unroll
        for (int j4 = 0; j4 < 4; ++j4)
#pragma unroll
            for (int r = 0; r < 16; ++r) { const float p = __expf(sc[j4][r] - mnew); sc[j4][r] = p; ps += p; }
        ps += __shfl_xor(ps, 32);
        sum = sum * resc + ps; mrun = mnew;
#pragma unroll
        for (int mt = 0; mt < 4; ++mt)
#pragma unroll
            for (int r = 0; r < 16; ++r) o[mt][r] *= resc;
#pragma unroll
        for (int j4 = 0; j4 < 4; ++j4)
#pragma unroll
            for (int s = 0; s < 2; ++s) { const bf16x8 pf = pack8(sc[j4], s); const int kstep = 2 * (4 * half + j4) + s;
#pragma unroll
                for (int mt = 0; mt < 4; ++mt) o[mt] = MFMA32(*(const LAS bf16x8*)(Vt + (32 * mt + c) * LDV + 16 * kstep + 8 * h), pf, o[mt]); }
    }
    const float inv = 1.f / sum;
#pragma unroll
    for (int mt = 0; mt < 4; ++mt) store_ot(xo + (size_t)t * 512 + hd * 128 + 32 * mt, o[mt], inv, h);
}

__device__ __forceinline__ void sb_unit(LAS unsigned char* lds, const bf16* proj, float kmax2, bf16* y, int hd, int qb, int tid) {
    const int lane = tid & 63, wave = __builtin_amdgcn_readfirstlane(tid >> 6), c = lane & 31, h = lane >> 5;
    LAS bf16* Kl = (LAS bf16*)lds;
    LAS bf16* Vt = (LAS bf16*)(lds + 34816);
    LAS unsigned* flags = (LAS unsigned*)(lds + 69632);
    constexpr int LDV = 136;
    const float scale = 0.08838834764831845f;
    const int t = 256 * qb + 32 * wave + c;
    bf16x8 qf[8]; float qq = 0.f;
#pragma unroll
    for (int ks = 0; ks < 8; ++ks) { const u32x4 w = *(const u32x4*)(proj + (size_t)t * NPROJ + PC_SBQ + hd * 128 + 16 * ks + 8 * h); qq += dot8(w, w); qf[ks] = __builtin_bit_cast(bf16x8, w); }
    qq += __shfl_xor(qq, 32);
    const float zb = sqrtf(qq * kmax2) * scale;
    f32x16 o[4];
#pragma unroll
    for (int mt = 0; mt < 4; ++mt)
#pragma unroll
        for (int r = 0; r < 16; ++r) o[mt][r] = 0.f;
    float carry = 0.f; bool wdone = false;
    const int tmax = 256 * qb + 32 * wave + 31;
#pragma unroll 1
    for (int kb = 2 * qb + 1; kb >= 0; --kb) {
        __syncthreads();
        stage_k_loop<128>(Kl, proj + (size_t)(128 * kb) * NPROJ + PC_SBK + hd * 128, NPROJ, 128, 0, tid);
        stage_vt_loop<128>(Vt, LDV, proj + (size_t)(128 * kb) * NPROJ + PC_SBV + hd * 128, NPROJ, 128, 0, tid);
        __syncthreads();
        if (!wdone && 128 * kb < tmax) {
#pragma unroll 1
            for (int kt = 3; kt >= 0; --kt) {
                const int key0 = 128 * kb + 32 * kt;
                if (key0 >= tmax) continue;
                const int trel = launder_v(t - key0 - 4 * h);
                f32x16 acc;
#pragma unroll
                for (int r = 0; r < 16; ++r) acc[r] = 0.f;
#pragma unroll
                for (int ks = 0; ks < 8; ++ks) acc = MFMA32(*(const LAS bf16x8*)(Kl + (32 * kt + c) * 136 + 16 * ks + 8 * h), qf[ks], acc);
                float lg[16], gso[4], gst[4];
#pragma unroll
                for (int g = 0; g < 4; ++g) { float s = 0.f;
#pragma unroll
                    for (int r = 0; r < 4; ++r) { const int reg = 4 * g + r; const bool valid = (r + 8 * g) < trel; const float z = acc[reg] * scale; acc[reg] = z;
                        const float l = valid ? -(fmaxf(z, 0.f) + __logf(1.f + __expf(-fabsf(z)))) : 0.f; lg[reg] = l; s += l; }
                    gso[g] = s; const float oth = __shfl_xor(s, 32); gst[g] = (h == 0) ? oth : 0.f; gso[g] = s + oth; }
                float suf = carry;
#pragma unroll
                for (int g = 3; g >= 0; --g) { float R = suf + gst[g];
#pragma unroll
                    for (int r = 3; r >= 0; --r) { const int reg = 4 * g + r; R += lg[reg]; const bool valid = (r + 8 * g) < trel; acc[reg] = valid ? __expf(acc[reg] + R) : 0.f; }
                    suf += gso[g]; }
                carry = suf;
#pragma unroll
                for (int s = 0; s < 2; ++s) { const bf16x8 pf = pack8(acc, s); const int kstep = 2 * kt + s;
#pragma unroll
                    for (int mt = 0; mt < 4; ++mt) o[mt] = MFMA32(*(const LAS bf16x8*)(Vt + (32 * mt + c) * LDV + 16 * kstep + 8 * h), pf, o[mt]); }
            }
            wdone = __all(carry + zb < -110.f);
        }
        if (lane == 0) flags[wave] = (wdone || kb == 0) ? 0u : 1u;
        LDS_WAIT();
        __syncthreads();
        unsigned any = 0u;
#pragma unroll
        for (int w8 = 0; w8 < 8; ++w8) any |= flags[w8];
        if (any == 0u) break;
    }
#pragma unroll
    for (int mt = 0; mt < 4; ++mt) store_ot(y + (size_t)t * 2048 + 1536 + hd * 128 + 32 * mt, o[mt], 1.f, h);
}

__device__ __forceinline__ void dpost_token(const bf16* __restrict__ oraw, const bf16* __restrict__ opb, const bf16* __restrict__ proj, const float* __restrict__ gain, bf16* __restrict__ y, int t, int lane) {
#pragma unroll
    for (int p = 0; p < 2; ++p) {
        const int c = 512 * p + 8 * lane;
        const u32x4 ov = *(const u32x4*)(oraw + (size_t)t * 1024 + c), pv = *(const u32x4*)(opb + (size_t)t * 1024 + c);
        const f32x4 a = {bf_lo(ov.x) + bf_lo(pv.x), bf_hi(ov.x) + bf_hi(pv.x), bf_lo(ov.y) + bf_lo(pv.y), bf_hi(ov.y) + bf_hi(pv.y)},
                    b = {bf_lo(ov.z) + bf_lo(pv.z), bf_hi(ov.z) + bf_hi(pv.z), bf_lo(ov.w) + bf_lo(pv.w), bf_hi(ov.w) + bf_hi(pv.w)};
        float ss = (a.x * a.x + a.y * a.y) + (a.z * a.z + a.w * a.w) + (b.x * b.x + b.y * b.y) + (b.z * b.z + b.w * b.w);
        ss = red16(ss);
        const float r = rsqrtf(ss * (1.f / 128.f) + EPS_);
        const f32x4 g0 = *(const f32x4*)(gain + (c & 127)), g1 = *(const f32x4*)(gain + (c & 127) + 4);
        const u32x4 zz = *(const u32x4*)(proj + (size_t)t * NPROJ + PC_Z + c);
        u32x4 o;
        o.x = cvt_pk_bf16(a.x * r * g0.x * siluf_(bf_lo(zz.x)), a.y * r * g0.y * siluf_(bf_hi(zz.x)));
        o.y = cvt_pk_bf16(a.z * r * g0.z * siluf_(bf_lo(zz.y)), a.w * r * g0.w * siluf_(bf_hi(zz.y)));
        o.z = cvt_pk_bf16(b.x * r * g1.x * siluf_(bf_lo(zz.z)), b.y * r * g1.y * siluf_(bf_hi(zz.z)));
        o.w = cvt_pk_bf16(b.z * r * g1.z * siluf_(bf_lo(zz.w)), b.w * r * g1.w * siluf_(bf_hi(zz.w)));
        *(u32x4*)(y + (size_t)t * 2048 + c) = o;
    }
}

__device__ __forceinline__ void convact_item(const bf16* __restrict__ up, const float* __restrict__ cw  , bf16* __restrict__ act, int tb, int cb, int lane) {
    const int c = 512 * cb + 8 * lane;
    float wg[3][8], wv[3][8];
#pragma unroll
    for (int i = 0; i < 3; ++i) {
        const f32x4 a = *(const f32x4*)(cw + i * 8192 + c), b = *(const f32x4*)(cw + i * 8192 + c + 4);
        const f32x4 d = *(const f32x4*)(cw + i * 8192 + 4096 + c), e = *(const f32x4*)(cw + i * 8192 + 4096 + c + 4);
        wg[i][0] = a.x; wg[i][1] = a.y; wg[i][2] = a.z; wg[i][3] = a.w; wg[i][4] = b.x; wg[i][5] = b.y; wg[i][6] = b.z; wg[i][7] = b.w;
        wv[i][0] = d.x; wv[i][1] = d.y; wv[i][2] = d.z; wv[i][3] = d.w; wv[i][4] = e.x; wv[i][5] = e.y; wv[i][6] = e.z; wv[i][7] = e.w;
    }
    const int t0 = tb * 32;
    const u32x4 z4 = {0u, 0u, 0u, 0u};
    u32x4 gp0 = z4, vp0 = z4, gp1 = z4, vp1 = z4;
    if (t0 >= 2) { gp0 = *(const u32x4*)(up + (size_t)(t0 - 2) * 8192 + c); vp0 = *(const u32x4*)(up + (size_t)(t0 - 2) * 8192 + 4096 + c);
                   gp1 = *(const u32x4*)(up + (size_t)(t0 - 1) * 8192 + c); vp1 = *(const u32x4*)(up + (size_t)(t0 - 1) * 8192 + 4096 + c); }
#pragma unroll 1
    for (int bt = 0; bt < 4; ++bt) {
        u32x4 gr[10], vr[10];
        gr[0] = gp0; vr[0] = vp0; gr[1] = gp1; vr[1] = vp1;
#pragma unroll
        for (int r = 0; r < 8; ++r) { const int t = t0 + 8 * bt + r; gr[2 + r] = *(const u32x4*)(up + (size_t)t * 8192 + c); vr[2 + r] = *(const u32x4*)(up + (size_t)t * 8192 + 4096 + c); }
        u32x4 ov[8];
#pragma unroll
        for (int r = 0; r < 8; ++r) {
            float ga[8], va[8];
#define CA_TAP(i, G, V, OP) \
            ga[0] OP wg[i][0] * bf_lo(G.x); ga[1] OP wg[i][1] * bf_hi(G.x); ga[2] OP wg[i][2] * bf_lo(G.y); ga[3] OP wg[i][3] * bf_hi(G.y); \
            ga[4] OP wg[i][4] * bf_lo(G.z); ga[5] OP wg[i][5] * bf_hi(G.z); ga[6] OP wg[i][6] * bf_lo(G.w); ga[7] OP wg[i][7] * bf_hi(G.w); \
            va[0] OP wv[i][0] * bf_lo(V.x); va[1] OP wv[i][1] * bf_hi(V.x); va[2] OP wv[i][2] * bf_lo(V.y); va[3] OP wv[i][3] * bf_hi(V.y); \
            va[4] OP wv[i][4] * bf_lo(V.z); va[5] OP wv[i][5] * bf_hi(V.z); va[6] OP wv[i][6] * bf_lo(V.w); va[7] OP wv[i][7] * bf_hi(V.w);
            CA_TAP(0, gr[r], vr[r], =) CA_TAP(1, gr[r + 1], vr[r + 1], +=) CA_TAP(2, gr[r + 2], vr[r + 2], +=)
#undef CA_TAP
            u32x4 o;
            o.x = cvt_pk_bf16(siluf_(ga[0]) * va[0], siluf_(ga[1]) * va[1]); o.y = cvt_pk_bf16(siluf_(ga[2]) * va[2], siluf_(ga[3]) * va[3]);
            o.z = cvt_pk_bf16(siluf_(ga[4]) * va[4], siluf_(ga[5]) * va[5]); o.w = cvt_pk_bf16(siluf_(ga[6]) * va[6], siluf_(ga[7]) * va[7]);
            ov[r] = o;
        }
#pragma unroll
        for (int r = 0; r < 8; ++r) *(u32x4*)(act + (size_t)(t0 + 8 * bt + r) * 4096 + c) = ov[r];
        gp0 = gr[8]; vp0 = vr[8]; gp1 = gr[9]; vp1 = vr[9];
    }
}

__device__ __forceinline__ const void* arg_ptr(int i) {
    const int off = launder_s(i * 8);
    const __attribute__((address_space(4))) char* ka = (const __attribute__((address_space(4))) char*)__builtin_amdgcn_kernarg_segment_ptr();
    return *(const void* const __attribute__((address_space(4)))*)(ka + off);
}
#define AIN(i) ((const float*)arg_ptr(i))
struct Args { const float* in[23]; float* out; unsigned char* ws; };
static_assert(sizeof(Args) == 25 * 8, "Args has no padding");

__global__ void __launch_bounds__(NWAVES * 64, 2) fwd_kernel(Args args) {
    extern __shared__ __attribute__((aligned(16))) unsigned char lds_raw[];
    LAS unsigned char* lds = (LAS unsigned char*)lds_raw;
    const int tid0 = threadIdx.x;
    const int G = gridDim.x, bx = blockIdx.x;
    const int NGW = G * NWAVES;
    unsigned* ctl0 = (unsigned*)((unsigned char*)arg_ptr(24) + WS_CTL);
    for (int u = tid0; u < (LDS_BYTES - LDSCTL_OFF) / 4; u += NWAVES * 64) ((LAS unsigned*)(lds + LDSCTL_OFF))[u] = 0u;
    __syncthreads();
    volatile LAS unsigned* MISC = (volatile LAS unsigned*)(lds + MISC_OFF);
    (void)xcd_barrier_post(ctl0 + CW_BAR, MISC + 8);
    if (bx >= 8) (void)xcd_barrier_post(ctl0 + CW_BAR2, MISC + 10);
#define GRID_BAR() do { XcdBarrier b_; b_.bar = (unsigned*)((unsigned char*)arg_ptr(24) + WS_CTL) + CW_BAR; b_.x = xb_xcc_id(); b_.st = MISC + 8; b_.G = gridDim.x; xcd_barrier(b_); } while (0)
#define SUB_BAR() do { XcdBarrier b_; b_.bar = (unsigned*)((unsigned char*)arg_ptr(24) + WS_CTL) + CW_BAR2; b_.x = xb_xcc_id(); b_.st = MISC + 10; b_.G = gridDim.x - 8; xcd_barrier(b_); } while (0)
#define PHASE_IDS() const int tid = launder_v(threadIdx.x), lane = tid & 63, wave = __builtin_amdgcn_readfirstlane(tid >> 6), gw = bx * NWAVES + wave; (void)lane; (void)gw; (void)tid; WS_PTRS()

#define WS_PTRS() unsigned char* ws = (unsigned char*)arg_ptr(24); float* hbuf = (float*)arg_ptr(23); (void)hbuf; \
    bf16* Win_t = (bf16*)(ws + WS_WIN); bf16* Wup_t = (bf16*)(ws + WS_WUP); bf16* Wdn_t = (bf16*)(ws + WS_WDN); bf16* Wo_t = (bf16*)(ws + WS_WO); \
    bf16* Wbd_t = (bf16*)(ws + WS_WBD); bf16* Wbs_t = (bf16*)(ws + WS_WBS); bf16* Wbb_t = (bf16*)(ws + WS_WBB); \
    bf16* Wxq_t = (bf16*)(ws + WS_WXQ); bf16* Wxkv_t = (bf16*)(ws + WS_WXKV); bf16* Wxo_t = (bf16*)(ws + WS_WXO); \
    bf16* XN = (bf16*)(ws + WS_XN); bf16* PROJ = (bf16*)(ws + WS_PROJ); bf16* UP = (bf16*)(ws + WS_UP); bf16* ACT = (bf16*)(ws + WS_ACT); \
    unsigned char* DPREP = ws + WS_DPREP; bf16* ORAW = (bf16*)(ws + WS_ORAW); bf16* OPB = (bf16*)(ws + WS_OPB); (void)OPB; bf16* Y = (bf16*)(ws + WS_Y); \
    unsigned char* GATES = ws + WS_MRG; (void)GATES; bf16* MRGB = (bf16*)(ws + WS_MRGB); bf16* XQ = (bf16*)(ws + WS_XQ); bf16* XO = (bf16*)(ws + WS_XO); \
    bf16* KV = (bf16*)(ws + WS_KV); bf16* MEMN = (bf16*)(ws + WS_MEMN); float* GL = (float*)(ws + WS_GL); unsigned* ctl = (unsigned*)(ws + WS_CTL); unsigned long long* SSQ = (unsigned long long*)(ws + WS_SSQ); (void)SSQ; \
    (void)Win_t; (void)Wup_t; (void)Wdn_t; (void)Wo_t; (void)Wbd_t; (void)Wbs_t; (void)Wbb_t; (void)Wxq_t; (void)Wxkv_t; (void)Wxo_t; (void)XN; (void)PROJ; (void)UP; (void)ACT; \
    (void)DPREP; (void)ORAW; (void)Y; (void)MRGB; (void)XQ; (void)XO; (void)KV; (void)MEMN; (void)GL; (void)ctl

#define CONVERT_WEIGHTS(LIN, LREST, W0_, NW_) do { \
        LAS float* scr = (LAS float*)(lds + wave * 16384); \
        constexpr int N_IN = 32 * 400, N_UP = 32 * 256, N_DN = 64 * 64, N_O = 32 * 64, N_BD = 16 * 64, N_BS = 8 * 64, N_XQ = 32 * 16, N_XKV = 32 * 32, N_XO = 8 * 64; \
        constexpr int N_REST = N_UP + N_DN + N_O + N_BD + 2 * N_BS + N_XQ + N_XKV + N_XO; \
        const int lin_ = (LIN), lrest_ = (LREST); \
        const int nitems_ = (lin_ >= 0 ? N_IN : 0) + (lrest_ >= 0 ? N_REST : 0); \
        _Pragma("unroll 1") for (int it = (W0_); it < nitems_; it += (NW_)) { \
            int r = it; \
            if (lin_ >= 0) { if (r < N_IN) { const int kb = r / 400, nb = r % 400; \
                transpose_item<1>(AIN(3) + (size_t)lin_ * 2048 * IN_COLS_SRC, 2048, IN_COLS_SRC, Win_t + (size_t)lin_ * NPROJ * 2048, scr, kb, nb, lane, AIN(2) + lin_ * 2048); continue; } r -= N_IN; } \
            TR_CASE2(N_UP, 19, 2048, 8192, Wup_t, AIN(18) + lrest_ * 2048) TR_CASE(N_DN, 21, 4096, 2048, Wdn_t, nullptr) TR_CASE(N_O, 12, 2048, 2048, Wo_t, nullptr) TR_CASEW(N_BD, 9, 1024, 2048, 0) \
            TR_CASEW(N_BS, 10, 512, 2048, 1024) TR_CASEW(N_BS, 11, 512, 2048, 1536) TR_CASE(N_XQ, 15, 2048, 512, Wxq_t, AIN(13) + lrest_ * 2048) TR_CASE(N_XKV, 16, 2048, 1024, Wxkv_t, nullptr) TR_CASE(N_XO, 17, 512, 2048, Wxo_t, nullptr) \
        } } while (0)
#define TR_CASEW(NPER, IDX, KK, NN, KOFF) \
            if (r < (NPER)) { const int kb = r / ((NN) / 32), nb = r % ((NN) / 32); \
                transpose_item<0>(AIN(IDX) + (size_t)lrest_ * (KK) * (NN), KK, NN, Wbd_t + (size_t)lrest_ * 2048 * 2048 + (KOFF), scr, kb, nb, lane, nullptr, 2048); continue; } r -= (NPER);
#define TR_CASE2(NPER, IDX, KK, NN, DSTP, GK) \
            if (r < (NPER)) { const int kb = r / ((NN) / 32), nb = r % ((NN) / 32); \
                transpose_item<2>(AIN(IDX) + (size_t)lrest_ * (KK) * (NN), KK, NN, (DSTP) + (size_t)lrest_ * (NN) * (KK), scr, kb, nb, lane, GK); continue; } r -= (NPER);
#define TR_CASE(NPER, IDX, KK, NN, DSTP, GK) \
            if (r < (NPER)) { const int kb = r / ((NN) / 32), nb = r % ((NN) / 32); \
                transpose_item<0>(AIN(IDX) + (size_t)lrest_ * (KK) * (NN), KK, NN, (DSTP) + (size_t)lrest_ * (NN) * (KK), scr, kb, nb, lane, GK); continue; } r -= (NPER);
    {
        PHASE_IDS();
        CONVERT_WEIGHTS(0, -1, gw, NGW);
#pragma unroll 1
        for (int m = gw; m < S_; m += NGW) {
            const f32x4* xr = (const f32x4*)(AIN(0) + (size_t)m * D_) + lane; u32x2* o8 = (u32x2*)(XN + (size_t)m * D_) + lane; float ss = 0.f;
            f32x4 xv[8];
#pragma unroll
            for (int j = 0; j < 8; ++j) xv[j] = xr[64 * j];
#pragma unroll
            for (int j = 0; j < 8; ++j) { const f32x4 v = xv[j]; ss += (v.x * v.x + v.y * v.y) + (v.z * v.z + v.w * v.w); u32x2 w; w.x = cvt_pk_bf16(v.x, v.y); w.y = cvt_pk_bf16(v.z, v.w); o8[64 * j] = w; }
            ss = wave_sum(ss); if (lane == 0) SSQ[m] = (unsigned long long)(ss * 1048576.f); }
#pragma unroll 1
        for (int it = gw; it < 4 * MEML; it += NGW) { const int l = it / MEML, m = it % MEML;
            rms_row_bf16(AIN(1) + (size_t)m * D_, AIN(14) + l * D_, MEMN + ((size_t)l * MEML + m) * D_, lane); }
    }
    GRID_BAR();

#pragma unroll 1
    for (int l = 0; l < DEPTH_; ++l) {

        { WS_PTRS(); pg8::Gemm g{XN, Win_t + (size_t)l * NPROJ * D_, S_, NPART_A, D_, D_, D_}; pg8::StaticOrder SO; SO.init(S_, NPART_A, G, bx);
          pg8::EpiProj E{PROJ, NPROJ, SSQ + (size_t)(3 * l) * S_, GATES, PC_GATE, NPART_A};
          pg8::gemm_phase<pg8::EpiProj, pg8::StaticOrder, true>(lds, g, SO, E); }
        GRID_BAR();
        { PHASE_IDS(); float kmax = 0.f;
#pragma unroll 1
          for (int t = gw; t < S_; t += NGW) { const u32x4 r = *(const u32x4*)(PROJ + (size_t)t * NPROJ + PC_SBK + 8 * lane); float ss = dot8(r, r); ss = red16(ss); kmax = fmaxf(kmax, ss); }
          if ((lane & 15) == 0) atomicMax(ctl + CW_KMAX + l * 64 + (lane >> 4), __float_as_uint(kmax));
          const float* convw = AIN(4) + (size_t)l * 4 * 3072; const float* alog = AIN(5) + l * 8; const float* dtb = AIN(6) + l * 8;
          int cur_hd = -1;
          const unsigned char* zero16 = (const unsigned char*)(ctl + CW_ZERO16);
          float alog_c = 0.f, dtb_c = 0.f;
          if (bx < (S_ / 64) * 8) { const int u0 = bx, hd0 = u0 & 7, t00 = (u0 >> 3) * 64;
              __syncthreads();
              prep_stage_raw(lds, PROJ, zero16, t00, hd0, tid);
              asm volatile("s_waitcnt vmcnt(0)" ::: "memory"); }
#pragma unroll 1
          for (int u = bx; u < (S_ / 64) * 8; u += G) { const int hd = u & 7;
            if (hd != cur_hd) {
                __syncthreads();
                for (int i = tid; i < 4 * 384; i += NWAVES * 64) { const int tap = i / 384, c = i % 384; ((LAS float*)(lds + P_CW))[i] = convw[tap * 3072 + (c >> 7) * 1024 + hd * 128 + (c & 127)]; }
                alog_c = alog[hd]; dtb_c = dtb[hd];
                asm volatile("" : "+v"(alog_c), "+v"(dtb_c));
                cur_hd = hd; }
            delta_prep_unit(lds, PROJ, convw, alog_c, dtb_c, DPREP + ((size_t)hd * (S_ / 64) + (u >> 3)) * DU_BYTES, GL + u, OPB, (u >> 3) * 64, hd, tid, zero16, (u + G < (S_ / 64) * 8) ? ((u + G) >> 3) * 64 : -1); }
          __syncthreads(); }
        GRID_BAR();
        { PHASE_IDS();
        if (bx < 8) delta_scan_head(lds, DPREP, GL, ORAW, bx, tid);
        else {
            const int late = (bx >> 3) & 1;
            if (late) { CONVERT_WEIGHTS(-1, l, gw - 8 * NWAVES, NGW - 8 * NWAVES); __syncthreads(); }
            { pg8::Gemm g{XN, Win_t + (size_t)l * NPROJ * D_ + (size_t)PC_SWAQ * D_, S_, NPROJ - PC_SWAQ, D_, D_, D_}; pg8::StaticOrder SO; SO.init(S_, NPROJ - PC_SWAQ, G - 8, bx - 8);
              pg8::EpiBf16 E{PROJ + PC_SWAQ, NPROJ, SSQ + (size_t)(3 * l) * S_};
              pg8::gemm_phase<pg8::EpiBf16, pg8::StaticOrder, true>(lds, g, SO, E); }
            asm volatile("s_waitcnt vmcnt(0)" ::: "memory");
            __syncthreads();
            if (tid == 0) { __builtin_amdgcn_fence(__ATOMIC_RELEASE, "agent"); asm volatile("s_waitcnt vmcnt(0)" ::: "memory"); (void)xb_add(ctl + CW_B1CNT + l * 64, 1u); }
            { const int cB = (bx - 8 + 56) % (G - 8);
              pg8::Gemm g{XN, Win_t + (size_t)l * NPROJ * D_ + (size_t)NPART_A * D_, S_, PC_SWAQ - NPART_A, D_, D_, D_}; pg8::StaticOrder SO; SO.init(S_, PC_SWAQ - NPART_A, G - 8, cB);
              pg8::EpiProj E{PROJ + NPART_A, NPROJ, SSQ + (size_t)(3 * l) * S_, GATES + (NPART_A - PC_GATE), 0, PC_GATE + 6144 - NPART_A};
              pg8::gemm_phase<pg8::EpiProj, pg8::StaticOrder, true>(lds, g, SO, E); }
            if (tid == 0) { unsigned* bar0 = ctl + CW_BAR; XB_SPIN(xb_ld(ctl + CW_B1CNT + l * 64) < (unsigned)(G - 8), bar0); __builtin_amdgcn_fence(__ATOMIC_ACQUIRE, "agent"); asm volatile("s_waitcnt vmcnt(0)" ::: "memory"); }
            __syncthreads();
            {
              const int j = bx - 8, NSH = G - 8;
              const float* sinks = AIN(8) + l * 8;
              int u0, u1, u2;
              if (NSH == 248) {
                  const bool shortg = (j >= 184 && j < 192) || j >= 200;
                  if (shortg) { const int si = j < 192 ? j - 184 : 8 + (j - 200); u0 = 2 * si; u1 = 2 * si + 1; u2 = 256 + si; }
                  else { const int li = j < 184 ? j : j - 8;
                      if (li < 144) { u0 = 112 + li; u1 = 256 + 56 + li; u2 = -1; }
                      else { const int k2 = li - 144; u0 = 256 + 200 + k2; u1 = k2 < 8 ? 256 + 248 + k2 : -1; u2 = -1; } } }
              else { u0 = j; u1 = j + NSH; u2 = j + 2 * NSH; if (u1 >= 512) u1 = -1; if (u2 >= 512) u2 = -1; }
#pragma unroll 1
              for (int k = 0; k < 3; ++k) { const int u = (k == 0) ? u0 : (k == 1 ? u1 : u2);
                  if (u < 0) continue;
                  if (u < 256) sb_unit(lds, PROJ, __uint_as_float(ctl[CW_KMAX + l * 64 + (u & 3)]), Y, u & 3, u >> 2, tid);
                  else swa_unit(lds, PROJ, sinks, Y, (u - 256) & 1, (u - 256) >> 1, tid); }
            }
            __syncthreads();
            if (!late) { CONVERT_WEIGHTS(-1, l, gw - 8 * NWAVES, NGW - 8 * NWAVES); }
        } }
        GRID_BAR();
        { PHASE_IDS();
#pragma unroll 1
          for (int t = gw; t < S_; t += 2 * NGW) { dpost_token(ORAW, OPB, PROJ, AIN(7) + l * 128, Y, t, lane); dpost_token(ORAW, OPB, PROJ, AIN(7) + l * 128, Y, t + NGW, lane); } }
        GRID_BAR();
        { WS_PTRS(); pg8::StaticOrder SO; SO.init(S_, D_, G, bx);
          pg8::Gemm g{Y, Wbd_t + (size_t)l * 2048 * 2048, S_, D_, 2048, 2048, 2048}; pg8::EpiMerge E{GATES, 6144, MRGB, D_};
          pg8::gemm_phase<pg8::EpiMerge, pg8::StaticOrder, true>(lds, g, SO, E); }
        GRID_BAR();
        { WS_PTRS(); pg8::Gemm g{MRGB, Wo_t + (size_t)l * D_ * D_, S_, D_, D_, D_, D_}; pg8::StaticOrder SO; SO.init(S_, D_, G, bx);
          pg8::EpiRes E{XN, D_, SSQ + (size_t)(3 * l + 1) * S_};
          pg8::gemm_phase<pg8::EpiRes, pg8::StaticOrder, true>(lds, g, SO, E); }
        GRID_BAR();
        { WS_PTRS(); pg8::Gemm g{XN, Wxq_t + (size_t)l * 512 * D_, S_, 512, D_, D_, D_}; pg8::StaticOrder SO; SO.init(S_, 512, G, bx);
          pg8::EpiBf16 E{XQ, 512, SSQ + (size_t)(3 * l + 1) * S_};
          pg8::gemm_phase<pg8::EpiBf16, pg8::StaticOrder, true>(lds, g, SO, E); }
        { WS_PTRS(); pg8::Gemm g{MEMN + (size_t)l * MEML * D_, Wxkv_t + (size_t)l * 1024 * D_, MEML, 1024, D_, D_, D_}; pg8::StaticOrder SO; SO.init(MEML, 1024, G, (bx + G - 128) % G);
          pg8::EpiBf16 E{KV + (size_t)l * MEML * 1024, 1024, nullptr};
          pg8::gemm_phase<pg8::EpiBf16, pg8::StaticOrder, true>(lds, g, SO, E); }
        { PHASE_IDS(); if (bx >= 132 && l + 1 < DEPTH_) { CONVERT_WEIGHTS(l + 1, -1, gw - 132 * NWAVES, NGW - 132 * NWAVES); } }
        GRID_BAR();
        { PHASE_IDS();
#pragma unroll 1
          for (int u = bx; u < 256; u += G) xattn_unit(lds, XQ, KV + (size_t)l * MEML * 1024, XO, u & 3, u >> 2, tid);
          __syncthreads(); }
        GRID_BAR();
        { WS_PTRS(); pg8::Gemm g{XO, Wxo_t + (size_t)l * D_ * 512, S_, D_, 512, 512, 512}; pg8::StaticOrder SO; SO.init(S_, D_, G, bx);
          pg8::EpiRes E{XN, D_, SSQ + (size_t)(3 * l + 2) * S_};
          pg8::gemm_phase<pg8::EpiRes, pg8::StaticOrder, true>(lds, g, SO, E); }
        GRID_BAR();
        { WS_PTRS(); pg8::Gemm g{XN, Wup_t + (size_t)l * 8192 * D_, S_, 8192, D_, D_, D_}; pg8::StaticOrder SO; SO.init(S_, 8192, G, bx);
          pg8::EpiConv E{ACT, SSQ + (size_t)(3 * l + 2) * S_, AIN(20) + (size_t)l * 3 * 8192, UP};
          pg8::gemm_phase<pg8::EpiConv, pg8::StaticOrder, true>(lds, g, SO, E); }
        GRID_BAR();
        { PHASE_IDS(); const float* cw = AIN(20) + (size_t)l * 3 * 8192;
#pragma unroll 1
          for (int it = bx * NWAVES * 64 + tid; it < 512 * 512; it += G * NWAVES * 64) {
              const int c = (it & 511) * 8, rj = it >> 9, grp = rj >> 1, j = rj & 1, t = 64 * grp + j;
              const bf16* h0 = UP + ((size_t)(grp * 4 + 2 + j) * 2) * 4096 + c;
              const bf16* h1 = j ? UP + ((size_t)(grp * 4 + 2) * 2) * 4096 + c : UP + ((size_t)((grp - 1) * 4 + 1) * 2) * 4096 + c;
              const bf16* h2 = j ? UP + ((size_t)((grp - 1) * 4 + 1) * 2) * 4096 + c : UP + ((size_t)((grp - 1) * 4 + 0) * 2) * 4096 + c;
              const u32x4 z4 = {0u, 0u, 0u, 0u};
              const bool p1 = j || grp > 0, p2 = grp > 0;
              const u32x4 g0 = *(const u32x4*)h0, v0 = *(const u32x4*)(h0 + 4096);
              const u32x4 g1 = p1 ? *(const u32x4*)h1 : z4, v1 = p1 ? *(const u32x4*)(h1 + 4096) : z4;
              const u32x4 g2 = p2 ? *(const u32x4*)h2 : z4, v2 = p2 ? *(const u32x4*)(h2 + 4096) : z4;
              float ga[8], va[8];
#define FX_TAP(i, G_, V_, OP) { const f32x4 a = *(const f32x4*)(cw + (i) * 8192 + c), b = *(const f32x4*)(cw + (i) * 8192 + c + 4), d = *(const f32x4*)(cw + (i) * 8192 + 4096 + c), e = *(const f32x4*)(cw + (i) * 8192 + 4096 + c + 4); \
              ga[0] OP a[0] * bf_lo(G_.x); ga[1] OP a[1] * bf_hi(G_.x); ga[2] OP a[2] * bf_lo(G_.y); ga[3] OP a[3] * bf_hi(G_.y); ga[4] OP b[0] * bf_lo(G_.z); ga[5] OP b[1] * bf_hi(G_.z); ga[6] OP b[2] * bf_lo(G_.w); ga[7] OP b[3] * bf_hi(G_.w); \
              va[0] OP d[0] * bf_lo(V_.x); va[1] OP d[1] * bf_hi(V_.x); va[2] OP d[2] * bf_lo(V_.y); va[3] OP d[3] * bf_hi(V_.y); va[4] OP e[0] * bf_lo(V_.z); va[5] OP e[1] * bf_hi(V_.z); va[6] OP e[2] * bf_lo(V_.w); va[7] OP e[3] * bf_hi(V_.w); }
              FX_TAP(0, g2, v2, =) FX_TAP(1, g1, v1, +=) FX_TAP(2, g0, v0, +=)
#undef FX_TAP
              u32x4 o;
#define FX_ACT(x_, y_) ((x_) * __builtin_amdgcn_rcpf(1.f + __expf(-(x_))) * (y_))
              o.x = cvt_pk_bf16(FX_ACT(ga[0], va[0]), FX_ACT(ga[1], va[1])); o.y = cvt_pk_bf16(FX_ACT(ga[2], va[2]), FX_ACT(ga[3], va[3]));
              o.z = cvt_pk_bf16(FX_ACT(ga[4], va[4]), FX_ACT(ga[5], va[5])); o.w = cvt_pk_bf16(FX_ACT(ga[6], va[6]), FX_ACT(ga[7], va[7]));
#undef FX_ACT
              *(u32x4*)(ACT + (size_t)t * 4096 + c) = o; } }
        GRID_BAR();
        { WS_PTRS(); pg8::Gemm g{ACT, Wdn_t + (size_t)l * D_ * DFF, S_, D_, DFF, DFF, DFF}; pg8::StaticOrder SO; SO.init(S_, D_, G, bx);
          pg8::EpiRes E{XN, D_, SSQ + (size_t)(3 * l + 3) * S_};
          pg8::gemm_phase<pg8::EpiRes, pg8::StaticOrder, true>(lds, g, SO, E); }
        GRID_BAR();
    }
    { PHASE_IDS();
#pragma unroll 1
      for (int m = gw; m < S_; m += NGW) { const u32x2* hr = (const u32x2*)(XN + (size_t)m * D_) + lane; f32x4* orow = (f32x4*)(hbuf + (size_t)m * D_) + lane; const f32x4* gr = (const f32x4*)AIN(22) + lane;
          const float rstd = rsqrtf((float)SSQ[(size_t)(3 * DEPTH_) * S_ + m] * (1.f / (2048.f * 1048576.f)) + EPS_);
          u32x2 hv[8]; f32x4 gq[8];
#pragma unroll
          for (int j = 0; j < 8; ++j) { hv[j] = hr[64 * j]; gq[j] = gr[64 * j]; }
#pragma unroll
          for (int j = 0; j < 8; ++j) { const f32x4 v = {bf_lo(hv[j].x), bf_hi(hv[j].x), bf_lo(hv[j].y), bf_hi(hv[j].y)}; orow[64 * j] = v * rstd * gq[j]; } } }
}

extern "C" void kernel_launch(void* const* d_in, const int* in_sizes, int n_in, void* d_out, int out_size, void* d_ws, size_t ws_size, hipStream_t stream) {
    static int grid = 0;
    if (grid == 0) {
        if (n_in != 23 || out_size != S_ * D_ || ws_size < WS_END) { fprintf(stderr, "kernel_launch: unexpected shapes (n_in %d, out %d, ws %zu, need %zu)\n", n_in, out_size, ws_size, (size_t)WS_END); grid = -1; return; }
        int dev = 0, cus = 0, per_cu = 0;
        if (hipGetDevice(&dev) != hipSuccess || hipDeviceGetAttribute(&cus, hipDeviceAttributeMultiprocessorCount, dev) != hipSuccess) { grid = -1; return; }
        if (hipFuncSetAttribute((const void*)fwd_kernel, hipFuncAttributeMaxDynamicSharedMemorySize, LDS_BYTES) != hipSuccess) { fprintf(stderr, "kernel_launch: hipFuncSetAttribute failed\n"); grid = -1; return; }
        if (hipOccupancyMaxActiveBlocksPerMultiprocessor(&per_cu, (const void*)fwd_kernel, NWAVES * 64, LDS_BYTES) != hipSuccess || per_cu < 1)
            fprintf(stderr, "kernel_launch: occupancy query reports %d workgroups per CU\n", per_cu);
        (void)hipGetLastError();
        grid = cus;
    }
    if (grid < 0) return;
    if (hipMemsetAsync((char*)d_ws + WS_CTL, 0, CTL_ZERO_BYTES, stream) != hipSuccess || hipMemsetAsync((char*)d_ws + WS_SSQ, 0, SSQ_BYTES, stream) != hipSuccess) { fprintf(stderr, "kernel_launch: memset failed\n"); return; }
    Args a{};
    for (int i = 0; i < 23; ++i) a.in[i] = (const float*)d_in[i];
    a.out = (float*)d_out; a.ws = (unsigned char*)d_ws;
    hipLaunchKernelGGL(fwd_kernel, dim3(grid), dim3(NWAVES * 64), LDS_BYTES, stream, a);
    const hipError_t le = hipPeekAtLastError();
    if (le != hipSuccess) fprintf(stderr, "kernel_launch: launch failed: %s\n", hipGetErrorName(le));
}
```
